# Optimizing an MI355X kernel written in HIP

```python
import jax
import jax.numpy as jnp
from jax import lax
import numpy as np

D_MODEL = 1024
BATCH = 2
SEQ = 8192
DEPTH = 1

NORM_EPS = 1e-6
HG_KDIM = 128
HG_VDIM = 128
HG_HEADS = (D_MODEL // 2) // HG_VDIM
HG_FDIM = HG_HEADS * HG_KDIM
HG_WIDTH = HG_HEADS * HG_VDIM
HG_CHUNK = 64
RW_HEAD = 64
RW_WIDTH = D_MODEL // 2
RW_HEADS = RW_WIDTH // RW_HEAD
RW_DECAY_LORA = 32
RW_AAA_LORA = 32
RW_GATE_LORA = 96
RW_SHIFT_COLS = 3 * RW_WIDTH + RW_DECAY_LORA + RW_AAA_LORA + RW_GATE_LORA
RW_GN_EPS = 64e-5
RW_SPLITS = (RW_WIDTH, 2 * RW_WIDTH, 3 * RW_WIDTH, 3 * RW_WIDTH + RW_DECAY_LORA,
             3 * RW_WIDTH + RW_DECAY_LORA + RW_AAA_LORA)
IN_SPLITS = (HG_FDIM, 2 * HG_FDIM, 2 * HG_FDIM + HG_WIDTH, 2 * HG_FDIM + 2 * HG_WIDTH,
             2 * HG_FDIM + 2 * HG_WIDTH + RW_SHIFT_COLS)
IN_COLS = 2 * HG_FDIM + 2 * HG_WIDTH + RW_SHIFT_COLS + 2 * D_MODEL
N_GROUPS = 4
EXPERTS_PER_GROUP = 8
N_EXPERTS = N_GROUPS * EXPERTS_PER_GROUP
TOP_K = 2
D_FF_EXPERT = 512
MOE_BLOCK = 128

kernel_name = 'hgrn2_rwkv7_gated_hier_moe_block'


def rmsnorm(x, gain, eps=NORM_EPS):
    xf = x.astype(jnp.float32)
    y = xf * lax.rsqrt(jnp.mean(xf * xf, axis=-1, keepdims=True) + eps)
    return (y * gain.astype(jnp.float32)).astype(x.dtype)


def hgrn2_mixer(q, f_raw, i, g, lb, norm_g):
    B, S, _ = q.shape
    nc = S // HG_CHUNK
    f32 = jnp.float32
    f = lb + (1.0 - lb) * jax.nn.sigmoid(f_raw.astype(f32))
    log_f = jnp.log(f)
    k = 1.0 - f
    qf = jax.nn.silu(q.astype(f32))

    def to_chunks(t, d):
        return t.reshape(B, nc, HG_CHUNK, HG_HEADS, d).transpose(1, 0, 3, 2, 4)

    qc, kc, lc = to_chunks(qf, HG_KDIM), to_chunks(k, HG_KDIM), to_chunks(log_f, HG_KDIM)
    vc = to_chunks(i.astype(f32), HG_VDIM)
    causal = jnp.tril(jnp.ones((HG_CHUNK, HG_CHUNK), dtype=bool))[None, None, :, :, None]

    def chunk_step(state, inp):
        q_t, k_t, v_t, l_t = inp
        cum = jnp.cumsum(l_t, axis=2)
        o_inter = jnp.einsum('bhtk,bhkv->bhtv', q_t * jnp.exp(cum), state)
        rel = jnp.where(causal, cum[:, :, :, None, :] - cum[:, :, None, :, :], -jnp.inf)
        scores = jnp.einsum('bhtk,bhtsk,bhsk->bhts', q_t, jnp.exp(rel), k_t)
        o = o_inter + jnp.einsum('bhts,bhsv->bhtv', scores, v_t)
        last = cum[:, :, -1:, :]
        state = (jnp.exp(last[:, :, 0, :])[..., None] * state
                 + jnp.einsum('bhsk,bhsv->bhkv', k_t * jnp.exp(last - cum), v_t))
        return state, o

    s0 = jnp.zeros((B, HG_HEADS, HG_KDIM, HG_VDIM), f32)
    _, o = lax.scan(chunk_step, s0, (qc, kc, vc, lc))
    o = o.transpose(1, 0, 3, 2, 4).reshape(B, S, HG_HEADS, HG_VDIM)
    o = (o * lax.rsqrt(jnp.mean(o * o, axis=-1, keepdims=True) + NORM_EPS)
         * norm_g.astype(f32).reshape(HG_HEADS, HG_VDIM))
    return (o.reshape(B, S, HG_WIDTH) * jax.nn.silu(g.astype(f32))).astype(g.dtype)


def rwkv7_mixer(p, mu, w0, w2, a0, a2, g2, k_k, k_a, r_k, gn_w, gn_b):
    B, S, _ = p.shape
    dt = p.dtype
    f32 = jnp.float32
    p = p.astype(f32)
    prev = jnp.pad(p, ((0, 0), (1, 0), (0, 0)))[:, :-1]
    p = p + mu.astype(f32) * (prev - p)
    r, k, v, wd, ad, gd = jnp.split(p, RW_SPLITS, axis=-1)
    w = -jax.nn.softplus(-(w0.astype(f32) + jnp.tanh(wd) @ w2.astype(f32))) - 0.5
    decay = jnp.exp(-jnp.exp(w))
    a = jax.nn.sigmoid(a0.astype(f32) + ad @ a2.astype(f32))
    g = jax.nn.sigmoid(gd) @ g2.astype(f32)

    def heads(t):
        return t.reshape(B, S, RW_HEADS, RW_HEAD)

    kk = heads(k * k_k.astype(f32))
    kk = kk * lax.rsqrt(jnp.maximum(jnp.sum(kk * kk, axis=-1, keepdims=True), 1e-24))
    k = k * (1.0 + (a - 1.0) * k_a.astype(f32))
    r_h, k_h, v_h, w_h, a_h = heads(r), heads(k), heads(v), heads(decay), heads(a)

    def seq(t):
        return jnp.swapaxes(t, 0, 1)

    def time_step(state, inp):
        r_t, w_t, k_t, v_t, a_t, b_t = inp
        sa = jnp.einsum('bhij,bhj->bhi', state, a_t)
        state = (state * w_t[:, :, None, :] + sa[..., None] * b_t[:, :, None, :]
                 + v_t[..., None] * k_t[:, :, None, :])
        return state, jnp.einsum('bhij,bhj->bhi', state, r_t)

    s0 = jnp.zeros((B, RW_HEADS, RW_HEAD, RW_HEAD), f32)
    _, y = lax.scan(time_step, s0, (seq(r_h), seq(w_h), seq(k_h), seq(v_h), seq(-kk), seq(kk * a_h)))
    y = seq(y)
    mean = jnp.mean(y, axis=-1, keepdims=True)
    var = jnp.mean(jnp.square(y - mean), axis=-1, keepdims=True)
    y = ((y - mean) * lax.rsqrt(var + RW_GN_EPS)).reshape(B, S, RW_WIDTH) * gn_w.astype(f32) + gn_b.astype(f32)
    bonus = jnp.sum(r_h * k_h * r_k.astype(f32), axis=-1, keepdims=True) * v_h
    return ((y + bonus.reshape(B, S, RW_WIDTH)) * g).astype(dt)


def hier_moe(h, wg_r, bg_r, we_r, be_r, w_gate, w_up, w_down):
    B, S, D = h.shape
    N = B * S
    f32 = jnp.float32
    xf = h.reshape(N, D)
    lg = (xf @ wg_r).astype(f32) + bg_r.astype(f32)
    pg = jax.nn.softmax(lg, axis=-1)
    _, grp_idx = lax.top_k(lg, 1)
    p_grp = jnp.take_along_axis(pg, grp_idx, axis=1)[:, 0]
    le = ((xf @ we_r).astype(f32) + be_r.astype(f32)).reshape(N, N_GROUPS, EXPERTS_PER_GROUP)
    sel = jnp.broadcast_to(grp_idx[:, :, None], (N, 1, EXPERTS_PER_GROUP))
    pe = jax.nn.softmax(jnp.take_along_axis(le, sel, axis=1)[:, 0], axis=-1)
    top_p, top_i = lax.top_k(pe, TOP_K)
    wts = p_grp[:, None] * top_p / jnp.sum(top_p, axis=-1, keepdims=True)
    eid = (grp_idx * EXPERTS_PER_GROUP + top_i).astype(jnp.int32)

    A = N * TOP_K
    eid_flat = eid.reshape(A)
    tok_flat = jnp.repeat(jnp.arange(N, dtype=jnp.int32), TOP_K)
    w_flat = wts.reshape(A)
    sorted_e, order = lax.sort_key_val(eid_flat, jnp.arange(A, dtype=jnp.int32))
    counts = jnp.bincount(eid_flat, length=N_EXPERTS).astype(jnp.int32)
    starts = jnp.cumsum(counts) - counts
    padded = (counts + MOE_BLOCK - 1) // MOE_BLOCK * MOE_BLOCK
    pad_end = jnp.cumsum(padded)
    pad_start = pad_end - padded
    dest = pad_start[sorted_e] + (jnp.arange(A, dtype=jnp.int32) - starts[sorted_e])
    n_blocks = -(-(A + N_EXPERTS * MOE_BLOCK) // MOE_BLOCK)
    P = n_blocks * MOE_BLOCK
    buf_tok = jnp.zeros((P,), jnp.int32).at[dest].set(tok_flat[order])
    buf_w = jnp.zeros((P,), f32).at[dest].set(w_flat[order])
    blk_e = jnp.minimum(jnp.searchsorted(pad_end, jnp.arange(n_blocks, dtype=jnp.int32) * MOE_BLOCK,
                                         side='right'), N_EXPERTS - 1).astype(jnp.int32)
    xb = xf[buf_tok].reshape(n_blocks, MOE_BLOCK, D)

    def expert_block(args):
        xblk, e = args
        hid = jax.nn.silu(xblk @ w_gate[e]) * (xblk @ w_up[e])
        return hid @ w_down[e]

    yb = lax.map(expert_block, (xb, blk_e)).reshape(P, D)
    out = jnp.zeros((N, D), f32).at[buf_tok].add(yb.astype(f32) * buf_w[:, None])
    return out.reshape(B, S, D).astype(h.dtype)


def setup_inputs(seed: int = 0) -> dict:
    key = jax.random.key(seed)
    ks = iter(jax.random.split(key, 40))
    L, D = DEPTH, D_MODEL

    def nrm(shape, scale):
        return scale * jax.random.normal(next(ks), shape, jnp.float32)

    return {
        'x': nrm((BATCH, SEQ, D), 1.0),
        'c': nrm((BATCH, D), 1.0),
        'ada_w': nrm((L, D, 6 * D), 0.5 * D ** -0.5),
        'ada_b': nrm((L, 6 * D), 0.01),
        'norm1_g': 1.0 + nrm((L, D), 0.02),
        'w_in': nrm((L, D, IN_COLS), D ** -0.5),
        'hg_lb': nrm((L + 1, HG_FDIM), 0.5),
        'hg_norm_g': 1.0 + nrm((L, HG_WIDTH), 0.02),
        'rw_mu': jax.random.uniform(next(ks), (L, RW_SHIFT_COLS), jnp.float32),
        'rw_w0': jnp.linspace(-6.0, -1.0, RW_WIDTH, dtype=jnp.float32) + nrm((L, RW_WIDTH), 0.1),
        'rw_w2': nrm((L, RW_DECAY_LORA, RW_WIDTH), 0.1 * RW_DECAY_LORA ** -0.5),
        'rw_a0': nrm((L, RW_WIDTH), 0.1),
        'rw_a2': nrm((L, RW_AAA_LORA, RW_WIDTH), RW_AAA_LORA ** -0.5),
        'rw_g2': nrm((L, RW_GATE_LORA, RW_WIDTH), RW_GATE_LORA ** -0.5),
        'rw_kk': 0.85 + nrm((L, RW_WIDTH), 0.02),
        'rw_ka': 1.0 + nrm((L, RW_WIDTH), 0.02),
        'rw_rk': -0.04 + nrm((L, RW_HEADS, RW_HEAD), 0.02),
        'rw_gn_w': 1.0 + nrm((L, RW_WIDTH), 0.02),
        'rw_gn_b': nrm((L, RW_WIDTH), 0.01),
        'w_proj_a': nrm((L, HG_WIDTH, D), HG_WIDTH ** -0.5),
        'w_proj_b': nrm((L, RW_WIDTH, D), RW_WIDTH ** -0.5),
        'w_out': nrm((L, D, D), D ** -0.5),
        'norm2_g': 1.0 + nrm((L, D), 0.02),
        'router_g_w': nrm((L, D, N_GROUPS), D ** -0.5),
        'router_g_b': nrm((L, N_GROUPS), 0.01),
        'router_e_w': nrm((L, D, N_EXPERTS), D ** -0.5),
        'router_e_b': nrm((L, N_EXPERTS), 0.01),
        'exp_w_gate': nrm((L, N_EXPERTS, D, D_FF_EXPERT), D ** -0.5),
        'exp_w_up': nrm((L, N_EXPERTS, D, D_FF_EXPERT), D ** -0.5),
        'exp_w_down': nrm((L, N_EXPERTS, D_FF_EXPERT, D), D_FF_EXPERT ** -0.5),
        'final_g': 1.0 + nrm((D,), 0.02),
    }


def reference(x, c, ada_w, ada_b, norm1_g, w_in, hg_lb, hg_norm_g, rw_mu, rw_w0, rw_w2, rw_a0, rw_a2,
              rw_g2, rw_kk, rw_ka, rw_rk, rw_gn_w, rw_gn_b, w_proj_a, w_proj_b, w_out, norm2_g,
              router_g_w, router_g_b, router_e_w, router_e_b, exp_w_gate, exp_w_up, exp_w_down, final_g):
    lb_all = jnp.cumsum(jax.nn.softmax(hg_lb.astype(jnp.float32), axis=0), axis=0)
    cs = jax.nn.silu(c)
    for l in range(DEPTH):
        mod = cs @ ada_w[l] + ada_b[l]
        sh1, sc1, gt1, sh2, sc2, gt2 = jnp.split(mod[:, None, :], 6, axis=-1)
        h = rmsnorm(x, norm1_g[l]) * (1.0 + sc1) + sh1
        proj = h @ w_in[l]
        hq, hf, hi, hg, rw_p, gates = jnp.split(proj, IN_SPLITS, axis=-1)
        o_a = hgrn2_mixer(hq, hf, hi, hg, lb_all[l], hg_norm_g[l])
        o_b = rwkv7_mixer(rw_p, rw_mu[l], rw_w0[l], rw_w2[l], rw_a0[l], rw_a2[l], rw_g2[l],
                          rw_kk[l], rw_ka[l], rw_rk[l], rw_gn_w[l], rw_gn_b[l])
        gate_a, gate_b = jnp.split(jax.nn.sigmoid(gates), 2, axis=-1)
        mixed = gate_a * (o_a @ w_proj_a[l]) + gate_b * (o_b @ w_proj_b[l])
        x = x + gt1 * (mixed @ w_out[l])
        h2 = rmsnorm(x, norm2_g[l]) * (1.0 + sc2) + sh2
        x = x + gt2 * hier_moe(h2, router_g_w[l], router_g_b[l], router_e_w[l], router_e_b[l],
                               exp_w_gate[l], exp_w_up[l], exp_w_down[l])
    return rmsnorm(x, final_g)
```

```cpp
#define MK_ONE_LAUNCH 1
#include <hip/hip_runtime.h>
#include <stdint.h>
#include <stdio.h>

#ifndef MK_ONE_LAUNCH
#define MK_ONE_LAUNCH 0
#endif
#ifndef MK_LAST_PHASE
#define MK_LAST_PHASE 99
#endif

#define DI __device__ __forceinline__
#define LAS __attribute__((address_space(3)))
typedef unsigned short bf16;
typedef short bf16x8 __attribute__((ext_vector_type(8)));
typedef float f32x4 __attribute__((ext_vector_type(4)));
typedef float f32x2 __attribute__((ext_vector_type(2)));
typedef unsigned u32x4 __attribute__((ext_vector_type(4)));
typedef unsigned u32x2 __attribute__((ext_vector_type(2)));

constexpr int NTOK = 16384, DM = 1024, SEQ = 8192;
constexpr int LDP = 3840;
constexpr int NWIN = 5888;
constexpr int C_HQ = 0, C_HF = 512, C_HI = 1024, C_HG = 1536, C_RR = 2048, C_RK = 2560, C_RV = 3072, C_WD = 3584, C_AD = 3616, C_GD = 3648;
constexpr int MOE_PMAX = 40960;

constexpr size_t MiB = 1u << 20;
constexpr size_t WS_CTL = 0, CTL_ZERO_BYTES = 1 * MiB;
constexpr size_t WS_MOD = 1 * MiB;
constexpr size_t WS_SLOT = 1 * MiB + 64 * 1024;
constexpr size_t WS_WTS = WS_SLOT + 128 * 1024;
constexpr size_t WS_EID = WS_WTS + 128 * 1024;
constexpr size_t WS_POS = WS_EID + 128 * 1024;
constexpr size_t WS_BONUS = 2 * MiB;
constexpr size_t WS_HGC = 2 * MiB + 512 * 1024;
constexpr size_t WS_RGC = 3 * MiB;
constexpr size_t WS_WIN = 4 * MiB;
constexpr size_t WS_WPA = 16 * MiB, WS_WPB = 17 * MiB, WS_WOUT = 18 * MiB;
constexpr size_t WS_PROJ = 20 * MiB;
constexpr size_t WS_HS = 140 * MiB;
constexpr size_t WS_RM = 172 * MiB;
constexpr size_t WS_RS = 236 * MiB;
constexpr size_t WS_GATES = 140 * MiB;
constexpr size_t WS_MIXED = 204 * MiB;
constexpr size_t WS_EWGU = 20 * MiB;
constexpr size_t WS_EWD = 84 * MiB;
constexpr size_t WS_XG = 116 * MiB;
constexpr size_t WS_H2 = 196 * MiB;
constexpr size_t WS_HID = 196 * MiB;
constexpr size_t WS_END = 252 * MiB;
constexpr int CW_BAR = 4096, CW_ECNT = 16384;

constexpr int LDS_BYTES = 163840;
constexpr int LDS_MISC = 163840 - 256;

typedef __bf16 bf16x2_t __attribute__((ext_vector_type(2)));
DI unsigned cvt_pk(float lo, float hi) { bf16x2_t v = {(__bf16)lo, (__bf16)hi}; return __builtin_bit_cast(unsigned, v); }
DI bf16 f2bf(float x) { return (bf16)(cvt_pk(x, 0.f) & 0xffffu); }
DI float bf2f(bf16 b) { return __uint_as_float(((unsigned)b) << 16); }
DI float bflo(unsigned w) { return __uint_as_float(w << 16); }
DI float bfhi(unsigned w) { return __uint_as_float(w & 0xffff0000u); }
DI float sigmoidf_(float x) { return 1.0f / (1.0f + __expf(-x)); }
DI float siluf_(float x) { return x / (1.0f + __expf(-x)); }
DI float wave_sum(float v) {
#pragma unroll
    for (int o = 1; o < 64; o <<= 1) v += __shfl_xor(v, o);
    return v;
}
DI f32x4 mfma16(bf16x8 a, bf16x8 b, f32x4 c) { return __builtin_amdgcn_mfma_f32_16x16x32_bf16(a, b, c, 0, 0, 0); }
#define LDS_WAIT() asm volatile("s_waitcnt lgkmcnt(0)" ::: "memory")
#define VM_WAIT() asm volatile("s_waitcnt vmcnt(0)" ::: "memory")

template <int TP, int TQ, int KS>
DI void mm_ll(const LAS bf16* P, int ldp, const LAS bf16* Q, int ldq, f32x4 (&acc)[TP][TQ], int lane) {
    const int r = lane & 15, g = lane >> 4;
#pragma unroll
    for (int ks = 0; ks < KS; ++ks) {
        bf16x8 pf[TP], qf[TQ];
#pragma unroll
        for (int tp = 0; tp < TP; ++tp) pf[tp] = *(const LAS bf16x8*)(P + (tp * 16 + r) * ldp + ks * 32 + g * 8);
#pragma unroll
        for (int tq = 0; tq < TQ; ++tq) qf[tq] = *(const LAS bf16x8*)(Q + (tq * 16 + r) * ldq + ks * 32 + g * 8);
#pragma unroll
        for (int tp = 0; tp < TP; ++tp)
#pragma unroll
            for (int tq = 0; tq < TQ; ++tq) acc[tp][tq] = mfma16(pf[tp], qf[tq], acc[tp][tq]);
    }
}
template <int TP, int TQ, int KS>
DI void mm_gl(const bf16* P, int ldp, const LAS bf16* Q, int ldq, f32x4 (&acc)[TP][TQ], int lane) {
    const int r = lane & 15, g = lane >> 4;
#pragma unroll
    for (int ks = 0; ks < KS; ++ks) {
        bf16x8 pf[TP], qf[TQ];
#pragma unroll
        for (int tp = 0; tp < TP; ++tp) pf[tp] = *(const bf16x8*)(P + (size_t)(tp * 16 + r) * ldp + ks * 32 + g * 8);
#pragma unroll
        for (int tq = 0; tq < TQ; ++tq) qf[tq] = *(const LAS bf16x8*)(Q + (tq * 16 + r) * ldq + ks * 32 + g * 8);
#pragma unroll
        for (int tp = 0; tp < TP; ++tp)
#pragma unroll
            for (int tq = 0; tq < TQ; ++tq) acc[tp][tq] = mfma16(pf[tp], qf[tq], acc[tp][tq]);
    }
}
template <int TP, int TQ, int KS>
DI void mm_gg(const bf16* P, int ldp, const bf16* Q, int ldq, f32x4 (&acc)[TP][TQ], int lane) {
    const int r = lane & 15, g = lane >> 4;
#pragma unroll
    for (int ks = 0; ks < KS; ++ks) {
        bf16x8 pf[TP], qf[TQ];
#pragma unroll
        for (int tp = 0; tp < TP; ++tp) pf[tp] = *(const bf16x8*)(P + (size_t)(tp * 16 + r) * ldp + ks * 32 + g * 8);
#pragma unroll
        for (int tq = 0; tq < TQ; ++tq) qf[tq] = *(const bf16x8*)(Q + (size_t)(tq * 16 + r) * ldq + ks * 32 + g * 8);
#pragma unroll
        for (int tp = 0; tp < TP; ++tp)
#pragma unroll
            for (int tq = 0; tq < TQ; ++tq) acc[tp][tq] = mfma16(pf[tp], qf[tq], acc[tp][tq]);
    }
}
template <int A, int B> DI void zero_acc(f32x4 (&acc)[A][B]) {
#pragma unroll
    for (int a = 0; a < A; ++a)
#pragma unroll
        for (int b = 0; b < B; ++b) acc[a][b] = (f32x4){0.f, 0.f, 0.f, 0.f};
}
namespace pg8 {
#define PG8_LAS __attribute__((address_space(3)))
typedef unsigned short bf16_t;
typedef short bf16x8 __attribute__((ext_vector_type(8)));
typedef float f32x4 __attribute__((ext_vector_type(4)));
typedef unsigned u32x4 __attribute__((ext_vector_type(4)));
constexpr int BM = 256, BK = 64, HALF = 128, HTB = HALF * BK * 2  , STAGE_BYTES = 8 * HTB, NXCD = 8, WGM = 8;

__host__ __device__ __forceinline__ int lds_byte(int r, int c) { const int st = (r >> 4) * 2 + (c >> 5), rr = r & 15, cc = c & 31, ob = rr * 64 + cc * 2; return st * 1024 + (ob ^ (((ob >> 9) & 1) << 5)); }
__host__ __device__ __forceinline__ void stage_rc(int b, int& R, int& C) { const int st = b / 1024, sb = b % 1024, swz = sb ^ (((sb >> 9) & 1) << 5); R = (st >> 1) * 16 + swz / 64; C = (st & 1) * 32 + (swz % 64) / 2; }
__host__ __device__ __forceinline__ int perm32(int rho) { const int n = rho >> 4, i = rho & 15; return 8 * (i >> 2) + 4 * n + (i & 3); }

struct Unit { int pm, pn; };
struct Gemm { const bf16_t* A; const bf16_t* Bt; int M, N, K, lda; };

struct StaticOrder {
    int nM, nN, nwg, G, c;
    __host__ __device__ void init(int M, int N, int G_, int c_) { nM = M / BM; nN = N / BM; nwg = nM * nN; G = G_; c = c_; }
    __host__ __device__ bool next(int i, Unit& u) const {
        const long L = (long)i * G + c; if (L >= nwg) return false;
        int wgid = (int)L; { const int q = nwg / NXCD, r = nwg % NXCD, xcd = wgid % NXCD, off = wgid / NXCD; wgid = (xcd < r ? xcd * (q + 1) : r * (q + 1) + (xcd - r) * q) + off; }
        const int nig = WGM * nN, gid = wgid / nig, fm = gid * WGM, gsz = (nM - fm) < WGM ? (nM - fm) : WGM;
        u.pm = fm + ((wgid % nig) % gsz); u.pn = (wgid % nig) / gsz; return true;
    }
    __device__ __forceinline__ void a_ready(const Unit&) const {}
    __device__ __forceinline__ void done(const Unit&) const {}
};
struct CountedOrder : StaticOrder {
    const unsigned* ready; unsigned need; unsigned* tmo;
    __device__ __forceinline__ void a_ready(const Unit& u) const {
        if (threadIdx.x < 64) {
            const unsigned long long t0 = __builtin_amdgcn_s_memrealtime(); unsigned polls = 0;
            while ((unsigned)__builtin_amdgcn_readfirstlane(__hip_atomic_load(ready + 64 * u.pm, __ATOMIC_RELAXED, __HIP_MEMORY_SCOPE_AGENT)) < need) {
                if ((++polls & 255u) == 0u && __builtin_amdgcn_readfirstlane(__hip_atomic_load(tmo, __ATOMIC_RELAXED, __HIP_MEMORY_SCOPE_AGENT)) != 0u) break;
                if (__builtin_amdgcn_s_memrealtime() - t0 > 2000000ull) {
                    if (threadIdx.x == 0) { unsigned expect = 0u; __hip_atomic_compare_exchange_strong(tmo + 1, &expect, 0x600u | (unsigned)(u.pm & 0xff), __ATOMIC_RELAXED, __ATOMIC_RELAXED, __HIP_MEMORY_SCOPE_AGENT); __hip_atomic_store(tmo, 1u, __ATOMIC_RELAXED, __HIP_MEMORY_SCOPE_AGENT); }
                    break; }
                __builtin_amdgcn_s_sleep(2); }
            __builtin_amdgcn_fence(__ATOMIC_ACQUIRE, "agent");
            asm volatile("s_waitcnt vmcnt(0)" ::: "memory");
        }
#if !defined(BROKEN_HOOK_NO_BARRIER)
        asm volatile("" ::: "memory"); __builtin_amdgcn_s_barrier(); asm volatile("" ::: "memory");
#endif
    }
};

__device__ __forceinline__ unsigned cvt_pk_bf16(float lo, float hi) { return ::cvt_pk(lo, hi); }
typedef float f32x2 __attribute__((ext_vector_type(2)));
__device__ __forceinline__ f32x2 gelu_pk(f32x2 v) {
    const f32x2 av = __builtin_elementwise_abs(v), d = av * 0.2316418882f + 1.0f;
    f32x2 t; t.x = __builtin_amdgcn_rcpf(d.x); t.y = __builtin_amdgcn_rcpf(d.y);
    f32x2 q = t * 0.5307027145f + (-0.7265760135f); q = q * t + 0.7107068705f; q = q * t + (-0.142248368f); q = q * t + 0.127414796f; q = q * t;
    const f32x2 s = (v * v) * (-0.72134752044f);
    f32x2 e; e.x = __builtin_amdgcn_exp2f(s.x); e.y = __builtin_amdgcn_exp2f(s.y);
    const f32x2 m = v * (q * e), r = v - m;
    f32x2 o; o.x = v.x < 0.f ? m.x : r.x; o.y = v.y < 0.f ? m.y : r.y; return o;
}

struct EpiF32 {
    static constexpr bool PERM = false, AFTER_DRAIN = false;
    float* C; int ldc; const float* bias;
    __device__ __forceinline__ void operator()(const f32x4 (&acc)[2][2][4][2], const Unit& u, int wr, int wc, int fr, int fq) const {
        const int row0 = u.pm * BM + wr * 64 + fr, col0 = u.pn * BM + wc * 32 + 4 * fq;
        f32x4 bv[2][2];
#pragma unroll
        for (int bj = 0; bj < 2; ++bj)
#pragma unroll
            for (int n = 0; n < 2; ++n) bv[bj][n] = bias ? *(const f32x4*)(bias + col0 + bj * HALF + n * 16) : (f32x4){0.f, 0.f, 0.f, 0.f};
#pragma unroll
        for (int ai = 0; ai < 2; ++ai)
#pragma unroll
            for (int m = 0; m < 4; ++m) { float* rowp = C + (size_t)(row0 + ai * HALF + m * 16) * ldc + col0;
#pragma unroll
                for (int bj = 0; bj < 2; ++bj)
#pragma unroll
                    for (int n = 0; n < 2; ++n) *(f32x4*)(rowp + bj * HALF + n * 16) = acc[ai][bj][m][n] + bv[bj][n]; }
    }
};
template <int ACT  > struct EpiBf16 {
    static constexpr bool PERM = true, AFTER_DRAIN = false;
    bf16_t* O; int ldc; const float* bias; int split_cols; size_t split_stride;
    __device__ __forceinline__ void operator()(const f32x4 (&acc)[2][2][4][2], const Unit& u, int wr, int wc, int fr, int fq) const {
        const int row0 = u.pm * BM + wr * 64 + fr; int colt = u.pn * BM; bf16_t* base = O;
        if (split_cols) { const int t = colt / split_cols; base += (size_t)t * split_stride; colt -= t * split_cols; }
        const int col0 = colt + wc * 32 + 8 * fq, bcol0 = u.pn * BM + wc * 32 + 8 * fq;
        f32x4 bv[2][2];
#pragma unroll
        for (int bj = 0; bj < 2; ++bj)
#pragma unroll
            for (int n = 0; n < 2; ++n) bv[bj][n] = bias ? *(const f32x4*)(bias + bcol0 + bj * HALF + 4 * n) : (f32x4){0.f, 0.f, 0.f, 0.f};
#pragma unroll
        for (int ai = 0; ai < 2; ++ai)
#pragma unroll
            for (int m = 0; m < 4; ++m) { bf16_t* rowp = base + (size_t)(row0 + ai * HALF + m * 16) * ldc + col0;
#pragma unroll
                for (int bj = 0; bj < 2; ++bj) { f32x4 v0 = acc[ai][bj][m][0] + bv[bj][0], v1 = acc[ai][bj][m][1] + bv[bj][1];
                    if (ACT == 1) { f32x2 a = gelu_pk((f32x2){v0[0], v0[1]}), b = gelu_pk((f32x2){v0[2], v0[3]}), c = gelu_pk((f32x2){v1[0], v1[1]}), d = gelu_pk((f32x2){v1[2], v1[3]});
                        v0 = (f32x4){a.x, a.y, b.x, b.y}; v1 = (f32x4){c.x, c.y, d.x, d.y}; }
                    if (ACT == 2) {
#pragma unroll
                        for (int j = 0; j < 4; ++j) { v0[j] = 0.5f * v0[j] * (1.0f + erff(v0[j] * 0.70710678f)); v1[j] = 0.5f * v1[j] * (1.0f + erff(v1[j] * 0.70710678f)); } }
                    u32x4 w; w.x = cvt_pk_bf16(v0[0], v0[1]); w.y = cvt_pk_bf16(v0[2], v0[3]); w.z = cvt_pk_bf16(v1[0], v1[1]); w.w = cvt_pk_bf16(v1[2], v1[3]);
                    *(u32x4*)(rowp + bj * HALF) = w; } }
    }
};
template <class Epi, class Sched, bool STAMP = false>
__device__ __forceinline__ void gemm_phase(PG8_LAS unsigned char* lds, const Gemm g, const Sched& S, const Epi& E, unsigned long long* stamps) {
    const int tid = threadIdx.x, wid = __builtin_amdgcn_readfirstlane(tid >> 6), lane = tid & 63, wr = wid >> 2, wc = wid & 3, fr = lane & 15, fq = lane >> 4;
    const int K = g.K, nt = K / BK;
    int ts_lo = 0, ts_hi = 0, nts = 0; const unsigned long long rt_entry = STAMP ? (unsigned long long)wall_clock64() : 0ull;
#define PG8_STAMP() do { if (STAMP && wid == 0 && nts < 64) { const unsigned long long _c = (unsigned long long)clock64(); \
        ts_lo = (lane == nts) ? (int)(unsigned)_c : ts_lo; ts_hi = (lane == nts) ? (int)(unsigned)(_c >> 32) : ts_hi; ++nts; } } while (0)
    PG8_STAMP();
    unsigned voffA[2], voffB[2];
#pragma unroll
    for (int i = 0; i < 2; ++i) { int R, C; stage_rc(tid * 16 + i * 8192, R, C); const int Rb = Epi::PERM ? ((R & ~31) + perm32(R & 31)) : R;
        voffA[i] = (unsigned)(R * g.lda + C) * 2u; voffB[i] = (unsigned)(Rb * K + C) * 2u; }
    const size_t kstep = (size_t)(BK * 2);
    const size_t hstep = (size_t)HALF * K * 2;
    const size_t tstep = 2 * hstep; const size_t hstepA = (size_t)HALF * g.lda * 2, tstepA = 2 * hstepA;
    const unsigned ldsw = (unsigned)wid * 1024u;
    const int aoff = lds_byte(wr * 64 + fr, fq * 8), boff = lds_byte(wc * 32 + fr, fq * 8);
#define PG8_SA(b, h) (((b) * 2 + (h)) * HTB)
#define PG8_SB(b, h) ((4 + (b) * 2 + (h)) * HTB)
#define PG8_STAGE(bufoff, gbase, voff) do { _Pragma("unroll") for (int _i = 0; _i < 2; ++_i) \
        __builtin_amdgcn_global_load_lds((const unsigned*)((const char*)(gbase) + (voff)[_i]), (PG8_LAS unsigned*)(lds + (bufoff) + ldsw + _i * 8192), 16, 0, 0); } while (0)
#define PG8_LDA(dst, b, h) do { _Pragma("unroll") for (int m = 0; m < 4; ++m) _Pragma("unroll") for (int k = 0; k < 2; ++k) dst[m][k] = *(const PG8_LAS bf16x8*)(lds + PG8_SA(b, h) + aoff + m * 2048 + k * 1024); } while (0)
#define PG8_LDB(dst, b, h) do { _Pragma("unroll") for (int n = 0; n < 2; ++n) _Pragma("unroll") for (int k = 0; k < 2; ++k) dst[n][k] = *(const PG8_LAS bf16x8*)(lds + PG8_SB(b, h) + boff + n * 2048 + k * 1024); } while (0)
#define PG8_MMA(ai, bj, At, Bt) do { __builtin_amdgcn_s_setprio(1); _Pragma("unroll") for (int m = 0; m < 4; ++m) _Pragma("unroll") for (int n = 0; n < 2; ++n) _Pragma("unroll") for (int k = 0; k < 2; ++k) \
        acc[ai][bj][m][n] = __builtin_amdgcn_mfma_f32_16x16x32_bf16(Bt[n][k], At[m][k], acc[ai][bj][m][n], 0, 0, 0); __builtin_amdgcn_s_setprio(0); } while (0)
#define PG8_WAIT_V(n) asm volatile("s_waitcnt vmcnt(" #n ")" ::: "memory")
#define PG8_WAIT_L(n) asm volatile("s_waitcnt lgkmcnt(" #n ")" ::: "memory")
#define PG8_BAR __builtin_amdgcn_s_barrier()
#define PG8_SCHED __builtin_amdgcn_sched_barrier(0)
    Unit cur, nxt; int ui = 0;
    if (!S.next(0, cur)) return;
    f32x4 acc[2][2][4][2];
#pragma unroll
    for (int a = 0; a < 2; ++a)
#pragma unroll
        for (int b = 0; b < 2; ++b)
#pragma unroll
            for (int m = 0; m < 4; ++m)
#pragma unroll
                for (int n = 0; n < 2; ++n) acc[a][b][m][n] = (f32x4){0.f, 0.f, 0.f, 0.f};
    bf16x8 At[4][2], B0[2][2], B1[2][2];
    const char* cA = (const char*)g.A + (size_t)cur.pm * tstepA; const char* cB = (const char*)g.Bt + (size_t)cur.pn * tstep;
    S.a_ready(cur);
    PG8_STAGE(PG8_SB(0, 0), cB, voffB); PG8_STAGE(PG8_SA(0, 0), cA, voffA); PG8_STAGE(PG8_SB(0, 1), cB + hstep, voffB); PG8_STAGE(PG8_SA(0, 1), cA + hstepA, voffA);
    if (wr == 1) PG8_BAR;
    PG8_WAIT_V(4); PG8_BAR;
    PG8_STAGE(PG8_SB(1, 0), cB + kstep, voffB); PG8_STAGE(PG8_SA(1, 0), cA + kstep, voffA); PG8_STAGE(PG8_SB(1, 1), cB + hstep + kstep, voffB);
    PG8_WAIT_V(6); PG8_BAR;
    PG8_STAMP();
    for (;;) {
        const bool has_next = S.next(ui + 1, nxt);
        const char* nA = has_next ? (const char*)g.A + (size_t)nxt.pm * tstepA : cA; const char* nB = has_next ? (const char*)g.Bt + (size_t)nxt.pn * tstep : cB;
        for (int t = 0; t < nt; t += 2) {
            const bool last = (t == nt - 2);
            const char* a1 = cA + (size_t)(t + 1) * kstep;
            const char* a2 = last ? nA : cA + (size_t)(t + 2) * kstep; const char* b2 = last ? nB : cB + (size_t)(t + 2) * kstep;
            const char* a3 = a2 + kstep; const char* b3 = b2 + kstep;
            if (last && has_next) S.a_ready(nxt);
            PG8_LDB(B0, 0, 0); PG8_SCHED; PG8_LDA(At, 0, 0); PG8_STAGE(PG8_SA(1, 1), a1 + hstepA, voffA);
            PG8_WAIT_L(8); PG8_BAR; PG8_WAIT_L(0); PG8_MMA(0, 0, At, B0); PG8_BAR; PG8_SCHED;
            PG8_LDB(B1, 0, 1); PG8_STAGE(PG8_SB(0, 0), b2, voffB);
            PG8_BAR; PG8_WAIT_L(0); PG8_MMA(0, 1, At, B1); PG8_BAR;
            PG8_LDA(At, 0, 1); PG8_STAGE(PG8_SA(0, 0), a2, voffA);
            PG8_BAR; PG8_WAIT_L(0); PG8_MMA(1, 0, At, B0); PG8_BAR; PG8_SCHED;
            PG8_STAGE(PG8_SB(0, 1), b2 + hstep, voffB);
            PG8_WAIT_V(6); PG8_BAR; PG8_MMA(1, 1, At, B1); PG8_BAR;
            PG8_LDB(B0, 1, 0); PG8_SCHED; PG8_LDA(At, 1, 0); PG8_STAGE(PG8_SA(0, 1), a2 + hstepA, voffA);
            PG8_WAIT_L(8); PG8_BAR; PG8_WAIT_L(0); PG8_MMA(0, 0, At, B0); PG8_BAR; PG8_SCHED;
            PG8_LDB(B1, 1, 1); PG8_STAGE(PG8_SB(1, 0), b3, voffB);
            PG8_BAR; PG8_WAIT_L(0); PG8_MMA(0, 1, At, B1); PG8_BAR;
            PG8_LDA(At, 1, 1); PG8_STAGE(PG8_SA(1, 0), a3, voffA);
            PG8_BAR; PG8_WAIT_L(0); PG8_MMA(1, 0, At, B0); PG8_BAR; PG8_SCHED;
            PG8_STAGE(PG8_SB(1, 1), b3 + hstep, voffB);
            PG8_WAIT_V(6); PG8_BAR; PG8_MMA(1, 1, At, B1); PG8_BAR;
        }
        PG8_STAMP();
        if constexpr (!Epi::AFTER_DRAIN) { E(acc, cur, wr, wc, fr, fq); S.done(cur); }
        PG8_STAMP();
        if (!has_next) break;
#pragma unroll
        for (int a = 0; a < 2; ++a)
#pragma unroll
            for (int b = 0; b < 2; ++b)
#pragma unroll
                for (int m = 0; m < 4; ++m)
#pragma unroll
                    for (int n = 0; n < 2; ++n) acc[a][b][m][n] = (f32x4){0.f, 0.f, 0.f, 0.f};
        cur = nxt; cA = nA; cB = nB; ++ui;
    }
    PG8_WAIT_V(0);
    if (wr == 0) PG8_BAR;
    PG8_BAR;
    if constexpr (Epi::AFTER_DRAIN) { E.fused(acc, cur, wr, wc, fr, fq, lds, wid, lane); S.done(cur); }
    PG8_STAMP();
    if (STAMP && wid == 0) { stamps[lane] = lane < nts ? (((unsigned long long)(unsigned)ts_hi << 32) | (unsigned)ts_lo) : 0ull;
        if (lane == 62) stamps[62] = rt_entry; if (lane == 63) stamps[63] = (unsigned long long)wall_clock64(); }
#undef PG8_STAMP
#undef PG8_SA
#undef PG8_SB
#undef PG8_STAGE
#undef PG8_LDA
#undef PG8_LDB
#undef PG8_MMA
#undef PG8_WAIT_V
#undef PG8_WAIT_L
#undef PG8_BAR
#undef PG8_SCHED
}
}
#define XB_TMO      128
#define XB_XCNT(j)  (256  + 64 * (j))
#define XB_XSUB(j)  (1280 + 64 * (j))
#define XB_XGEN(j)  (2304 + 64 * (j))
#define XB_TOP      3328
#define XB_TOPGEN   3392
#define XCD_BAR_WORDS 3456
#define XB_SPIN_CAP (1u << 22)

__device__ __forceinline__ unsigned xb_ld(unsigned* p)              { return __hip_atomic_load(p, __ATOMIC_RELAXED, __HIP_MEMORY_SCOPE_AGENT); }
__device__ __forceinline__ unsigned xb_add(unsigned* p, unsigned v) { return __hip_atomic_fetch_add(p, v, __ATOMIC_RELAXED, __HIP_MEMORY_SCOPE_AGENT); }
__device__ __forceinline__ unsigned xb_xcc_id() { return (unsigned)__builtin_amdgcn_s_getreg((3 << 11) | 20) & 0xFu; }
#define XB_SPIN(cond, bar) do { unsigned _sp = 0; while (cond) { __builtin_amdgcn_s_sleep(1); \
    if ((++_sp & 255u) == 0u) { if (xb_ld(&(bar)[XB_TMO])) break; if (_sp > XB_SPIN_CAP) { atomicAdd(&(bar)[XB_TMO], 1u); break; } } } } while (0)

struct XcdBarrier {
    unsigned* bar; unsigned x;
    volatile LAS unsigned* st;
};

__device__ __forceinline__ XcdBarrier xcd_barrier_post(unsigned* bar, volatile LAS unsigned* st) {
    XcdBarrier b; b.bar = bar; b.x = xb_xcc_id(); b.st = st;
    if (threadIdx.x == 0) (void)xb_add(&bar[XB_XCNT(b.x)], 1u);
    return b;
}
__device__ __forceinline__ void xcd_barrier_complete(unsigned* bar, unsigned x, unsigned& nloc, unsigned& nx) {
    const unsigned G = gridDim.x * gridDim.y * gridDim.z;
    unsigned sum, cnt, mine, sp = 0u;
    for (;;) {
        sum = 0u; cnt = 0u; mine = 0u;
#pragma unroll
        for (unsigned j = 0; j < 16; ++j) { const unsigned c = xb_ld(&bar[XB_XCNT(j)]); sum += c; cnt += (c > 0u) ? 1u : 0u; mine = (j == x) ? c : mine; }
        if (sum == G) break;
        __builtin_amdgcn_s_sleep(1);
        if ((++sp & 255u) == 0u) { if (xb_ld(&bar[XB_TMO])) break; if (sp > XB_SPIN_CAP) { atomicAdd(&bar[XB_TMO], 1u); break; } }
    }
    nloc = mine > 0u ? mine : 1u; nx = cnt > 0u ? cnt : 1u;
}

__device__ __forceinline__ void xcd_barrier(const XcdBarrier& b) {
    asm volatile("s_waitcnt vmcnt(0)" ::: "memory");
    __syncthreads();
    if (threadIdx.x == 0) {
        unsigned* bar = b.bar;
        __builtin_amdgcn_s_waitcnt(0);
        unsigned nloc = b.st[0], nx = b.st[1];
        if (nloc == 0u) { xcd_barrier_complete(bar, b.x, nloc, nx); b.st[0] = nloc; b.st[1] = nx; }
        const unsigned old = xb_add(&bar[XB_XSUB(b.x)], 1u);
        const unsigned gen = old / nloc;
        if (old + 1u == (gen + 1u) * nloc) {
            __builtin_amdgcn_fence(__ATOMIC_RELEASE, "agent");
            asm volatile("s_waitcnt vmcnt(0)" ::: "memory");
            const unsigned og = xb_add(&bar[XB_TOP], 1u);
            const unsigned tg = og / nx;
            if (og + 1u == (tg + 1u) * nx) xb_add(&bar[XB_TOPGEN], 1u);
            else XB_SPIN(xb_ld(&bar[XB_TOPGEN]) == tg, bar);
            __builtin_amdgcn_fence(__ATOMIC_ACQUIRE, "agent");
            xb_add(&bar[XB_XGEN(b.x)], 1u);
            asm volatile("s_waitcnt vmcnt(0)" ::: "memory");
        } else {
            XB_SPIN(xb_ld(&bar[XB_XGEN(b.x)]) == gen, bar);
            __builtin_amdgcn_fence(__ATOMIC_ACQUIRE, "agent");
            asm volatile("s_waitcnt vmcnt(0)" ::: "memory");
        }
    }
    __syncthreads();
}


struct Args { const float* in[31]; float* out; unsigned char* ws; int ph_lo, ph_hi; };

struct Ctx {
    LAS unsigned char* lds;
    int tid, lane, wave, nblk, blk;
};

DI void transpose_item(const float* W, int ldw, int src_n0, int k0, bf16* dst, int ldd, bool zero, LAS float* scr, int lane) {
    if (!zero) {
#pragma unroll 8
        for (int i = 0; i < 32; ++i) { const int kk = 2 * i + (lane >> 5); scr[kk * 33 + (lane & 31)] = W[(size_t)(k0 + kk) * ldw + src_n0 + (lane & 31)]; }
    }
    LDS_WAIT(); asm volatile("" ::: "memory");
    const int c = lane & 7;
#pragma unroll
    for (int j = 0; j < 4; ++j) { const int n = (lane >> 3) + 8 * j; const LAS float* s = scr + (8 * c) * 33 + n;
        u32x4 o;
        if (zero) { o = (u32x4){0u, 0u, 0u, 0u}; }
        else { o.x = cvt_pk(s[0 * 33], s[1 * 33]); o.y = cvt_pk(s[2 * 33], s[3 * 33]); o.z = cvt_pk(s[4 * 33], s[5 * 33]); o.w = cvt_pk(s[6 * 33], s[7 * 33]); }
        *(u32x4*)(dst + (size_t)n * ldd + k0 + 8 * c) = o; }
    LDS_WAIT(); asm volatile("" ::: "memory");
}

DI void phase_prologue(const Ctx& X, const Args& a) {
    unsigned char* ws = a.ws;
    LAS float* scr = (LAS float*)(X.lds + X.wave * 16384);
    const int gw = X.blk * 8 + X.wave, NGW = X.nblk * 8;
    constexpr int I_IN = 16 * (NWIN / 32), I_PA = 8 * 32, I_PB = 8 * 32, I_OUT = 16 * 32;
    constexpr int NITEMS = I_IN + I_PA + I_PB + I_OUT;
    for (int it = gw; it < NITEMS; it += NGW) {
        int r = it;
        if (r < I_IN) { const int kb = r / (NWIN / 32), nb = r % (NWIN / 32); const int n0 = nb * 32;
            const bool zero = (n0 >= 3744 && n0 < 3840); const int src = n0 < 3744 ? n0 : n0 - 96;
            transpose_item(a.in[5], 5792, zero ? 0 : src, kb * 64, (bf16*)(ws + WS_WIN) + (size_t)n0 * 1024, 1024, zero, scr, X.lane); continue; }
        r -= I_IN;
        if (r < I_PA) { const int kb = r / 32, nb = r % 32; transpose_item(a.in[19], 1024, nb * 32, kb * 64, (bf16*)(ws + WS_WPA) + (size_t)(nb * 32) * 512, 512, false, scr, X.lane); continue; }
        r -= I_PA;
        if (r < I_PB) { const int kb = r / 32, nb = r % 32; transpose_item(a.in[20], 1024, nb * 32, kb * 64, (bf16*)(ws + WS_WPB) + (size_t)(nb * 32) * 512, 512, false, scr, X.lane); continue; }
        r -= I_PB;
        { const int kb = r / 32, nb = r % 32; transpose_item(a.in[21], 1024, nb * 32, kb * 64, (bf16*)(ws + WS_WOUT) + (size_t)(nb * 32) * 1024, 1024, false, scr, X.lane); }
    }
    __syncthreads();
    {
        LAS float* cs = (LAS float*)X.lds;
        LAS float* part = (LAS float*)(X.lds + 8192);
        for (int i = X.tid; i < 2048; i += 512) cs[i] = siluf_(a.in[1][i]);
        __syncthreads();
        const float* aw = a.in[2]; const float* ab = a.in[3]; float* mod = (float*)(ws + WS_MOD);
        for (int cb = X.blk; cb < 256; cb += X.nblk) {
            const int c = X.tid % 24, kg = X.tid / 24;
            float s0 = 0.f, s1 = 0.f;
            if (kg < 21) for (int k = kg; k < 1024; k += 21) { const float w = aw[(size_t)k * 6144 + cb * 24 + c]; s0 += cs[k] * w; s1 += cs[1024 + k] * w; }
            if (kg < 21) { part[(kg * 24 + c) * 2] = s0; part[(kg * 24 + c) * 2 + 1] = s1; }
            __syncthreads();
            if (X.tid < 48) { const int cc = X.tid >> 1, b = X.tid & 1; float s = 0.f;
                for (int q = 0; q < 21; ++q) s += part[(q * 24 + cc) * 2 + b];
                mod[b * 6144 + cb * 24 + cc] = s + ab[cb * 24 + cc]; }
            __syncthreads();
        }
    }
}

DI void phase_norm1(const Ctx& X, const Args& a) {
    const float* x = a.in[0]; const float* g1 = a.in[4]; const float* mod = (const float*)(a.ws + WS_MOD);
    bf16* h = (bf16*)a.out;
    const int gw = X.blk * 8 + X.wave, NGW = X.nblk * 8;
    for (int m = gw; m < NTOK; m += NGW) {
        const int b = m >> 13;
        const f32x4* xr = (const f32x4*)(x + (size_t)m * DM) + X.lane;
        f32x4 v[4]; float s = 0.f;
#pragma unroll
        for (int j = 0; j < 4; ++j) { v[j] = xr[64 * j]; s += (v[j].x * v[j].x + v[j].y * v[j].y) + (v[j].z * v[j].z + v[j].w * v[j].w); }
        const float rs = 1.0f / sqrtf(wave_sum(s) * (1.f / DM) + 1e-6f);
        u32x2* o = (u32x2*)(h + (size_t)m * DM) + X.lane;
#pragma unroll
        for (int j = 0; j < 4; ++j) { const int col = 4 * X.lane + 256 * j;
            const f32x4 g = *(const f32x4*)(g1 + col), sh = *(const f32x4*)(mod + b * 6144 + col), sc = *(const f32x4*)(mod + b * 6144 + 1024 + col);
            const f32x4 y = v[j] * rs * g * (1.0f + sc) + sh;
            u32x2 w; w.x = cvt_pk(y.x, y.y); w.y = cvt_pk(y.z, y.w); o[64 * j] = w; }
    }
}

constexpr int HG_CUMLD = 132;
DI float hg_lb_of(const float* hg_lb, int idx) { return 1.0f / (1.0f + __expf(hg_lb[512 + idx] - hg_lb[idx])); }

DI void hg_load_f(const Ctx& X, const bf16* proj, const float* hg_lb, int row0, int hh, LAS float* CUM, float (&f)[16]) {
    const int t = X.tid >> 3, cg = (X.tid & 7) * 16;
    const u32x4* src = (const u32x4*)(proj + (size_t)(row0 + t) * LDP + C_HF + hh * 128 + cg);
    const u32x4 r0 = src[0], r1 = src[1];
    const unsigned w[8] = {r0.x, r0.y, r0.z, r0.w, r1.x, r1.y, r1.z, r1.w};
#pragma unroll
    for (int e = 0; e < 8; ++e) {
        const float lb0 = hg_lb_of(hg_lb, hh * 128 + cg + 2 * e), lb1 = hg_lb_of(hg_lb, hh * 128 + cg + 2 * e + 1);
        f[2 * e] = lb0 + (1.0f - lb0) * sigmoidf_(bflo(w[e])); f[2 * e + 1] = lb1 + (1.0f - lb1) * sigmoidf_(bfhi(w[e]));
    }
#pragma unroll
    for (int e = 0; e < 16; e += 4) *(LAS f32x4*)(CUM + t * HG_CUMLD + cg + e) = (f32x4){__logf(f[e]), __logf(f[e + 1]), __logf(f[e + 2]), __logf(f[e + 3])};
}
DI void hg_scan(const Ctx& X, LAS float* CUM, LAS float* TOT) {
    const int k = X.tid & 127, seg = X.tid >> 7;
    float v[16]; float run = 0.f;
#pragma unroll
    for (int i = 0; i < 16; ++i) { run += CUM[(seg * 16 + i) * HG_CUMLD + k]; v[i] = run; }
    TOT[seg * 128 + k] = run;
    __syncthreads();
    float off = 0.f;
#pragma unroll
    for (int s = 0; s < 3; ++s) off += (s < seg) ? TOT[s * 128 + k] : 0.f;
#pragma unroll
    for (int i = 0; i < 16; ++i) CUM[(seg * 16 + i) * HG_CUMLD + k] = v[i] + off;
    __syncthreads();
}

DI void hg1_unit(const Ctx& X, const Args& a, int u) {
    const bf16* proj = (const bf16*)(a.ws + WS_PROJ);
    const int pair = u >> 7, c = u & 127, b = pair >> 2, hh = pair & 3, row0 = b * SEQ + c * 64;
    LAS float* CUM = (LAS float*)X.lds; LAS float* TOT = (LAS float*)(X.lds + 33792);
    LAS bf16* KDT = (LAS bf16*)(X.lds + 36864); LAS bf16* VT = (LAS bf16*)(X.lds + 55296);
    float f[16];
    hg_load_f(X, proj, a.in[6], row0, hh, CUM, f);
    __syncthreads();
    hg_scan(X, CUM, TOT);
    const int t = X.tid >> 3, cg = (X.tid & 7) * 16;
    if (X.tid < 128) ((float*)(a.ws + WS_HGC))[(size_t)u * 128 + X.tid] = __expf(CUM[63 * HG_CUMLD + X.tid]);
    {
        const u32x4* src = (const u32x4*)(proj + (size_t)(row0 + t) * LDP + C_HI + hh * 128 + cg);
        const u32x4 r0 = src[0], r1 = src[1];
        const unsigned w[8] = {r0.x, r0.y, r0.z, r0.w, r1.x, r1.y, r1.z, r1.w};
#pragma unroll
        for (int e = 0; e < 16; ++e) {
            const int k = cg + e;
            const float kd = (1.0f - f[e]) * __expf(CUM[63 * HG_CUMLD + k] - CUM[t * HG_CUMLD + k]);
            KDT[k * 72 + t] = f2bf(kd);
            VT[k * 72 + t] = (bf16)((e & 1) ? (w[e >> 1] >> 16) : (w[e >> 1] & 0xffffu));
        }
    }
    __syncthreads();
    {
        const int w = X.wave, v0 = 32 * (w >> 1), k0 = 64 * (w & 1), r = X.lane & 15, g = X.lane >> 4;
        f32x4 acc[4][2]; zero_acc(acc);
        mm_ll<4, 2, 2>(KDT + k0 * 72, 72, VT + v0 * 72, 72, acc, X.lane);
        bf16* dst = (bf16*)(a.ws + WS_HS) + (size_t)u * 16384;
#pragma unroll
        for (int tp = 0; tp < 4; ++tp)
#pragma unroll
            for (int tq = 0; tq < 2; ++tq) { u32x2 o; o.x = cvt_pk(acc[tp][tq][0], acc[tp][tq][1]); o.y = cvt_pk(acc[tp][tq][2], acc[tp][tq][3]);
                *(u32x2*)(dst + (v0 + 16 * tq + r) * 128 + k0 + 16 * tp + 4 * g) = o; }
    }
    __syncthreads();
}

DI void hg2_scan(const Ctx& X, const Args& a) {
    const float* gc = (const float*)(a.ws + WS_HGC);
    for (int it = X.blk * 512 + X.tid; it < 65536; it += X.nblk * 512) {
        const int pair = it >> 13, rem = it & 8191;
        const int kp = rem & 63;
        unsigned* base = (unsigned*)(a.ws + WS_HS) + (size_t)pair * 128 * 8192 + rem;
        const float* gb = gc + (size_t)pair * 128 * 128 + kp * 2;
        float s0 = 0.f, s1 = 0.f;
        for (int cb = 0; cb < 128; cb += 8) {
            unsigned uu[8]; f32x2 gg[8];
#pragma unroll
            for (int i = 0; i < 8; ++i) { uu[i] = base[(size_t)(cb + i) * 8192]; gg[i] = *(const f32x2*)(gb + (cb + i) * 128); }
#pragma unroll
            for (int i = 0; i < 8; ++i) { base[(size_t)(cb + i) * 8192] = cvt_pk(s0, s1); s0 = gg[i].x * s0 + bflo(uu[i]); s1 = gg[i].y * s1 + bfhi(uu[i]); }
        }
    }
}

DI void hg3_unit(const Ctx& X, const Args& a, int u) {
    bf16* proj = (bf16*)(a.ws + WS_PROJ);
    const int pair = u >> 7, c = u & 127, b = pair >> 2, hh = pair & 3, row0 = b * SEQ + c * 64;
    LAS float* CUM = (LAS float*)X.lds; LAS float* TOT = (LAS float*)(X.lds + 33792);
    LAS float* RED = (LAS float*)(X.lds + 36352);
    LAS bf16* QD = (LAS bf16*)(X.lds + 36864); LAS bf16* QT = (LAS bf16*)(X.lds + 54272); LAS bf16* KT = (LAS bf16*)(X.lds + 71680);
    LAS bf16* VT = (LAS bf16*)(X.lds + 89088); LAS bf16* PM = (LAS bf16*)(X.lds + 107520);
    float f[16];
    hg_load_f(X, proj, a.in[6], row0, hh, CUM, f);
    __syncthreads();
    hg_scan(X, CUM, TOT);
    {
        const int t = X.tid >> 3, cg = (X.tid & 7) * 16;
        const u32x4* sq = (const u32x4*)(proj + (size_t)(row0 + t) * LDP + C_HQ + hh * 128 + cg);
        const u32x4* sv = (const u32x4*)(proj + (size_t)(row0 + t) * LDP + C_HI + hh * 128 + cg);
        const u32x4 q0 = sq[0], q1 = sq[1], i0 = sv[0], i1 = sv[1];
        const unsigned qw[8] = {q0.x, q0.y, q0.z, q0.w, q1.x, q1.y, q1.z, q1.w};
        const unsigned iw[8] = {i0.x, i0.y, i0.z, i0.w, i1.x, i1.y, i1.z, i1.w};
        unsigned oqd[8], oqt[8], okt[8];
#pragma unroll
        for (int e = 0; e < 8; ++e) {
            float qd[2], qt[2], kt[2];
#pragma unroll
            for (int hb = 0; hb < 2; ++hb) {
                const int k = cg + 2 * e + hb;
                const float cum = CUM[t * HG_CUMLD + k], ref = CUM[31 * HG_CUMLD + k];
                const float qs = siluf_(hb ? bfhi(qw[e]) : bflo(qw[e]));
                qd[hb] = qs * __expf(cum); qt[hb] = qs * __expf(cum - ref); kt[hb] = (1.0f - f[2 * e + hb]) * __expf(ref - cum);
                VT[k * 72 + t] = (bf16)(hb ? (iw[e] >> 16) : (iw[e] & 0xffffu));
            }
            oqd[e] = cvt_pk(qd[0], qd[1]); oqt[e] = cvt_pk(qt[0], qt[1]); okt[e] = cvt_pk(kt[0], kt[1]);
        }
        *(LAS u32x4*)(QD + t * 136 + cg) = (u32x4){oqd[0], oqd[1], oqd[2], oqd[3]}; *(LAS u32x4*)(QD + t * 136 + cg + 8) = (u32x4){oqd[4], oqd[5], oqd[6], oqd[7]};
        *(LAS u32x4*)(QT + t * 136 + cg) = (u32x4){oqt[0], oqt[1], oqt[2], oqt[3]}; *(LAS u32x4*)(QT + t * 136 + cg + 8) = (u32x4){oqt[4], oqt[5], oqt[6], oqt[7]};
        *(LAS u32x4*)(KT + t * 136 + cg) = (u32x4){okt[0], okt[1], okt[2], okt[3]}; *(LAS u32x4*)(KT + t * 136 + cg + 8) = (u32x4){okt[4], okt[5], okt[6], okt[7]};
    }
    __syncthreads();
    const int w = X.wave, r = X.lane & 15, g = X.lane >> 4, tq0 = 16 * (w >> 1);
    {
        f32x4 acc[2][1]; zero_acc(acc);
        const int s0 = 32 * (w & 1);
        mm_ll<2, 1, 4>(KT + s0 * 136, 136, QT + tq0 * 136, 136, acc, X.lane);
        const int t = tq0 + r;
#pragma unroll
        for (int tp = 0; tp < 2; ++tp) { const int sb = s0 + 16 * tp + 4 * g; float v[4];
#pragma unroll
            for (int e = 0; e < 4; ++e) v[e] = (sb + e <= t) ? acc[tp][0][e] : 0.f;
            u32x2 o; o.x = cvt_pk(v[0], v[1]); o.y = cvt_pk(v[2], v[3]); *(LAS u32x2*)(PM + t * 72 + sb) = o; }
    }
    __syncthreads();
    {
        const int v0 = 64 * (w & 1), t = tq0 + r;
        f32x4 acc[4][1]; zero_acc(acc);
        mm_gl<4, 1, 4>((const bf16*)(a.ws + WS_HS) + (size_t)u * 16384 + (size_t)v0 * 128, 128, QD + tq0 * 136, 136, acc, X.lane);
        mm_ll<4, 1, 2>(VT + v0 * 72, 72, PM + tq0 * 72, 72, acc, X.lane);
        float ss = 0.f;
#pragma unroll
        for (int tp = 0; tp < 4; ++tp)
#pragma unroll
            for (int e = 0; e < 4; ++e) ss += acc[tp][0][e] * acc[tp][0][e];
        ss += __shfl_xor(ss, 16); ss += __shfl_xor(ss, 32);
        if (g == 0) RED[t * 2 + (w & 1)] = ss;
        __syncthreads();
        const float rs = 1.0f / sqrtf((RED[t * 2] + RED[t * 2 + 1]) * (1.0f / 128.0f) + 1e-6f);
        const float* ng = a.in[7];
#pragma unroll
        for (int tp = 0; tp < 4; ++tp) { const int v = v0 + 16 * tp + 4 * g;
            const u32x2 gw = *(const u32x2*)(proj + (size_t)(row0 + t) * LDP + C_HG + hh * 128 + v);
            const f32x4 n4 = *(const f32x4*)(ng + hh * 128 + v);
            const float o0 = acc[tp][0][0] * rs * n4.x * siluf_(bflo(gw.x)), o1 = acc[tp][0][1] * rs * n4.y * siluf_(bfhi(gw.x));
            const float o2 = acc[tp][0][2] * rs * n4.z * siluf_(bflo(gw.y)), o3 = acc[tp][0][3] * rs * n4.w * siluf_(bfhi(gw.y));
            u32x2 o; o.x = cvt_pk(o0, o1); o.y = cvt_pk(o2, o3);
            *(u32x2*)(proj + (size_t)(row0 + t) * LDP + C_HQ + hh * 128 + v) = o; }
    }
    __syncthreads();
}

constexpr int R_AT = 0, R_RT = 9216, R_BH = 18432, R_KH = 27648, R_BHT = 36864, R_KHT = 46080, R_VT = 55296, R_AAK = 64512, R_ARB = 73728, R_ARK = 82944,
              R_WT = 92160, R_U0T = 101376, R_XB = 110592, R_CUM = 144384, R_GC = 161792;
constexpr int R_LW = 64512, R_LA = 69632, R_W2T = 74752, R_A2T = 79872;
constexpr int R_TOT = 92160, R_RED = 94208;
constexpr int XBLD = 132, CUMLD = 68;

DI f32x4 rw_shift4(const bf16* proj, const float* mu, int row, int col, bool first) {
    const u32x2 cw = *(const u32x2*)(proj + (size_t)row * LDP + col);
    u32x2 pw = (u32x2){0u, 0u};
    if (!first) pw = *(const u32x2*)(proj + (size_t)(row - 1) * LDP + col);
    const f32x4 m = *(const f32x4*)(mu + (col - C_RR));
    const f32x4 c = (f32x4){bflo(cw.x), bfhi(cw.x), bflo(cw.y), bfhi(cw.y)}, p = (f32x4){bflo(pw.x), bfhi(pw.x), bflo(pw.y), bfhi(pw.y)};
    return c + m * (p - c);
}

DI void rw_subst_col(const LAS float* AAB, LAS float* XB, int cidx) {
    for (int bk = 0; bk < 4; ++bk) {
        const int t0 = 16 * bk;
        float acc[16];
#pragma unroll
        for (int i = 0; i < 16; ++i) acc[i] = XB[(t0 + i) * XBLD + cidx];
        for (int s = 0; s < t0; s += 4) {
            const float x0 = XB[(s + 0) * XBLD + cidx], x1 = XB[(s + 1) * XBLD + cidx], x2 = XB[(s + 2) * XBLD + cidx], x3 = XB[(s + 3) * XBLD + cidx];
#pragma unroll
            for (int i = 0; i < 16; ++i) { const f32x4 a4 = *(const LAS f32x4*)(AAB + (t0 + i) * CUMLD + s); acc[i] += (a4[0] * x0 + a4[1] * x1) + (a4[2] * x2 + a4[3] * x3); }
        }
#pragma unroll
        for (int i = 1; i < 16; ++i) {
#pragma unroll
            for (int s4 = 0; s4 < (i + 3) / 4; ++s4) { const f32x4 a4 = *(const LAS f32x4*)(AAB + (t0 + i) * CUMLD + t0 + 4 * s4);
#pragma unroll
                for (int e = 0; e < 4; ++e) if (4 * s4 + e < i) acc[i] += a4[e] * acc[4 * s4 + e]; }
        }
#pragma unroll
        for (int i = 0; i < 16; ++i) XB[(t0 + i) * XBLD + cidx] = acc[i];
    }
}

DI void rw1_unit(const Ctx& X, const Args& a, int u) {
    const bf16* proj = (const bf16*)(a.ws + WS_PROJ);
    const float* mu = a.in[8];
    const int pair = u >> 7, c = u & 127, b = pair >> 3, h = pair & 7, row0 = b * SEQ + c * 64;
    LAS unsigned char* L = X.lds;
    LAS bf16 *AT = (LAS bf16*)(L + R_AT), *RT = (LAS bf16*)(L + R_RT), *BH = (LAS bf16*)(L + R_BH), *KH = (LAS bf16*)(L + R_KH), *BHT = (LAS bf16*)(L + R_BHT), *KHT = (LAS bf16*)(L + R_KHT),
             *VT = (LAS bf16*)(L + R_VT), *AAK = (LAS bf16*)(L + R_AAK), *ARB = (LAS bf16*)(L + R_ARB), *ARK = (LAS bf16*)(L + R_ARK), *WT = (LAS bf16*)(L + R_WT), *U0T = (LAS bf16*)(L + R_U0T),
             *LW = (LAS bf16*)(L + R_LW), *LA = (LAS bf16*)(L + R_LA), *W2T = (LAS bf16*)(L + R_W2T), *A2T = (LAS bf16*)(L + R_A2T);
    LAS float *XB = (LAS float*)(L + R_XB), *CUM = (LAS float*)(L + R_CUM), *GC = (LAS float*)(L + R_GC), *TOT = (LAS float*)(L + R_TOT), *RED = (LAS float*)(L + R_RED);
    const int w = X.wave, r = X.lane & 15, g = X.lane >> 4;
    {
        const int t = X.tid >> 3, c8 = (X.tid & 7) * 8; const bool first = (c == 0 && t == 0);
        const f32x4 v0 = rw_shift4(proj, mu, row0 + t, C_WD + c8, first), v1 = rw_shift4(proj, mu, row0 + t, C_WD + c8 + 4, first);
        if (c8 < 32) { u32x4 o; o.x = cvt_pk(tanhf(v0.x), tanhf(v0.y)); o.y = cvt_pk(tanhf(v0.z), tanhf(v0.w)); o.z = cvt_pk(tanhf(v1.x), tanhf(v1.y)); o.w = cvt_pk(tanhf(v1.z), tanhf(v1.w));
            *(LAS u32x4*)(LW + t * 40 + c8) = o; }
        else { u32x4 o; o.x = cvt_pk(v0.x, v0.y); o.y = cvt_pk(v0.z, v0.w); o.z = cvt_pk(v1.x, v1.y); o.w = cvt_pk(v1.z, v1.w);
            *(LAS u32x4*)(LA + t * 40 + (c8 - 32)) = o; }
        const int m = X.tid >> 4, j4 = (X.tid & 15) * 4;
        const f32x4 w2 = *(const f32x4*)(a.in[10] + m * 512 + h * 64 + j4), a2 = *(const f32x4*)(a.in[12] + m * 512 + h * 64 + j4);
#pragma unroll
        for (int e = 0; e < 4; ++e) { W2T[(j4 + e) * 40 + m] = f2bf(w2[e]); A2T[(j4 + e) * 40 + m] = f2bf(a2[e]); }
    }
    __syncthreads();
    const int t = 16 * (w >> 1) + r, jb = 32 * (w & 1) + 4 * g;
    float rs_[8], kf_[8], vs_[8], kkv_[8], aa_[8], lw_[8];
    {
        f32x4 accw[2][1], acca[2][1]; zero_acc(accw); zero_acc(acca);
        mm_ll<2, 1, 1>(W2T + 32 * (w & 1) * 40, 40, LW + 16 * (w >> 1) * 40, 40, accw, X.lane);
        mm_ll<2, 1, 1>(A2T + 32 * (w & 1) * 40, 40, LA + 16 * (w >> 1) * 40, 40, acca, X.lane);
        const bool first = (c == 0 && t == 0);
        float ss = 0.f, bon = 0.f;
#pragma unroll
        for (int i = 0; i < 2; ++i) {
            const int j = jb + 16 * i, col = h * 64 + j;
            const f32x4 rr = rw_shift4(proj, mu, row0 + t, C_RR + col, first), kk = rw_shift4(proj, mu, row0 + t, C_RK + col, first), vv = rw_shift4(proj, mu, row0 + t, C_RV + col, first);
            const f32x4 w0 = *(const f32x4*)(a.in[9] + col), a0 = *(const f32x4*)(a.in[11] + col), k_k = *(const f32x4*)(a.in[14] + col), k_a = *(const f32x4*)(a.in[15] + col), r_k = *(const f32x4*)(a.in[16] + col);
            f32x4 lw4;
#pragma unroll
            for (int e = 0; e < 4; ++e) {
                const float y = -(w0[e] + accw[i][0][e]);
                const float sp = fmaxf(y, 0.f) + log1pf(__expf(-fabsf(y)));
                const float wlog = -sp - 0.5f;
                const float lw = -__expf(wlog);
                const float aa = sigmoidf_(a0[e] + acca[i][0][e]);
                const float kkv = kk[e] * k_k[e];
                const float kf = kk[e] * (1.0f + (aa - 1.0f) * k_a[e]);
                ss += kkv * kkv; bon += rr[e] * kf * r_k[e];
                rs_[4 * i + e] = rr[e]; kf_[4 * i + e] = kf; vs_[4 * i + e] = vv[e]; kkv_[4 * i + e] = kkv; aa_[4 * i + e] = aa; lw_[4 * i + e] = lw; lw4[e] = lw;
            }
            *(LAS f32x4*)(CUM + t * CUMLD + j) = lw4;
        }
        ss += __shfl_xor(ss, 16); ss += __shfl_xor(ss, 32); bon += __shfl_xor(bon, 16); bon += __shfl_xor(bon, 32);
        if (g == 0) { RED[(t * 2 + (w & 1)) * 2] = ss; RED[(t * 2 + (w & 1)) * 2 + 1] = bon; }
    }
    __syncthreads();
    {
        const int j = X.tid & 63, seg = X.tid >> 6; float v[8]; float run = 0.f;
#pragma unroll
        for (int i = 0; i < 8; ++i) { run += CUM[(seg * 8 + i) * CUMLD + j]; v[i] = run; }
        TOT[seg * 64 + j] = run;
        __syncthreads();
        float off = 0.f;
#pragma unroll
        for (int s = 0; s < 7; ++s) off += (s < seg) ? TOT[s * 64 + j] : 0.f;
#pragma unroll
        for (int i = 0; i < 8; ++i) CUM[(seg * 8 + i) * CUMLD + j] = v[i] + off;
        if (seg == 7) { const float gc = __expf(v[7] + off); GC[j] = gc; ((float*)(a.ws + WS_RGC))[(size_t)u * 64 + j] = gc; }
    }
    __syncthreads();
    {
        const float ssT = RED[(t * 2) * 2] + RED[(t * 2 + 1) * 2];
        const float inv = 1.0f / sqrtf(fmaxf(ssT, 1e-24f));
        if (g == 0 && (w & 1) == 0) ((float*)(a.ws + WS_BONUS))[(size_t)(row0 + t) * 8 + h] = RED[(t * 2) * 2 + 1] + RED[(t * 2 + 1) * 2 + 1];
#pragma unroll
        for (int i = 0; i < 2; ++i) {
            const int j = jb + 16 * i;
            const f32x4 cum = *(const LAS f32x4*)(CUM + t * CUMLD + j);
            float at[4], rt[4], bh[4], kh[4];
#pragma unroll
            for (int e = 0; e < 4; ++e) {
                const float kkn = kkv_[4 * i + e] * inv;
                const float eneg = __expf(-cum[e]);
                at[e] = -kkn * __expf(cum[e] - lw_[4 * i + e]); rt[e] = rs_[4 * i + e] * __expf(cum[e]);
                bh[e] = kkn * aa_[4 * i + e] * eneg; kh[e] = kf_[4 * i + e] * eneg;
                BHT[(j + e) * 72 + t] = f2bf(bh[e]); KHT[(j + e) * 72 + t] = f2bf(kh[e]); VT[(j + e) * 72 + t] = f2bf(vs_[4 * i + e]);
            }
            *(LAS u32x2*)(AT + t * 72 + j) = (u32x2){cvt_pk(at[0], at[1]), cvt_pk(at[2], at[3])};
            *(LAS u32x2*)(RT + t * 72 + j) = (u32x2){cvt_pk(rt[0], rt[1]), cvt_pk(rt[2], rt[3])};
            *(LAS u32x2*)(BH + t * 72 + j) = (u32x2){cvt_pk(bh[0], bh[1]), cvt_pk(bh[2], bh[3])};
            *(LAS u32x2*)(KH + t * 72 + j) = (u32x2){cvt_pk(kh[0], kh[1]), cvt_pk(kh[2], kh[3])};
            *(LAS f32x4*)(XB + t * XBLD + j) = (f32x4){at[0], at[1], at[2], at[3]};
        }
    }
    __syncthreads();
    {
        LAS float* AAB = CUM;
        const int tq0 = 16 * (w >> 1), s0 = 32 * (w & 1);
        f32x4 ab[2][1], ak[2][1], rb[2][1], rk[2][1]; zero_acc(ab); zero_acc(ak); zero_acc(rb); zero_acc(rk);
        mm_ll<2, 1, 2>(BH + s0 * 72, 72, AT + tq0 * 72, 72, ab, X.lane);
        mm_ll<2, 1, 2>(KH + s0 * 72, 72, AT + tq0 * 72, 72, ak, X.lane);
        mm_ll<2, 1, 2>(BH + s0 * 72, 72, RT + tq0 * 72, 72, rb, X.lane);
        mm_ll<2, 1, 2>(KH + s0 * 72, 72, RT + tq0 * 72, 72, rk, X.lane);
#pragma unroll
        for (int tp = 0; tp < 2; ++tp) { const int sb = s0 + 16 * tp + 4 * g; f32x4 vab; float vak[4], vrb[4], vrk[4];
#pragma unroll
            for (int e = 0; e < 4; ++e) { const bool lo = (sb + e < t), le = (sb + e <= t);
                vab[e] = lo ? ab[tp][0][e] : 0.f; vak[e] = lo ? ak[tp][0][e] : 0.f; vrb[e] = le ? rb[tp][0][e] : 0.f; vrk[e] = le ? rk[tp][0][e] : 0.f; }
            *(LAS f32x4*)(AAB + t * CUMLD + sb) = vab;
            *(LAS u32x2*)(AAK + t * 72 + sb) = (u32x2){cvt_pk(vak[0], vak[1]), cvt_pk(vak[2], vak[3])};
            *(LAS u32x2*)(ARB + t * 72 + sb) = (u32x2){cvt_pk(vrb[0], vrb[1]), cvt_pk(vrb[2], vrb[3])};
            *(LAS u32x2*)(ARK + t * 72 + sb) = (u32x2){cvt_pk(vrk[0], vrk[1]), cvt_pk(vrk[2], vrk[3])}; }
    }
    __syncthreads();
    {
        const int tq0 = 16 * (w >> 1), i0 = 32 * (w & 1);
        f32x4 acc[2][1]; zero_acc(acc);
        mm_ll<2, 1, 2>(VT + i0 * 72, 72, AAK + tq0 * 72, 72, acc, X.lane);
#pragma unroll
        for (int tp = 0; tp < 2; ++tp) *(LAS f32x4*)(XB + t * XBLD + 64 + i0 + 16 * tp + 4 * g) = acc[tp][0];
    }
    __syncthreads();
    if (w < 2) {
        const int cidx = w * 64 + X.lane;
        rw_subst_col(CUM, XB, cidx);
        LAS bf16* dst = (w == 0 ? WT : U0T) + X.lane * 72;
#pragma unroll
        for (int q = 0; q < 8; ++q) { float x[8];
#pragma unroll
            for (int e = 0; e < 8; ++e) x[e] = XB[(8 * q + e) * XBLD + cidx];
            *(LAS u32x4*)(dst + 8 * q) = (u32x4){cvt_pk(x[0], x[1]), cvt_pk(x[2], x[3]), cvt_pk(x[4], x[5]), cvt_pk(x[6], x[7])}; }
    }
    __syncthreads();
    {
        bf16* out = (bf16*)(a.ws + WS_RM) + (size_t)u * 16384;
        const int q0 = 16 * (w >> 1), p0 = 32 * (w & 1), qq = q0 + r;
        f32x4 accG[2][1], accY[2][1], accM[2][1], accN[2][1]; zero_acc(accG); zero_acc(accY); zero_acc(accM); zero_acc(accN);
        mm_ll<2, 1, 2>(WT + p0 * 72, 72, ARB + q0 * 72, 72, accG, X.lane);
        mm_ll<2, 1, 2>(U0T + p0 * 72, 72, ARB + q0 * 72, 72, accY, X.lane);
        mm_ll<2, 1, 2>(VT + p0 * 72, 72, ARK + q0 * 72, 72, accY, X.lane);
        mm_ll<2, 1, 2>(WT + p0 * 72, 72, BHT + q0 * 72, 72, accM, X.lane);
        mm_ll<2, 1, 2>(BHT + p0 * 72, 72, U0T + q0 * 72, 72, accN, X.lane);
        mm_ll<2, 1, 2>(KHT + p0 * 72, 72, VT + q0 * 72, 72, accN, X.lane);
        const float gq = GC[qq];
#pragma unroll
        for (int tp = 0; tp < 2; ++tp) { const int pp = p0 + 16 * tp + 4 * g;
            const u32x2 rtw = *(const LAS u32x2*)(RT + qq * 72 + pp);
            const f32x4 gp = *(const LAS f32x4*)(GC + pp);
            const f32x4 G4 = accG[tp][0] + (f32x4){bflo(rtw.x), bfhi(rtw.x), bflo(rtw.y), bfhi(rtw.y)};
            const f32x4 M4 = accM[tp][0] * gq, N4 = accN[tp][0] * gp;
            *(u32x2*)(out + 0 * 4096 + qq * 64 + pp) = (u32x2){cvt_pk(M4[0], M4[1]), cvt_pk(M4[2], M4[3])};
            *(u32x2*)(out + 1 * 4096 + qq * 64 + pp) = (u32x2){cvt_pk(N4[0], N4[1]), cvt_pk(N4[2], N4[3])};
            *(u32x2*)(out + 2 * 4096 + qq * 64 + pp) = (u32x2){cvt_pk(G4[0], G4[1]), cvt_pk(G4[2], G4[3])};
            *(u32x2*)(out + 3 * 4096 + qq * 64 + pp) = (u32x2){cvt_pk(accY[tp][0][0], accY[tp][0][1]), cvt_pk(accY[tp][0][2], accY[tp][0][3])}; }
    }
    __syncthreads();
}

DI void rw2_chain(const Ctx& X, const Args& a, int ch) {
    const int pair = ch >> 2, i0 = 16 * (ch & 3), r = X.lane & 15, g = X.lane >> 4, i = i0 + r;
    const bf16* RM = (const bf16*)(a.ws + WS_RM); bf16* RS = (bf16*)(a.ws + WS_RS); const float* RGC = (const float*)(a.ws + WS_RGC);
    f32x4 acc[4];
#pragma unroll
    for (int pt = 0; pt < 4; ++pt) acc[pt] = (f32x4){0.f, 0.f, 0.f, 0.f};
    u32x2 mlo[4][2], mhi[4][2], nn[4]; f32x4 gcv[4];
    auto load = [&](int c) {
        const size_t u = (size_t)pair * 128 + c; const bf16* M = RM + u * 16384; const bf16* NT = M + 4096;
#pragma unroll
        for (int pt = 0; pt < 4; ++pt) {
#pragma unroll
            for (int ks = 0; ks < 2; ++ks) { mlo[pt][ks] = *(const u32x2*)(M + (16 * pt + r) * 64 + 32 * ks + 4 * g); mhi[pt][ks] = *(const u32x2*)(M + (16 * pt + r) * 64 + 32 * ks + 16 + 4 * g); }
            nn[pt] = *(const u32x2*)(NT + i * 64 + 16 * pt + 4 * g);
            gcv[pt] = *(const f32x4*)(RGC + u * 64 + 16 * pt + 4 * g);
        }
    };
    load(0);
    for (int c = 0; c < 128; ++c) {
        const size_t u = (size_t)pair * 128 + c;
        bf16x8 mf[4][2]; f32x4 nw[4];
#pragma unroll
        for (int pt = 0; pt < 4; ++pt) {
#pragma unroll
            for (int ks = 0; ks < 2; ++ks) mf[pt][ks] = __builtin_bit_cast(bf16x8, (u32x4){mlo[pt][ks].x, mlo[pt][ks].y, mhi[pt][ks].x, mhi[pt][ks].y});
            nw[pt] = (f32x4){bflo(nn[pt].x), bfhi(nn[pt].x), bflo(nn[pt].y), bfhi(nn[pt].y)} + gcv[pt] * acc[pt];
        }
        if (c + 1 < 128) load(c + 1);
        unsigned pk[4][2];
#pragma unroll
        for (int pt = 0; pt < 4; ++pt) { pk[pt][0] = cvt_pk(acc[pt][0], acc[pt][1]); pk[pt][1] = cvt_pk(acc[pt][2], acc[pt][3]);
            *(u32x2*)(RS + u * 4096 + i * 64 + 16 * pt + 4 * g) = (u32x2){pk[pt][0], pk[pt][1]}; }
        const bf16x8 sf0 = __builtin_bit_cast(bf16x8, (u32x4){pk[0][0], pk[0][1], pk[1][0], pk[1][1]});
        const bf16x8 sf1 = __builtin_bit_cast(bf16x8, (u32x4){pk[2][0], pk[2][1], pk[3][0], pk[3][1]});
#pragma unroll
        for (int pt = 0; pt < 4; ++pt) { nw[pt] = mfma16(mf[pt][0], sf0, nw[pt]); nw[pt] = mfma16(mf[pt][1], sf1, nw[pt]); acc[pt] = nw[pt]; }
    }
}

DI void rw3_unit(const Ctx& X, const Args& a, int u) {
    bf16* proj = (bf16*)(a.ws + WS_PROJ);
    const float* mu = a.in[8];
    const int pair = u >> 7, c = u & 127, b = pair >> 3, h = pair & 7, row0 = b * SEQ + c * 64;
    LAS bf16* SG = (LAS bf16*)X.lds;
    LAS bf16* G2T = (LAS bf16*)(X.lds + 13312);
    LAS float* RED = (LAS float*)(X.lds + 26624);
    const int w = X.wave, r = X.lane & 15, g = X.lane >> 4;
    for (int idx = X.tid; idx < 64 * 24; idx += 512) {
        const int t = idx / 24, c4 = (idx % 24) * 4; const bool first = (c == 0 && t == 0);
        const f32x4 v = rw_shift4(proj, mu, row0 + t, C_GD + c4, first);
        *(LAS u32x2*)(SG + t * 104 + c4) = (u32x2){cvt_pk(sigmoidf_(v.x), sigmoidf_(v.y)), cvt_pk(sigmoidf_(v.z), sigmoidf_(v.w))};
    }
    for (int idx = X.tid; idx < 96 * 16; idx += 512) {
        const int m = idx >> 4, j4 = (idx & 15) * 4;
        const f32x4 g2 = *(const f32x4*)(a.in[13] + m * 512 + h * 64 + j4);
#pragma unroll
        for (int e = 0; e < 4; ++e) G2T[(j4 + e) * 104 + m] = f2bf(g2[e]);
    }
    __syncthreads();
    const int t = 16 * (w >> 1) + r, i0 = 32 * (w & 1);
    const bf16* RMu = (const bf16*)(a.ws + WS_RM) + (size_t)u * 16384;
    f32x4 acc[2][1], gg[2][1]; zero_acc(acc); zero_acc(gg);
    mm_gg<2, 1, 2>((const bf16*)(a.ws + WS_RS) + (size_t)u * 4096 + (size_t)i0 * 64, 64, RMu + 2 * 4096 + 16 * (w >> 1) * 64, 64, acc, X.lane);
    mm_ll<2, 1, 3>(G2T + i0 * 104, 104, SG + 16 * (w >> 1) * 104, 104, gg, X.lane);
    float s = 0.f;
#pragma unroll
    for (int tp = 0; tp < 2; ++tp) { const u32x2 y0 = *(const u32x2*)(RMu + 3 * 4096 + t * 64 + i0 + 16 * tp + 4 * g);
        acc[tp][0] += (f32x4){bflo(y0.x), bfhi(y0.x), bflo(y0.y), bfhi(y0.y)};
        s += (acc[tp][0][0] + acc[tp][0][1]) + (acc[tp][0][2] + acc[tp][0][3]); }
    s += __shfl_xor(s, 16); s += __shfl_xor(s, 32);
    if (g == 0) RED[(t * 2 + (w & 1)) * 2] = s;
    __syncthreads();
    const float mean = (RED[(t * 2) * 2] + RED[(t * 2 + 1) * 2]) * (1.0f / 64.0f);
    float q = 0.f;
#pragma unroll
    for (int tp = 0; tp < 2; ++tp)
#pragma unroll
        for (int e = 0; e < 4; ++e) { const float d = acc[tp][0][e] - mean; q += d * d; }
    q += __shfl_xor(q, 16); q += __shfl_xor(q, 32);
    if (g == 0) RED[(t * 2 + (w & 1)) * 2 + 1] = q;
    __syncthreads();
    const float rstd = 1.0f / sqrtf((RED[(t * 2) * 2 + 1] + RED[(t * 2 + 1) * 2 + 1]) * (1.0f / 64.0f) + 64e-5f);
    const float bonus = ((const float*)(a.ws + WS_BONUS))[(size_t)(row0 + t) * 8 + h];
    const bool first = (c == 0 && t == 0);
#pragma unroll
    for (int tp = 0; tp < 2; ++tp) { const int i = i0 + 16 * tp + 4 * g, col = h * 64 + i;
        const f32x4 vv = rw_shift4(proj, mu, row0 + t, C_RV + col, first);
        const f32x4 gw = *(const f32x4*)(a.in[17] + col), gb = *(const f32x4*)(a.in[18] + col);
        f32x4 o;
#pragma unroll
        for (int e = 0; e < 4; ++e) o[e] = ((acc[tp][0][e] - mean) * rstd * gw[e] + gb[e] + bonus * vv[e]) * gg[tp][0][e];
        *(u32x2*)(proj + (size_t)(row0 + t) * LDP + C_RR + col) = (u32x2){cvt_pk(o[0], o[1]), cvt_pk(o[2], o[3])}; }
    __syncthreads();
}

namespace epi {
using pg8::Unit; using pg8::BM; using pg8::HALF;
struct SigmoidBf16 {
    static constexpr bool PERM = true, AFTER_DRAIN = false;
    bf16* O; int ldc;
    DI void operator()(const f32x4 (&acc)[2][2][4][2], const Unit& u, int wr, int wc, int fr, int fq) const {
        const int row0 = u.pm * BM + wr * 64 + fr, col0 = u.pn * BM + wc * 32 + 8 * fq;
#pragma unroll
        for (int ai = 0; ai < 2; ++ai)
#pragma unroll
            for (int m = 0; m < 4; ++m) { bf16* rowp = O + (size_t)(row0 + ai * HALF + m * 16) * ldc + col0;
#pragma unroll
                for (int bj = 0; bj < 2; ++bj) { const f32x4 v0 = acc[ai][bj][m][0], v1 = acc[ai][bj][m][1];
                    u32x4 w; w.x = cvt_pk(sigmoidf_(v0[0]), sigmoidf_(v0[1])); w.y = cvt_pk(sigmoidf_(v0[2]), sigmoidf_(v0[3])); w.z = cvt_pk(sigmoidf_(v1[0]), sigmoidf_(v1[1])); w.w = cvt_pk(sigmoidf_(v1[2]), sigmoidf_(v1[3]));
                    *(u32x4*)(rowp + bj * HALF) = w; } }
    }
};
template <bool ADD> struct GateMix {
    static constexpr bool PERM = true, AFTER_DRAIN = false;
    bf16* O; int ldc; const bf16* gate; int ldg;
    DI void operator()(const f32x4 (&acc)[2][2][4][2], const Unit& u, int wr, int wc, int fr, int fq) const {
        const int row0 = u.pm * BM + wr * 64 + fr, col0 = u.pn * BM + wc * 32 + 8 * fq;
#pragma unroll
        for (int ai = 0; ai < 2; ++ai)
#pragma unroll
            for (int m = 0; m < 4; ++m) { const size_t row = (size_t)(row0 + ai * HALF + m * 16);
#pragma unroll
                for (int bj = 0; bj < 2; ++bj) { const f32x4 v0 = acc[ai][bj][m][0], v1 = acc[ai][bj][m][1];
                    const u32x4 gw = *(const u32x4*)(gate + row * ldg + col0 + bj * HALF);
                    float o[8] = {v0[0] * bflo(gw.x), v0[1] * bfhi(gw.x), v0[2] * bflo(gw.y), v0[3] * bfhi(gw.y), v1[0] * bflo(gw.z), v1[1] * bfhi(gw.z), v1[2] * bflo(gw.w), v1[3] * bfhi(gw.w)};
                    bf16* op = O + row * ldc + col0 + bj * HALF;
                    if (ADD) { const u32x4 pw = *(const u32x4*)op;
                        o[0] += bflo(pw.x); o[1] += bfhi(pw.x); o[2] += bflo(pw.y); o[3] += bfhi(pw.y); o[4] += bflo(pw.z); o[5] += bfhi(pw.z); o[6] += bflo(pw.w); o[7] += bfhi(pw.w); }
                    *(u32x4*)op = (u32x4){cvt_pk(o[0], o[1]), cvt_pk(o[2], o[3]), cvt_pk(o[4], o[5]), cvt_pk(o[6], o[7])}; } }
    }
};
struct Resid {
    static constexpr bool PERM = false, AFTER_DRAIN = false;
    const float* base; float* C; const float* gt;
    DI void operator()(const f32x4 (&acc)[2][2][4][2], const Unit& u, int wr, int wc, int fr, int fq) const {
        const int row0 = u.pm * BM + wr * 64 + fr, col0 = u.pn * BM + wc * 32 + 4 * fq;
        const int b = (u.pm * BM) >> 13;
        f32x4 gv[2][2];
#pragma unroll
        for (int bj = 0; bj < 2; ++bj)
#pragma unroll
            for (int n = 0; n < 2; ++n) gv[bj][n] = *(const f32x4*)(gt + b * 6144 + col0 + bj * HALF + n * 16);
#pragma unroll
        for (int ai = 0; ai < 2; ++ai)
#pragma unroll
            for (int m = 0; m < 4; ++m) { const size_t off = (size_t)(row0 + ai * HALF + m * 16) * DM + col0;
#pragma unroll
                for (int bj = 0; bj < 2; ++bj)
#pragma unroll
                    for (int n = 0; n < 2; ++n) { const f32x4 bs = *(const f32x4*)(base + off + bj * HALF + n * 16);
                        *(f32x4*)(C + off + bj * HALF + n * 16) = bs + gv[bj][n] * acc[ai][bj][m][n]; } }
    }
};
struct SwiGlu {
    static constexpr bool PERM = true, AFTER_DRAIN = false;
    bf16* O;
    DI void operator()(const f32x4 (&acc)[2][2][4][2], const Unit& u, int wr, int wc, int fr, int fq) const {
        const int row0 = u.pm * BM + wr * 64 + fr, col0 = (u.pn & 3) * 128 + wc * 32 + 8 * fq;
#pragma unroll
        for (int ai = 0; ai < 2; ++ai)
#pragma unroll
            for (int m = 0; m < 4; ++m) { const f32x4 g0 = acc[ai][0][m][0], g1 = acc[ai][0][m][1], u0 = acc[ai][1][m][0], u1 = acc[ai][1][m][1];
                u32x4 w; w.x = cvt_pk(siluf_(g0[0]) * u0[0], siluf_(g0[1]) * u0[1]); w.y = cvt_pk(siluf_(g0[2]) * u0[2], siluf_(g0[3]) * u0[3]);
                w.z = cvt_pk(siluf_(g1[0]) * u1[0], siluf_(g1[1]) * u1[1]); w.w = cvt_pk(siluf_(g1[2]) * u1[2], siluf_(g1[3]) * u1[3]);
                *(u32x4*)(O + (size_t)(row0 + ai * HALF + m * 16) * 512 + col0) = w; }
    }
};
struct MoeOut {
    static constexpr bool PERM = true, AFTER_DRAIN = false;
    bf16* O;
    DI void operator()(const f32x4 (&acc)[2][2][4][2], const Unit& u, int wr, int wc, int fr, int fq) const {
        const int row0 = u.pm * BM + wr * 64 + fr, col0 = (u.pn & 3) * BM + wc * 32 + 8 * fq;
#pragma unroll
        for (int ai = 0; ai < 2; ++ai)
#pragma unroll
            for (int m = 0; m < 4; ++m) { bf16* rowp = O + (size_t)(row0 + ai * HALF + m * 16) * DM + col0;
#pragma unroll
                for (int bj = 0; bj < 2; ++bj) { const f32x4 v0 = acc[ai][bj][m][0], v1 = acc[ai][bj][m][1];
                    *(u32x4*)(rowp + bj * HALF) = (u32x4){cvt_pk(v0[0], v0[1]), cvt_pk(v0[2], v0[3]), cvt_pk(v1[0], v1[1]), cvt_pk(v1[2], v1[3])}; } }
    }
};
struct MoeOrder {
    const LAS int* tile_e; int ntiles, G, c;
    DI bool next(int i, Unit& u) const { const int L = i * G + c; if (L >= ntiles * 4) return false; const int pm = L >> 2; u.pm = pm; u.pn = tile_e[pm] * 4 + (L & 3); return true; }
    DI void a_ready(const Unit&) const {}
    DI void done(const Unit&) const {}
};
}

constexpr int L_TILE_E = 131072, L_PADSTART = 131072 + 1024, L_NTILES = 131072 + 1024 + 256;
DI void moe_tables(const Ctx& X, const Args& a) {
    LAS int* tile_e = (LAS int*)(X.lds + L_TILE_E); LAS int* pad_start = (LAS int*)(X.lds + L_PADSTART); LAS int* ntl = (LAS int*)(X.lds + L_NTILES);
    if (X.tid == 0) {
        const unsigned* cnt = (const unsigned*)(a.ws + WS_CTL) + CW_ECNT; int tiles = 0;
        for (int e = 0; e < 32; ++e) { const int n = (int)__hip_atomic_load(cnt + e, __ATOMIC_RELAXED, __HIP_MEMORY_SCOPE_AGENT); const int nt = (n + 255) >> 8;
            pad_start[e] = tiles * 256; for (int q = 0; q < nt; ++q) tile_e[tiles + q] = e; tiles += nt; }
        pad_start[32] = tiles * 256; ntl[0] = tiles;
    }
    __syncthreads();
}

DI void phase_expert_weights(const Ctx& X, const Args& a) {
    LAS float* scr = (LAS float*)(X.lds + X.wave * 16384);
    const int gw = X.blk * 8 + X.wave, NGW = X.nblk * 8;
    bf16* WGU = (bf16*)(a.ws + WS_EWGU); bf16* WD = (bf16*)(a.ws + WS_EWD);
    for (int it = gw; it < 3 * 8192; it += NGW) {
        const int which = it >> 13, r = it & 8191, e = r >> 8, q = r & 255;
        if (which < 2) { const int kb = q >> 4, nb = q & 15;
            transpose_item(a.in[27 + which] + (size_t)e * 1024 * 512, 512, nb * 32, kb * 64, WGU + ((size_t)e * 1024 + (nb >> 2) * 256 + which * 128 + (nb & 3) * 32) * 1024, 1024, false, scr, X.lane); }
        else { const int kb = q >> 5, nb = q & 31;
            transpose_item(a.in[29] + (size_t)e * 512 * 1024, 1024, nb * 32, kb * 64, WD + ((size_t)e * 1024 + nb * 32) * 512, 512, false, scr, X.lane); }
    }
}

DI void phase_router(const Ctx& X, const Args& a) {
    const float* x1 = a.out; const float* g2 = a.in[22]; const float* mod = (const float*)(a.ws + WS_MOD);
    const float* wgr = a.in[23]; const float* bgr = a.in[24]; const float* wer = a.in[25]; const float* ber = a.in[26];
    bf16* h2 = (bf16*)(a.ws + WS_H2);
    LAS int* EL = (LAS int*)X.lds;
    LAS int* PL = (LAS int*)(X.lds + 512);
    unsigned* cnt = (unsigned*)(a.ws + WS_CTL) + CW_ECNT;
    for (int tb = X.blk; tb < 256; tb += X.nblk) {
        for (int q = 0; q < 8; ++q) {
            const int tl = X.wave * 8 + q, m = tb * 64 + tl, b = m >> 13;
            const f32x4* xr = (const f32x4*)(x1 + (size_t)m * DM) + X.lane;
            f32x4 v[4]; float s = 0.f;
#pragma unroll
            for (int j = 0; j < 4; ++j) { v[j] = xr[64 * j]; s += (v[j].x * v[j].x + v[j].y * v[j].y) + (v[j].z * v[j].z + v[j].w * v[j].w); }
            const float rs = 1.0f / sqrtf(wave_sum(s) * (1.f / DM) + 1e-6f);
            float lg[4], le[32];
#pragma unroll
            for (int o = 0; o < 4; ++o) lg[o] = 0.f;
#pragma unroll
            for (int o = 0; o < 32; ++o) le[o] = 0.f;
            u32x2* op = (u32x2*)(h2 + (size_t)m * DM) + X.lane;
#pragma unroll
            for (int j = 0; j < 4; ++j) { const int col = 4 * X.lane + 256 * j;
                const f32x4 g = *(const f32x4*)(g2 + col), sh = *(const f32x4*)(mod + b * 6144 + 3072 + col), sc = *(const f32x4*)(mod + b * 6144 + 4096 + col);
                const f32x4 y = v[j] * rs * g * (1.0f + sc) + sh;
                op[64 * j] = (u32x2){cvt_pk(y.x, y.y), cvt_pk(y.z, y.w)};
#pragma unroll
                for (int e = 0; e < 4; ++e) { const int k = col + e;
                    const f32x4 wg4 = *(const f32x4*)(wgr + k * 4);
#pragma unroll
                    for (int o = 0; o < 4; ++o) lg[o] += y[e] * wg4[o];
#pragma unroll
                    for (int o4 = 0; o4 < 8; ++o4) { const f32x4 we4 = *(const f32x4*)(wer + k * 32 + o4 * 4);
#pragma unroll
                        for (int o = 0; o < 4; ++o) le[o4 * 4 + o] += y[e] * we4[o]; }
                    asm volatile("" ::: "memory"); } }
#pragma unroll
            for (int o = 0; o < 4; ++o) lg[o] = wave_sum(lg[o]) + bgr[o];
#pragma unroll
            for (int o = 0; o < 32; ++o) le[o] = wave_sum(le[o]) + ber[o];
            int gi = 0; float gm = lg[0];
#pragma unroll
            for (int o = 1; o < 4; ++o) if (lg[o] > gm) { gm = lg[o]; gi = o; }
            float gs = 0.f;
#pragma unroll
            for (int o = 0; o < 4; ++o) gs += __expf(lg[o] - gm);
            const float pgrp = 1.0f / gs;
            float sel[8];
#pragma unroll
            for (int o = 0; o < 8; ++o) sel[o] = gi == 0 ? le[o] : gi == 1 ? le[8 + o] : gi == 2 ? le[16 + o] : le[24 + o];
            int i0 = 0; float m0 = sel[0];
#pragma unroll
            for (int o = 1; o < 8; ++o) if (sel[o] > m0) { m0 = sel[o]; i0 = o; }
            int i1 = -1; float m1 = -3.0e38f;
#pragma unroll
            for (int o = 0; o < 8; ++o) if (o != i0 && sel[o] > m1) { m1 = sel[o]; i1 = o; }
            const float e1 = __expf(m1 - m0), den = 1.0f + e1;
            if (X.lane == 0) {
                EL[tl * 2] = gi * 8 + i0; EL[tl * 2 + 1] = gi * 8 + i1;
                float* wt = (float*)(a.ws + WS_WTS) + (size_t)m * 2; wt[0] = pgrp / den; wt[1] = pgrp * e1 / den;
            }
        }
        __syncthreads();
        if (X.tid < 32) { int n = 0;
            for (int q = 0; q < 128; ++q) n += (EL[q] == X.tid) ? 1 : 0;
            int base = 0; if (n) base = (int)__hip_atomic_fetch_add(cnt + X.tid, (unsigned)n, __ATOMIC_RELAXED, __HIP_MEMORY_SCOPE_AGENT);
            for (int q = 0; q < 128; ++q) if (EL[q] == X.tid) PL[q] = base++; }
        __syncthreads();
        if (X.tid < 128) { ((int*)(a.ws + WS_EID))[(size_t)tb * 128 + X.tid] = EL[X.tid]; ((int*)(a.ws + WS_POS))[(size_t)tb * 128 + X.tid] = PL[X.tid]; }
        __syncthreads();
    }
}

DI void phase_gather(const Ctx& X, const Args& a) {
    moe_tables(X, a);
    const LAS int* pad_start = (const LAS int*)(X.lds + L_PADSTART);
    const int* EID = (const int*)(a.ws + WS_EID); const int* POS = (const int*)(a.ws + WS_POS); int* SLOT = (int*)(a.ws + WS_SLOT);
    const bf16* h2 = (const bf16*)(a.ws + WS_H2); bf16* xg = (bf16*)(a.ws + WS_XG);
    const int gw = X.blk * 8 + X.wave, NGW = X.nblk * 8;
    for (int as = gw; as < 32768; as += NGW) {
        const int e = EID[as], dest = pad_start[e] + POS[as];
        if (X.lane == 0) SLOT[as] = dest;
        const u32x4* src = (const u32x4*)(h2 + (size_t)(as >> 1) * DM) + X.lane; u32x4* dst = (u32x4*)(xg + (size_t)dest * DM) + X.lane;
        dst[0] = src[0]; dst[64] = src[64];
    }
}

DI void phase_final(const Ctx& X, const Args& a, bool with_moe) {
    float* out = a.out; const float* fg = a.in[30]; const float* mod = (const float*)(a.ws + WS_MOD);
    const int* SLOT = (const int*)(a.ws + WS_SLOT); const float* WTS = (const float*)(a.ws + WS_WTS); const bf16* Y = (const bf16*)(a.ws + WS_XG);
    const int gw = X.blk * 8 + X.wave, NGW = X.nblk * 8;
    for (int m = gw; m < NTOK; m += NGW) {
        const int b = m >> 13;
        f32x4* xr = (f32x4*)(out + (size_t)m * DM) + X.lane;
        f32x4 v[4]; float s = 0.f;
        int s0 = 0, s1 = 0; float w0 = 0.f, w1 = 0.f;
        if (with_moe) { s0 = SLOT[m * 2]; s1 = SLOT[m * 2 + 1]; w0 = WTS[m * 2]; w1 = WTS[m * 2 + 1]; }
#pragma unroll
        for (int j = 0; j < 4; ++j) { const int col = 4 * X.lane + 256 * j; v[j] = xr[64 * j];
            if (with_moe) {
                const u32x2 y0 = *(const u32x2*)(Y + (size_t)s0 * DM + col), y1 = *(const u32x2*)(Y + (size_t)s1 * DM + col);
                const f32x4 gt = *(const f32x4*)(mod + b * 6144 + 5120 + col);
                const f32x4 mo = w0 * (f32x4){bflo(y0.x), bfhi(y0.x), bflo(y0.y), bfhi(y0.y)} + w1 * (f32x4){bflo(y1.x), bfhi(y1.x), bflo(y1.y), bfhi(y1.y)};
                v[j] = v[j] + gt * mo; }
            s += (v[j].x * v[j].x + v[j].y * v[j].y) + (v[j].z * v[j].z + v[j].w * v[j].w); }
        const float rs = 1.0f / sqrtf(wave_sum(s) * (1.f / DM) + 1e-6f);
#pragma unroll
        for (int j = 0; j < 4; ++j) { const f32x4 g = *(const f32x4*)(fg + 4 * X.lane + 256 * j); xr[64 * j] = v[j] * rs * g; }
    }
}

#ifndef MK_NOMOE
#define MK_NOMOE 0
#endif
constexpr int NPH = 14;
__global__ void __launch_bounds__(512, 2) mk_fwd(Args a) {
    extern __shared__ __attribute__((aligned(16))) unsigned char lds_raw[];
    Ctx X; X.lds = (LAS unsigned char*)lds_raw; X.tid = threadIdx.x; X.lane = X.tid & 63; X.wave = __builtin_amdgcn_readfirstlane(X.tid >> 6); X.nblk = gridDim.x; X.blk = blockIdx.x;
    if (X.tid < 8) ((LAS unsigned*)(X.lds + LDS_MISC))[X.tid] = 0u;
    __syncthreads();
    XcdBarrier bar = xcd_barrier_post((unsigned*)(a.ws + WS_CTL) + CW_BAR, (volatile LAS unsigned*)(X.lds + LDS_MISC));
    const int lo = a.ph_lo, hi = a.ph_hi;
#ifndef MK_PHASE_MASK
#define MK_PHASE_MASK 0xffff
#endif
#define IN(k) (((MK_PHASE_MASK >> (k)) & 1) && lo <= (k) && (k) < hi)
#define SEAM(k) do { if (IN(k) && IN((k) + 1)) xcd_barrier(bar); } while (0)
    unsigned char* ws = a.ws;
    bf16* hbuf = (bf16*)a.out;
    if (IN(0)) { phase_prologue(X, a); } SEAM(0);
    if (IN(1)) { phase_norm1(X, a); } SEAM(1);
    if (IN(2)) {
        pg8::Gemm g{hbuf, (const bf16*)(ws + WS_WIN), NTOK, LDP, 1024, 1024}; pg8::StaticOrder S; S.init(NTOK, LDP, X.nblk, X.blk);
        pg8::EpiBf16<0> E{(bf16*)(ws + WS_PROJ), LDP, nullptr, 0, 0};
        pg8::gemm_phase<pg8::EpiBf16<0>, pg8::StaticOrder>(X.lds, g, S, E, nullptr);
    } SEAM(2);
    if (IN(3)) {
        for (int u = X.blk; u < 1024; u += X.nblk) hg1_unit(X, a, u);
        for (int u = X.blk; u < 2048; u += X.nblk) rw1_unit(X, a, u);
    } SEAM(3);
    if (IN(4)) {
        hg2_scan(X, a);
        if (X.wave == 0) for (int ch = 0; ch < 64; ++ch) if ((128 + ch) % X.nblk == X.blk) rw2_chain(X, a, ch);
    } SEAM(4);
    if (IN(5)) {
        for (int u = X.blk; u < 1024; u += X.nblk) hg3_unit(X, a, u);
        for (int u = X.blk; u < 2048; u += X.nblk) rw3_unit(X, a, u);
    } SEAM(5);
    if (IN(6)) {
        pg8::Gemm g{hbuf, (const bf16*)(ws + WS_WIN) + (size_t)LDP * 1024, NTOK, 2048, 1024, 1024}; pg8::StaticOrder S; S.init(NTOK, 2048, X.nblk, X.blk);
        epi::SigmoidBf16 E{(bf16*)(ws + WS_GATES), 2048};
        pg8::gemm_phase<epi::SigmoidBf16, pg8::StaticOrder>(X.lds, g, S, E, nullptr);
    } SEAM(6);
    if (IN(7)) {
        pg8::StaticOrder S; S.init(NTOK, 1024, X.nblk, X.blk);
        { pg8::Gemm g{(const bf16*)(ws + WS_PROJ) + C_HQ, (const bf16*)(ws + WS_WPA), NTOK, 1024, 512, LDP};
          epi::GateMix<false> E{(bf16*)(ws + WS_MIXED), 1024, (const bf16*)(ws + WS_GATES), 2048};
          pg8::gemm_phase<epi::GateMix<false>, pg8::StaticOrder>(X.lds, g, S, E, nullptr); }
        __syncthreads();
        { pg8::Gemm g{(const bf16*)(ws + WS_PROJ) + C_RR, (const bf16*)(ws + WS_WPB), NTOK, 1024, 512, LDP};
          epi::GateMix<true> E{(bf16*)(ws + WS_MIXED), 1024, (const bf16*)(ws + WS_GATES) + 1024, 2048};
          pg8::gemm_phase<epi::GateMix<true>, pg8::StaticOrder>(X.lds, g, S, E, nullptr); }
    } SEAM(7);
    if (IN(8)) {
        pg8::Gemm g{(const bf16*)(ws + WS_MIXED), (const bf16*)(ws + WS_WOUT), NTOK, 1024, 1024, 1024}; pg8::StaticOrder S; S.init(NTOK, 1024, X.nblk, X.blk);
        epi::Resid E{a.in[0], a.out, (const float*)(ws + WS_MOD) + 2048};
        pg8::gemm_phase<epi::Resid, pg8::StaticOrder>(X.lds, g, S, E, nullptr);
        __syncthreads();
        if (!MK_NOMOE) phase_expert_weights(X, a);
    } SEAM(8);
#if !MK_NOMOE
    if (IN(9)) { phase_router(X, a); } SEAM(9);
    if (IN(10)) { phase_gather(X, a); } SEAM(10);
    if (IN(11)) {
        moe_tables(X, a);
        const int ntiles = ((const LAS int*)(X.lds + L_NTILES))[0];
        pg8::Gemm g{(const bf16*)(ws + WS_XG), (const bf16*)(ws + WS_EWGU), ntiles * 256, 32 * 1024, 1024, 1024};
        epi::MoeOrder S{(const LAS int*)(X.lds + L_TILE_E), ntiles, X.nblk, X.blk};
        epi::SwiGlu E{(bf16*)(ws + WS_HID)};
        pg8::gemm_phase<epi::SwiGlu, epi::MoeOrder>(X.lds, g, S, E, nullptr);
    } SEAM(11);
    if (IN(12)) {
        moe_tables(X, a);
        const int ntiles = ((const LAS int*)(X.lds + L_NTILES))[0];
        pg8::Gemm g{(const bf16*)(ws + WS_HID), (const bf16*)(ws + WS_EWD), ntiles * 256, 32 * 1024, 512, 512};
        epi::MoeOrder S{(const LAS int*)(X.lds + L_TILE_E), ntiles, X.nblk, X.blk};
        epi::MoeOut E{(bf16*)(ws + WS_XG)};
        pg8::gemm_phase<epi::MoeOut, epi::MoeOrder>(X.lds, g, S, E, nullptr);
    } SEAM(12);
#else
    SEAM(9); SEAM(10); SEAM(11); SEAM(12);
#endif
    if (IN(13)) { phase_final(X, a, !MK_NOMOE); }
#undef IN
#undef SEAM
}

extern "C" void kernel_launch(void* const* d_in, const int* in_sizes, int n_in, void* d_out, int out_size, void* d_ws, size_t ws_size, hipStream_t stream) {
    static int grid = 0;
    if (grid == 0) {
        int dev = 0, cus = 0;
        if (n_in != 31 || out_size != NTOK * DM || ws_size < WS_END) { fprintf(stderr, "kernel_launch: unexpected shapes (n_in %d out %d ws %zu)\n", n_in, out_size, ws_size); grid = -1; return; }
        if (hipGetDevice(&dev) != hipSuccess || hipDeviceGetAttribute(&cus, hipDeviceAttributeMultiprocessorCount, dev) != hipSuccess) { grid = -1; return; }
        if (hipFuncSetAttribute((const void*)mk_fwd, hipFuncAttributeMaxDynamicSharedMemorySize, LDS_BYTES) != hipSuccess) { fprintf(stderr, "kernel_launch: hipFuncSetAttribute failed\n"); grid = -1; return; }
        int per_cu = 0;
        if (hipOccupancyMaxActiveBlocksPerMultiprocessor(&per_cu, (const void*)mk_fwd, 512, LDS_BYTES) != hipSuccess || per_cu < 1) fprintf(stderr, "kernel_launch: occupancy query reports %d\n", per_cu);
        (void)hipGetLastError();
        grid = cus;
    }
    if (grid < 0) return;
    hipMemsetAsync((char*)d_ws + WS_CTL, 0, CTL_ZERO_BYTES, stream);
    Args a{};
    for (int i = 0; i < 31; ++i) a.in[i] = (const float*)d_in[i];
    a.out = (float*)d_out; a.ws = (unsigned char*)d_ws;
#if MK_ONE_LAUNCH
    a.ph_lo = 0; a.ph_hi = NPH;
    hipLaunchKernelGGL(mk_fwd, dim3(grid), dim3(512), LDS_BYTES, stream, a);
#else
    for (int ph = 0; ph < NPH; ++ph) {
        if (MK_NOMOE && ph >= 9 && ph <= 12) continue;
        a.ph_lo = ph; a.ph_hi = ph + 1;
        hipLaunchKernelGGL(mk_fwd, dim3(grid), dim3(512), LDS_BYTES, stream, a);
    }
#endif
}
```

```cpp
#define MK_ONE_LAUNCH 1
#include <hip/hip_runtime.h>
#include <stdint.h>
#include <stdio.h>

#ifndef MK_ONE_LAUNCH
#define MK_ONE_LAUNCH 0
#endif
#ifndef MK_LAST_PHASE
#define MK_LAST_PHASE 99
#endif

#define DI __device__ __forceinline__
#define LAS __attribute__((address_space(3)))
typedef unsigned short bf16;
typedef short bf16x8 __attribute__((ext_vector_type(8)));
typedef float f32x4 __attribute__((ext_vector_type(4)));
typedef float f32x2 __attribute__((ext_vector_type(2)));
typedef unsigned u32x4 __attribute__((ext_vector_type(4)));
typedef unsigned u32x2 __attribute__((ext_vector_type(2)));

constexpr int NTOK = 16384, DM = 1024, SEQ = 8192;
constexpr int LDP = 3840;
constexpr int NWIN = 5888;
constexpr int C_HQ = 0, C_HF = 512, C_HI = 1024, C_HG = 1536, C_RR = 2048, C_RK = 2560, C_RV = 3072, C_WD = 3584, C_AD = 3616, C_GD = 3648;
constexpr int MOE_PMAX = 40960;

constexpr size_t MiB = 1u << 20;
constexpr size_t WS_CTL = 0, CTL_ZERO_BYTES = 1 * MiB;
constexpr size_t WS_MOD = 1 * MiB;
constexpr size_t WS_SLOT = 1 * MiB + 64 * 1024;
constexpr size_t WS_WTS = WS_SLOT + 128 * 1024;
constexpr size_t WS_EID = WS_WTS + 128 * 1024;
constexpr size_t WS_POS = WS_EID + 128 * 1024;
constexpr size_t WS_RSV = WS_POS + 128 * 1024;
constexpr size_t WS_BONUS = 2 * MiB;
constexpr size_t WS_HGC = 2 * MiB + 512 * 1024;
constexpr size_t WS_RGC = 3 * MiB;
constexpr size_t WS_WRH = 3 * MiB + 512 * 1024;
constexpr size_t WS_WRL = WS_WRH + 196608;
constexpr size_t WS_CB = WS_WRL + 196608;
constexpr size_t WS_WIN = 4 * MiB;
constexpr size_t WS_WPA = 16 * MiB, WS_WPB = 17 * MiB, WS_WOUT = 18 * MiB;
constexpr size_t WS_PROJ = 20 * MiB;
constexpr size_t WS_HS = 140 * MiB;
constexpr size_t WS_RM = 172 * MiB;
constexpr size_t WS_RS = 236 * MiB;
constexpr size_t WS_MIXED = 204 * MiB;
constexpr size_t WS_EWGU = 20 * MiB;
constexpr size_t WS_EWD = 84 * MiB;
constexpr size_t WS_XG = 116 * MiB;
constexpr size_t WS_HID = 196 * MiB;
constexpr size_t WS_GATEB = 252 * MiB;
constexpr size_t WS_END = 284 * MiB;
constexpr int CW_BAR = 4096, CW_ECNT = 16384;

constexpr int LDS_BYTES = 163840;
constexpr int LDS_MISC = 163840 - 256;

typedef __bf16 bf16x2_t __attribute__((ext_vector_type(2)));
DI unsigned cvt_pk(float lo, float hi) { bf16x2_t v = {(__bf16)lo, (__bf16)hi}; return __builtin_bit_cast(unsigned, v); }
DI bf16 f2bf(float x) { return (bf16)(cvt_pk(x, 0.f) & 0xffffu); }
DI float bf2f(bf16 b) { return __uint_as_float(((unsigned)b) << 16); }
DI float bflo(unsigned w) { return __uint_as_float(w << 16); }
DI float bfhi(unsigned w) { return __uint_as_float(w & 0xffff0000u); }
DI float sigmoidf_(float x) { return 1.0f / (1.0f + __expf(-x)); }
DI float siluf_(float x) { return x / (1.0f + __expf(-x)); }
DI float wave_sum(float v) {
#pragma unroll
    for (int o = 1; o < 64; o <<= 1) v += __shfl_xor(v, o);
    return v;
}
DI f32x4 mfma16(bf16x8 a, bf16x8 b, f32x4 c) { return __builtin_amdgcn_mfma_f32_16x16x32_bf16(a, b, c, 0, 0, 0); }
#define LDS_WAIT() asm volatile("s_waitcnt lgkmcnt(0)" ::: "memory")
#define VM_WAIT() asm volatile("s_waitcnt vmcnt(0)" ::: "memory")

template <int TP, int TQ, int KS>
DI void mm_ll(const LAS bf16* P, int ldp, const LAS bf16* Q, int ldq, f32x4 (&acc)[TP][TQ], int lane) {
    const int r = lane & 15, g = lane >> 4;
#pragma unroll
    for (int ks = 0; ks < KS; ++ks) {
        bf16x8 pf[TP], qf[TQ];
#pragma unroll
        for (int tp = 0; tp < TP; ++tp) pf[tp] = *(const LAS bf16x8*)(P + (tp * 16 + r) * ldp + ks * 32 + g * 8);
#pragma unroll
        for (int tq = 0; tq < TQ; ++tq) qf[tq] = *(const LAS bf16x8*)(Q + (tq * 16 + r) * ldq + ks * 32 + g * 8);
#pragma unroll
        for (int tp = 0; tp < TP; ++tp)
#pragma unroll
            for (int tq = 0; tq < TQ; ++tq) acc[tp][tq] = mfma16(pf[tp], qf[tq], acc[tp][tq]);
    }
}
template <int TP, int TQ, int KS>
DI void mm_gl(const bf16* P, int ldp, const LAS bf16* Q, int ldq, f32x4 (&acc)[TP][TQ], int lane) {
    const int r = lane & 15, g = lane >> 4;
#pragma unroll
    for (int ks = 0; ks < KS; ++ks) {
        bf16x8 pf[TP], qf[TQ];
#pragma unroll
        for (int tp = 0; tp < TP; ++tp) pf[tp] = *(const bf16x8*)(P + (size_t)(tp * 16 + r) * ldp + ks * 32 + g * 8);
#pragma unroll
        for (int tq = 0; tq < TQ; ++tq) qf[tq] = *(const LAS bf16x8*)(Q + (tq * 16 + r) * ldq + ks * 32 + g * 8);
#pragma unroll
        for (int tp = 0; tp < TP; ++tp)
#pragma unroll
            for (int tq = 0; tq < TQ; ++tq) acc[tp][tq] = mfma16(pf[tp], qf[tq], acc[tp][tq]);
    }
}
template <int TP, int TQ, int KS>
DI void mm_gg(const bf16* P, int ldp, const bf16* Q, int ldq, f32x4 (&acc)[TP][TQ], int lane) {
    const int r = lane & 15, g = lane >> 4;
#pragma unroll
    for (int ks = 0; ks < KS; ++ks) {
        bf16x8 pf[TP], qf[TQ];
#pragma unroll
        for (int tp = 0; tp < TP; ++tp) pf[tp] = *(const bf16x8*)(P + (size_t)(tp * 16 + r) * ldp + ks * 32 + g * 8);
#pragma unroll
        for (int tq = 0; tq < TQ; ++tq) qf[tq] = *(const bf16x8*)(Q + (size_t)(tq * 16 + r) * ldq + ks * 32 + g * 8);
#pragma unroll
        for (int tp = 0; tp < TP; ++tp)
#pragma unroll
            for (int tq = 0; tq < TQ; ++tq) acc[tp][tq] = mfma16(pf[tp], qf[tq], acc[tp][tq]);
    }
}
template <int A, int B> DI void zero_acc(f32x4 (&acc)[A][B]) {
#pragma unroll
    for (int a = 0; a < A; ++a)
#pragma unroll
        for (int b = 0; b < B; ++b) acc[a][b] = (f32x4){0.f, 0.f, 0.f, 0.f};
}
namespace pg8 {
#define PG8_LAS __attribute__((address_space(3)))
typedef unsigned short bf16_t;
typedef short bf16x8 __attribute__((ext_vector_type(8)));
typedef float f32x4 __attribute__((ext_vector_type(4)));
typedef unsigned u32x4 __attribute__((ext_vector_type(4)));
constexpr int BM = 256, BK = 64, HALF = 128, HTB = HALF * BK * 2  , STAGE_BYTES = 8 * HTB, NXCD = 8, WGM = 8;

__host__ __device__ __forceinline__ int lds_byte(int r, int c) { const int st = (r >> 4) * 2 + (c >> 5), rr = r & 15, cc = c & 31, ob = rr * 64 + cc * 2; return st * 1024 + (ob ^ (((ob >> 9) & 1) << 5)); }
__host__ __device__ __forceinline__ void stage_rc(int b, int& R, int& C) { const int st = b / 1024, sb = b % 1024, swz = sb ^ (((sb >> 9) & 1) << 5); R = (st >> 1) * 16 + swz / 64; C = (st & 1) * 32 + (swz % 64) / 2; }
__host__ __device__ __forceinline__ int perm32(int rho) { const int n = rho >> 4, i = rho & 15; return 8 * (i >> 2) + 4 * n + (i & 3); }

struct Unit { int pm, pn; };
struct Gemm { const bf16_t* A; const bf16_t* Bt; int M, N, K, lda; };

struct StaticOrder {
    int nM, nN, nwg, G, c;
    __host__ __device__ void init(int M, int N, int G_, int c_) { nM = M / BM; nN = N / BM; nwg = nM * nN; G = G_; c = c_; }
    __host__ __device__ bool next(int i, Unit& u) const {
        const long L = (long)i * G + c; if (L >= nwg) return false;
        int wgid = (int)L; { const int q = nwg / NXCD, r = nwg % NXCD, xcd = wgid % NXCD, off = wgid / NXCD; wgid = (xcd < r ? xcd * (q + 1) : r * (q + 1) + (xcd - r) * q) + off; }
        const int nig = WGM * nN, gid = wgid / nig, fm = gid * WGM, gsz = (nM - fm) < WGM ? (nM - fm) : WGM;
        u.pm = fm + ((wgid % nig) % gsz); u.pn = (wgid % nig) / gsz; return true;
    }
    __device__ __forceinline__ void a_ready(const Unit&) const {}
    __device__ __forceinline__ void done(const Unit&) const {}
};
struct CountedOrder : StaticOrder {
    const unsigned* ready; unsigned need; unsigned* tmo;
    __device__ __forceinline__ void a_ready(const Unit& u) const {
        if (threadIdx.x < 64) {
            const unsigned long long t0 = __builtin_amdgcn_s_memrealtime(); unsigned polls = 0;
            while ((unsigned)__builtin_amdgcn_readfirstlane(__hip_atomic_load(ready + 64 * u.pm, __ATOMIC_RELAXED, __HIP_MEMORY_SCOPE_AGENT)) < need) {
                if ((++polls & 255u) == 0u && __builtin_amdgcn_readfirstlane(__hip_atomic_load(tmo, __ATOMIC_RELAXED, __HIP_MEMORY_SCOPE_AGENT)) != 0u) break;
                if (__builtin_amdgcn_s_memrealtime() - t0 > 2000000ull) {
                    if (threadIdx.x == 0) { unsigned expect = 0u; __hip_atomic_compare_exchange_strong(tmo + 1, &expect, 0x600u | (unsigned)(u.pm & 0xff), __ATOMIC_RELAXED, __ATOMIC_RELAXED, __HIP_MEMORY_SCOPE_AGENT); __hip_atomic_store(tmo, 1u, __ATOMIC_RELAXED, __HIP_MEMORY_SCOPE_AGENT); }
                    break; }
                __builtin_amdgcn_s_sleep(2); }
            __builtin_amdgcn_fence(__ATOMIC_ACQUIRE, "agent");
            asm volatile("s_waitcnt vmcnt(0)" ::: "memory");
        }
#if !defined(BROKEN_HOOK_NO_BARRIER)
        asm volatile("" ::: "memory"); __builtin_amdgcn_s_barrier(); asm volatile("" ::: "memory");
#endif
    }
};

__device__ __forceinline__ unsigned cvt_pk_bf16(float lo, float hi) { return ::cvt_pk(lo, hi); }
typedef float f32x2 __attribute__((ext_vector_type(2)));
__device__ __forceinline__ f32x2 gelu_pk(f32x2 v) {
    const f32x2 av = __builtin_elementwise_abs(v), d = av * 0.2316418882f + 1.0f;
    f32x2 t; t.x = __builtin_amdgcn_rcpf(d.x); t.y = __builtin_amdgcn_rcpf(d.y);
    f32x2 q = t * 0.5307027145f + (-0.7265760135f); q = q * t + 0.7107068705f; q = q * t + (-0.142248368f); q = q * t + 0.127414796f; q = q * t;
    const f32x2 s = (v * v) * (-0.72134752044f);
    f32x2 e; e.x = __builtin_amdgcn_exp2f(s.x); e.y = __builtin_amdgcn_exp2f(s.y);
    const f32x2 m = v * (q * e), r = v - m;
    f32x2 o; o.x = v.x < 0.f ? m.x : r.x; o.y = v.y < 0.f ? m.y : r.y; return o;
}

struct EpiF32 {
    static constexpr bool PERM = false, AFTER_DRAIN = false;
    float* C; int ldc; const float* bias;
    __device__ __forceinline__ void operator()(const f32x4 (&acc)[2][2][4][2], const Unit& u, int wr, int wc, int fr, int fq) const {
        const int row0 = u.pm * BM + wr * 64 + fr, col0 = u.pn * BM + wc * 32 + 4 * fq;
        f32x4 bv[2][2];
#pragma unroll
        for (int bj = 0; bj < 2; ++bj)
#pragma unroll
            for (int n = 0; n < 2; ++n) bv[bj][n] = bias ? *(const f32x4*)(bias + col0 + bj * HALF + n * 16) : (f32x4){0.f, 0.f, 0.f, 0.f};
#pragma unroll
        for (int ai = 0; ai < 2; ++ai)
#pragma unroll
            for (int m = 0; m < 4; ++m) { float* rowp = C + (size_t)(row0 + ai * HALF + m * 16) * ldc + col0;
#pragma unroll
                for (int bj = 0; bj < 2; ++bj)
#pragma unroll
                    for (int n = 0; n < 2; ++n) *(f32x4*)(rowp + bj * HALF + n * 16) = acc[ai][bj][m][n] + bv[bj][n]; }
    }
};
template <int ACT  > struct EpiBf16 {
    static constexpr bool PERM = true, AFTER_DRAIN = false;
    bf16_t* O; int ldc; const float* bias; int split_cols; size_t split_stride;
    __device__ __forceinline__ void operator()(const f32x4 (&acc)[2][2][4][2], const Unit& u, int wr, int wc, int fr, int fq) const {
        const int row0 = u.pm * BM + wr * 64 + fr; int colt = u.pn * BM; bf16_t* base = O;
        if (split_cols) { const int t = colt / split_cols; base += (size_t)t * split_stride; colt -= t * split_cols; }
        const int col0 = colt + wc * 32 + 8 * fq, bcol0 = u.pn * BM + wc * 32 + 8 * fq;
        f32x4 bv[2][2];
#pragma unroll
        for (int bj = 0; bj < 2; ++bj)
#pragma unroll
            for (int n = 0; n < 2; ++n) bv[bj][n] = bias ? *(const f32x4*)(bias + bcol0 + bj * HALF + 4 * n) : (f32x4){0.f, 0.f, 0.f, 0.f};
#pragma unroll
        for (int ai = 0; ai < 2; ++ai)
#pragma unroll
            for (int m = 0; m < 4; ++m) { bf16_t* rowp = base + (size_t)(row0 + ai * HALF + m * 16) * ldc + col0;
#pragma unroll
                for (int bj = 0; bj < 2; ++bj) { f32x4 v0 = acc[ai][bj][m][0] + bv[bj][0], v1 = acc[ai][bj][m][1] + bv[bj][1];
                    if (ACT == 1) { f32x2 a = gelu_pk((f32x2){v0[0], v0[1]}), b = gelu_pk((f32x2){v0[2], v0[3]}), c = gelu_pk((f32x2){v1[0], v1[1]}), d = gelu_pk((f32x2){v1[2], v1[3]});
                        v0 = (f32x4){a.x, a.y, b.x, b.y}; v1 = (f32x4){c.x, c.y, d.x, d.y}; }
                    if (ACT == 2) {
#pragma unroll
                        for (int j = 0; j < 4; ++j) { v0[j] = 0.5f * v0[j] * (1.0f + erff(v0[j] * 0.70710678f)); v1[j] = 0.5f * v1[j] * (1.0f + erff(v1[j] * 0.70710678f)); } }
                    u32x4 w; w.x = cvt_pk_bf16(v0[0], v0[1]); w.y = cvt_pk_bf16(v0[2], v0[3]); w.z = cvt_pk_bf16(v1[0], v1[1]); w.w = cvt_pk_bf16(v1[2], v1[3]);
                    *(u32x4*)(rowp + bj * HALF) = w; } }
    }
};
template <class Epi, class Sched, bool STAMP = false>
__device__ __forceinline__ void gemm_phase(PG8_LAS unsigned char* lds, const Gemm g, const Sched& S, const Epi& E, unsigned long long* stamps) {
    const int tid = threadIdx.x, wid = __builtin_amdgcn_readfirstlane(tid >> 6), lane = tid & 63, wr = wid >> 2, wc = wid & 3, fr = lane & 15, fq = lane >> 4;
    const int K = g.K, nt = K / BK;
    int ts_lo = 0, ts_hi = 0, nts = 0; const unsigned long long rt_entry = STAMP ? (unsigned long long)wall_clock64() : 0ull;
#define PG8_STAMP() do { if (STAMP && wid == 0 && nts < 64) { const unsigned long long _c = (unsigned long long)clock64(); \
        ts_lo = (lane == nts) ? (int)(unsigned)_c : ts_lo; ts_hi = (lane == nts) ? (int)(unsigned)(_c >> 32) : ts_hi; ++nts; } } while (0)
    PG8_STAMP();
    unsigned voffA[2], voffB[2];
#pragma unroll
    for (int i = 0; i < 2; ++i) { int R, C; stage_rc(tid * 16 + i * 8192, R, C); const int Rb = Epi::PERM ? ((R & ~31) + perm32(R & 31)) : R;
        voffA[i] = (unsigned)(R * g.lda + C) * 2u; voffB[i] = (unsigned)(Rb * K + C) * 2u; }
    const size_t kstep = (size_t)(BK * 2);
    const size_t hstep = (size_t)HALF * K * 2;
    const size_t tstep = 2 * hstep; const size_t hstepA = (size_t)HALF * g.lda * 2, tstepA = 2 * hstepA;
    const unsigned ldsw = (unsigned)wid * 1024u;
    const int aoff = lds_byte(wr * 64 + fr, fq * 8), boff = lds_byte(wc * 32 + fr, fq * 8);
#define PG8_SA(b, h) (((b) * 2 + (h)) * HTB)
#define PG8_SB(b, h) ((4 + (b) * 2 + (h)) * HTB)
#define PG8_STAGE(bufoff, gbase, voff) do { _Pragma("unroll") for (int _i = 0; _i < 2; ++_i) \
        __builtin_amdgcn_global_load_lds((const unsigned*)((const char*)(gbase) + (voff)[_i]), (PG8_LAS unsigned*)(lds + (bufoff) + ldsw + _i * 8192), 16, 0, 0); } while (0)
#define PG8_LDA(dst, b, h) do { _Pragma("unroll") for (int m = 0; m < 4; ++m) _Pragma("unroll") for (int k = 0; k < 2; ++k) dst[m][k] = *(const PG8_LAS bf16x8*)(lds + PG8_SA(b, h) + aoff + m * 2048 + k * 1024); } while (0)
#define PG8_LDB(dst, b, h) do { _Pragma("unroll") for (int n = 0; n < 2; ++n) _Pragma("unroll") for (int k = 0; k < 2; ++k) dst[n][k] = *(const PG8_LAS bf16x8*)(lds + PG8_SB(b, h) + boff + n * 2048 + k * 1024); } while (0)
#define PG8_MMA(ai, bj, At, Bt) do { __builtin_amdgcn_s_setprio(1); _Pragma("unroll") for (int m = 0; m < 4; ++m) _Pragma("unroll") for (int n = 0; n < 2; ++n) _Pragma("unroll") for (int k = 0; k < 2; ++k) \
        acc[ai][bj][m][n] = __builtin_amdgcn_mfma_f32_16x16x32_bf16(Bt[n][k], At[m][k], acc[ai][bj][m][n], 0, 0, 0); __builtin_amdgcn_s_setprio(0); } while (0)
#define PG8_WAIT_V(n) asm volatile("s_waitcnt vmcnt(" #n ")" ::: "memory")
#define PG8_WAIT_L(n) asm volatile("s_waitcnt lgkmcnt(" #n ")" ::: "memory")
#define PG8_BAR __builtin_amdgcn_s_barrier()
#define PG8_SCHED __builtin_amdgcn_sched_barrier(0)
    Unit cur, nxt; int ui = 0;
    if (!S.next(0, cur)) return;
    f32x4 acc[2][2][4][2];
#pragma unroll
    for (int a = 0; a < 2; ++a)
#pragma unroll
        for (int b = 0; b < 2; ++b)
#pragma unroll
            for (int m = 0; m < 4; ++m)
#pragma unroll
                for (int n = 0; n < 2; ++n) acc[a][b][m][n] = (f32x4){0.f, 0.f, 0.f, 0.f};
    bf16x8 At[4][2], B0[2][2], B1[2][2];
    const char* cA = (const char*)g.A + (size_t)cur.pm * tstepA; const char* cB = (const char*)g.Bt + (size_t)cur.pn * tstep;
    S.a_ready(cur);
    PG8_STAGE(PG8_SB(0, 0), cB, voffB); PG8_STAGE(PG8_SA(0, 0), cA, voffA); PG8_STAGE(PG8_SB(0, 1), cB + hstep, voffB); PG8_STAGE(PG8_SA(0, 1), cA + hstepA, voffA);
    if (wr == 1) PG8_BAR;
    PG8_WAIT_V(4); PG8_BAR;
    PG8_STAGE(PG8_SB(1, 0), cB + kstep, voffB); PG8_STAGE(PG8_SA(1, 0), cA + kstep, voffA); PG8_STAGE(PG8_SB(1, 1), cB + hstep + kstep, voffB);
    PG8_WAIT_V(6); PG8_BAR;
    PG8_STAMP();
    for (;;) {
        const bool has_next = S.next(ui + 1, nxt);
        const char* nA = has_next ? (const char*)g.A + (size_t)nxt.pm * tstepA : cA; const char* nB = has_next ? (const char*)g.Bt + (size_t)nxt.pn * tstep : cB;
        for (int t = 0; t < nt; t += 2) {
            const bool last = (t == nt - 2);
            const char* a1 = cA + (size_t)(t + 1) * kstep;
            const char* a2 = last ? nA : cA + (size_t)(t + 2) * kstep; const char* b2 = last ? nB : cB + (size_t)(t + 2) * kstep;
            const char* a3 = a2 + kstep; const char* b3 = b2 + kstep;
            if (last && has_next) S.a_ready(nxt);
            PG8_LDB(B0, 0, 0); PG8_SCHED; PG8_LDA(At, 0, 0); PG8_STAGE(PG8_SA(1, 1), a1 + hstepA, voffA);
            PG8_WAIT_L(8); PG8_BAR; PG8_WAIT_L(0); PG8_MMA(0, 0, At, B0); PG8_BAR; PG8_SCHED;
            PG8_LDB(B1, 0, 1); PG8_STAGE(PG8_SB(0, 0), b2, voffB);
            PG8_BAR; PG8_WAIT_L(0); PG8_MMA(0, 1, At, B1); PG8_BAR;
            PG8_LDA(At, 0, 1); PG8_STAGE(PG8_SA(0, 0), a2, voffA);
            PG8_BAR; PG8_WAIT_L(0); PG8_MMA(1, 0, At, B0); PG8_BAR; PG8_SCHED;
            PG8_STAGE(PG8_SB(0, 1), b2 + hstep, voffB);
            PG8_WAIT_V(6); PG8_BAR; PG8_MMA(1, 1, At, B1); PG8_BAR;
            PG8_LDB(B0, 1, 0); PG8_SCHED; PG8_LDA(At, 1, 0); PG8_STAGE(PG8_SA(0, 1), a2 + hstepA, voffA);
            PG8_WAIT_L(8); PG8_BAR; PG8_WAIT_L(0); PG8_MMA(0, 0, At, B0); PG8_BAR; PG8_SCHED;
            PG8_LDB(B1, 1, 1); PG8_STAGE(PG8_SB(1, 0), b3, voffB);
            PG8_BAR; PG8_WAIT_L(0); PG8_MMA(0, 1, At, B1); PG8_BAR;
            PG8_LDA(At, 1, 1); PG8_STAGE(PG8_SA(1, 0), a3, voffA);
            PG8_BAR; PG8_WAIT_L(0); PG8_MMA(1, 0, At, B0); PG8_BAR; PG8_SCHED;
            PG8_STAGE(PG8_SB(1, 1), b3 + hstep, voffB);
            PG8_WAIT_V(6); PG8_BAR; PG8_MMA(1, 1, At, B1); PG8_BAR;
        }
        PG8_STAMP();
        if constexpr (!Epi::AFTER_DRAIN) { E(acc, cur, wr, wc, fr, fq); S.done(cur); }
        PG8_STAMP();
        if (!has_next) break;
#pragma unroll
        for (int a = 0; a < 2; ++a)
#pragma unroll
            for (int b = 0; b < 2; ++b)
#pragma unroll
                for (int m = 0; m < 4; ++m)
#pragma unroll
                    for (int n = 0; n < 2; ++n) acc[a][b][m][n] = (f32x4){0.f, 0.f, 0.f, 0.f};
        cur = nxt; cA = nA; cB = nB; ++ui;
    }
    PG8_WAIT_V(0);
    if (wr == 0) PG8_BAR;
    PG8_BAR;
    if constexpr (Epi::AFTER_DRAIN) { E.fused(acc, cur, wr, wc, fr, fq, lds, wid, lane); S.done(cur); }
    PG8_STAMP();
    if (STAMP && wid == 0) { stamps[lane] = lane < nts ? (((unsigned long long)(unsigned)ts_hi << 32) | (unsigned)ts_lo) : 0ull;
        if (lane == 62) stamps[62] = rt_entry; if (lane == 63) stamps[63] = (unsigned long long)wall_clock64(); }
#undef PG8_STAMP
#undef PG8_SA
#undef PG8_SB
#undef PG8_STAGE
#undef PG8_LDA
#undef PG8_LDB
#undef PG8_MMA
#undef PG8_WAIT_V
#undef PG8_WAIT_L
#undef PG8_BAR
#undef PG8_SCHED
}
}
#define XB_TMO      128
#define XB_XCNT(j)  (256  + 64 * (j))
#define XB_XSUB(j)  (1280 + 64 * (j))
#define XB_XGEN(j)  (2304 + 64 * (j))
#define XB_TOP      3328
#define XB_TOPGEN   3392
#define XCD_BAR_WORDS 3456
#define XB_SPIN_CAP (1u << 22)

__device__ __forceinline__ unsigned xb_ld(unsigned* p)              { return __hip_atomic_load(p, __ATOMIC_RELAXED, __HIP_MEMORY_SCOPE_AGENT); }
__device__ __forceinline__ unsigned xb_add(unsigned* p, unsigned v) { return __hip_atomic_fetch_add(p, v, __ATOMIC_RELAXED, __HIP_MEMORY_SCOPE_AGENT); }
__device__ __forceinline__ unsigned xb_xcc_id() { return (unsigned)__builtin_amdgcn_s_getreg((3 << 11) | 20) & 0xFu; }
#define XB_SPIN(cond, bar) do { unsigned _sp = 0; while (cond) { __builtin_amdgcn_s_sleep(1); \
    if ((++_sp & 255u) == 0u) { if (xb_ld(&(bar)[XB_TMO])) break; if (_sp > XB_SPIN_CAP) { atomicAdd(&(bar)[XB_TMO], 1u); break; } } } } while (0)

struct XcdBarrier {
    unsigned* bar; unsigned x;
    volatile LAS unsigned* st;
};

__device__ __forceinline__ XcdBarrier xcd_barrier_post(unsigned* bar, volatile LAS unsigned* st) {
    XcdBarrier b; b.bar = bar; b.x = xb_xcc_id(); b.st = st;
    if (threadIdx.x == 0) (void)xb_add(&bar[XB_XCNT(b.x)], 1u);
    return b;
}
__device__ __forceinline__ void xcd_barrier_complete(unsigned* bar, unsigned x, unsigned& nloc, unsigned& nx) {
    const unsigned G = gridDim.x * gridDim.y * gridDim.z;
    unsigned sum, cnt, mine, sp = 0u;
    for (;;) {
        sum = 0u; cnt = 0u; mine = 0u;
#pragma unroll
        for (unsigned j = 0; j < 16; ++j) { const unsigned c = xb_ld(&bar[XB_XCNT(j)]); sum += c; cnt += (c > 0u) ? 1u : 0u; mine = (j == x) ? c : mine; }
        if (sum == G) break;
        __builtin_amdgcn_s_sleep(1);
        if ((++sp & 255u) == 0u) { if (xb_ld(&bar[XB_TMO])) break; if (sp > XB_SPIN_CAP) { atomicAdd(&bar[XB_TMO], 1u); break; } }
    }
    nloc = mine > 0u ? mine : 1u; nx = cnt > 0u ? cnt : 1u;
}

__device__ __forceinline__ void xcd_barrier(const XcdBarrier& b) {
    asm volatile("s_waitcnt vmcnt(0)" ::: "memory");
    __syncthreads();
    if (threadIdx.x == 0) {
        unsigned* bar = b.bar;
        __builtin_amdgcn_s_waitcnt(0);
        unsigned nloc = b.st[0], nx = b.st[1];
        if (nloc == 0u) { xcd_barrier_complete(bar, b.x, nloc, nx); b.st[0] = nloc; b.st[1] = nx; }
        const unsigned old = xb_add(&bar[XB_XSUB(b.x)], 1u);
        const unsigned gen = old / nloc;
        if (old + 1u == (gen + 1u) * nloc) {
            __builtin_amdgcn_fence(__ATOMIC_RELEASE, "agent");
            asm volatile("s_waitcnt vmcnt(0)" ::: "memory");
            const unsigned og = xb_add(&bar[XB_TOP], 1u);
            const unsigned tg = og / nx;
            if (og + 1u == (tg + 1u) * nx) xb_add(&bar[XB_TOPGEN], 1u);
            else XB_SPIN(xb_ld(&bar[XB_TOPGEN]) == tg, bar);
            __builtin_amdgcn_fence(__ATOMIC_ACQUIRE, "agent");
            xb_add(&bar[XB_XGEN(b.x)], 1u);
            asm volatile("s_waitcnt vmcnt(0)" ::: "memory");
        } else {
            XB_SPIN(xb_ld(&bar[XB_XGEN(b.x)]) == gen, bar);
            __builtin_amdgcn_fence(__ATOMIC_ACQUIRE, "agent");
            asm volatile("s_waitcnt vmcnt(0)" ::: "memory");
        }
    }
    __syncthreads();
}


struct Args { const float* in[31]; float* out; unsigned char* ws; int ph_lo, ph_hi; };

struct Ctx {
    LAS unsigned char* lds;
    int tid, lane, wave, nblk, blk;
};

DI void transpose_item(const float* W, int ldw, int src_n0, int k0, bf16* dst, int ldd, bool zero, LAS float* scr, int lane) {
    if (!zero) {
#pragma unroll 8
        for (int i = 0; i < 32; ++i) { const int kk = 2 * i + (lane >> 5); scr[kk * 33 + (lane & 31)] = W[(size_t)(k0 + kk) * ldw + src_n0 + (lane & 31)]; }
    }
    LDS_WAIT(); asm volatile("" ::: "memory");
    const int c = lane & 7;
#pragma unroll
    for (int j = 0; j < 4; ++j) { const int n = (lane >> 3) + 8 * j; const LAS float* s = scr + (8 * c) * 33 + n;
        u32x4 o;
        if (zero) { o = (u32x4){0u, 0u, 0u, 0u}; }
        else { o.x = cvt_pk(s[0 * 33], s[1 * 33]); o.y = cvt_pk(s[2 * 33], s[3 * 33]); o.z = cvt_pk(s[4 * 33], s[5 * 33]); o.w = cvt_pk(s[6 * 33], s[7 * 33]); }
        *(u32x4*)(dst + (size_t)n * ldd + k0 + 8 * c) = o; }
    LDS_WAIT(); asm volatile("" ::: "memory");
}

DI void phase_prologue(const Ctx& X, const Args& a) {
    unsigned char* ws = a.ws;
    LAS float* scr = (LAS float*)(X.lds + X.wave * 16384);
    const int gw = X.blk * 8 + X.wave, NGW = X.nblk * 8;
    constexpr int I_IN = 16 * (NWIN / 32), I_PA = 8 * 32, I_PB = 8 * 32, I_OUT = 16 * 32;
    constexpr int NITEMS = I_IN + I_PA + I_PB + I_OUT;
    for (int it = gw; it < NITEMS; it += NGW) {
        int r = it;
        if (r < I_IN) { const int kb = r / (NWIN / 32), nb = r % (NWIN / 32); const int n0 = nb * 32;
            const bool zero = (n0 >= 3744 && n0 < 3840); const int src = n0 < 3744 ? n0 : n0 - 96;
            transpose_item(a.in[5], 5792, zero ? 0 : src, kb * 64, (bf16*)(ws + WS_WIN) + (size_t)n0 * 1024, 1024, zero, scr, X.lane); continue; }
        r -= I_IN;
        if (r < I_PA) { const int kb = r / 32, nb = r % 32; transpose_item(a.in[19], 1024, nb * 32, kb * 64, (bf16*)(ws + WS_WPA) + (size_t)(nb * 32) * 512, 512, false, scr, X.lane); continue; }
        r -= I_PA;
        if (r < I_PB) { const int kb = r / 32, nb = r % 32; transpose_item(a.in[20], 1024, nb * 32, kb * 64, (bf16*)(ws + WS_WPB) + (size_t)(nb * 32) * 512, 512, false, scr, X.lane); continue; }
        r -= I_PB;
        { const int kb = r / 32, nb = r % 32; transpose_item(a.in[21], 1024, nb * 32, kb * 64, (bf16*)(ws + WS_WOUT) + (size_t)(nb * 32) * 1024, 1024, false, scr, X.lane); }
    }
    __syncthreads();
    {
        LAS float* cs = (LAS float*)X.lds;
        LAS float* part = (LAS float*)(X.lds + 8192);
        for (int i = X.tid; i < 2048; i += 512) cs[i] = siluf_(a.in[1][i]);
        __syncthreads();
        const float* aw = a.in[2]; const float* ab = a.in[3]; float* mod = (float*)(ws + WS_MOD);
        for (int cb = X.blk; cb < 256; cb += X.nblk) {
            const int c = X.tid % 24, kg = X.tid / 24;
            float s0 = 0.f, s1 = 0.f;
            if (kg < 21) for (int k = kg; k < 1024; k += 21) { const float w = aw[(size_t)k * 6144 + cb * 24 + c]; s0 += cs[k] * w; s1 += cs[1024 + k] * w; }
            if (kg < 21) { part[(kg * 24 + c) * 2] = s0; part[(kg * 24 + c) * 2 + 1] = s1; }
            __syncthreads();
            if (X.tid < 48) { const int cc = X.tid >> 1, b = X.tid & 1; float s = 0.f;
                for (int q = 0; q < 21; ++q) s += part[(q * 24 + cc) * 2 + b];
                mod[b * 6144 + cb * 24 + cc] = s + ab[cb * 24 + cc]; }
            __syncthreads();
        }
    }
}

DI void phase_norm1(const Ctx& X, const Args& a) {
    const float* x = a.in[0]; const float* g1 = a.in[4]; const float* mod = (const float*)(a.ws + WS_MOD);
    bf16* h = (bf16*)a.out;
    const int gw = X.blk * 8 + X.wave, NGW = X.nblk * 8;
    for (int m = gw; m < NTOK; m += NGW) {
        const int b = m >> 13;
        const f32x4* xr = (const f32x4*)(x + (size_t)m * DM) + X.lane;
        f32x4 v[4]; float s = 0.f;
#pragma unroll
        for (int j = 0; j < 4; ++j) { v[j] = xr[64 * j]; s += (v[j].x * v[j].x + v[j].y * v[j].y) + (v[j].z * v[j].z + v[j].w * v[j].w); }
        const float rs = 1.0f / sqrtf(wave_sum(s) * (1.f / DM) + 1e-6f);
        u32x2* o = (u32x2*)(h + (size_t)m * DM) + X.lane;
#pragma unroll
        for (int j = 0; j < 4; ++j) { const int col = 4 * X.lane + 256 * j;
            const f32x4 g = *(const f32x4*)(g1 + col), sh = *(const f32x4*)(mod + b * 6144 + col), sc = *(const f32x4*)(mod + b * 6144 + 1024 + col);
            const f32x4 y = v[j] * rs * g * (1.0f + sc) + sh;
            u32x2 w; w.x = cvt_pk(y.x, y.y); w.y = cvt_pk(y.z, y.w); o[64 * j] = w; }
    }
    {
        const float* g2 = a.in[22]; const float* wgr = a.in[23]; const float* bgr = a.in[24]; const float* wer = a.in[25]; const float* ber = a.in[26];
        bf16* WRH = (bf16*)(a.ws + WS_WRH); bf16* WRL = (bf16*)(a.ws + WS_WRL); float* CB = (float*)(a.ws + WS_CB);
        for (int idx = X.blk * 512 + X.tid; idx < 2 * 48 * 1024; idx += X.nblk * 512) {
            const int k = idx & 1023, o = (idx >> 10) % 48, b = idx / (48 * 1024);
            float wv = 0.f;
            if (o < 4) wv = wgr[k * 4 + o]; else if (o < 36) wv = wer[k * 32 + (o - 4)];
            wv *= g2[k] * (1.0f + mod[b * 6144 + 4096 + k]);
            const bf16 hi = f2bf(wv); const bf16 lo = f2bf(wv - bf2f(hi));
            WRH[idx] = hi; WRL[idx] = lo;
        }
        if (gw < 96) { const int b = gw / 48, o = gw % 48; float s = 0.f;
            if (o < 36) for (int k = X.lane; k < 1024; k += 64) s += mod[b * 6144 + 3072 + k] * (o < 4 ? wgr[k * 4 + o] : wer[k * 32 + (o - 4)]);
            s = wave_sum(s);
            if (X.lane == 0) CB[b * 48 + o] = o < 4 ? s + bgr[o] : (o < 36 ? s + ber[o - 4] : 0.f); }
    }
}

constexpr int HG_CUMLD = 132;
DI float hg_lb_of(const float* hg_lb, int idx) { return 1.0f / (1.0f + __expf(hg_lb[512 + idx] - hg_lb[idx])); }

DI void hg_load_f(const Ctx& X, const bf16* proj, const float* hg_lb, int row0, int hh, LAS float* CUM, float (&f)[16]) {
    const int t = X.tid >> 3, cg = (X.tid & 7) * 16;
    const u32x4* src = (const u32x4*)(proj + (size_t)(row0 + t) * LDP + C_HF + hh * 128 + cg);
    const u32x4 r0 = src[0], r1 = src[1];
    const unsigned w[8] = {r0.x, r0.y, r0.z, r0.w, r1.x, r1.y, r1.z, r1.w};
#pragma unroll
    for (int e = 0; e < 8; ++e) {
        const float lb0 = hg_lb_of(hg_lb, hh * 128 + cg + 2 * e), lb1 = hg_lb_of(hg_lb, hh * 128 + cg + 2 * e + 1);
        f[2 * e] = lb0 + (1.0f - lb0) * sigmoidf_(bflo(w[e])); f[2 * e + 1] = lb1 + (1.0f - lb1) * sigmoidf_(bfhi(w[e]));
    }
#pragma unroll
    for (int e = 0; e < 16; e += 4) *(LAS f32x4*)(CUM + t * HG_CUMLD + cg + e) = (f32x4){__logf(f[e]), __logf(f[e + 1]), __logf(f[e + 2]), __logf(f[e + 3])};
}
DI void hg_scan(const Ctx& X, LAS float* CUM, LAS float* TOT) {
    const int k = X.tid & 127, seg = X.tid >> 7;
    float v[16]; float run = 0.f;
#pragma unroll
    for (int i = 0; i < 16; ++i) { run += CUM[(seg * 16 + i) * HG_CUMLD + k]; v[i] = run; }
    TOT[seg * 128 + k] = run;
    __syncthreads();
    float off = 0.f;
#pragma unroll
    for (int s = 0; s < 3; ++s) off += (s < seg) ? TOT[s * 128 + k] : 0.f;
#pragma unroll
    for (int i = 0; i < 16; ++i) CUM[(seg * 16 + i) * HG_CUMLD + k] = v[i] + off;
    __syncthreads();
}

DI void hg1_unit(const Ctx& X, const Args& a, int u) {
    const bf16* proj = (const bf16*)(a.ws + WS_PROJ);
    const int pair = u >> 7, c = u & 127, b = pair >> 2, hh = pair & 3, row0 = b * SEQ + c * 64;
    LAS float* CUM = (LAS float*)X.lds; LAS float* TOT = (LAS float*)(X.lds + 33792);
    LAS bf16* KDT = (LAS bf16*)(X.lds + 36864); LAS bf16* VT = (LAS bf16*)(X.lds + 55296);
    float f[16];
    hg_load_f(X, proj, a.in[6], row0, hh, CUM, f);
    __syncthreads();
    hg_scan(X, CUM, TOT);
    const int t = X.tid >> 3, cg = (X.tid & 7) * 16;
    if (X.tid < 128) ((float*)(a.ws + WS_HGC))[(size_t)u * 128 + X.tid] = __expf(CUM[63 * HG_CUMLD + X.tid]);
    {
        const u32x4* src = (const u32x4*)(proj + (size_t)(row0 + t) * LDP + C_HI + hh * 128 + cg);
        const u32x4 r0 = src[0], r1 = src[1];
        const unsigned w[8] = {r0.x, r0.y, r0.z, r0.w, r1.x, r1.y, r1.z, r1.w};
#pragma unroll
        for (int e = 0; e < 16; ++e) {
            const int k = cg + e;
            const float kd = (1.0f - f[e]) * __expf(CUM[63 * HG_CUMLD + k] - CUM[t * HG_CUMLD + k]);
            KDT[k * 72 + t] = f2bf(kd);
            VT[k * 72 + t] = (bf16)((e & 1) ? (w[e >> 1] >> 16) : (w[e >> 1] & 0xffffu));
        }
    }
    __syncthreads();
    {
        const int w = X.wave, v0 = 32 * (w >> 1), k0 = 64 * (w & 1), r = X.lane & 15, g = X.lane >> 4;
        f32x4 acc[4][2]; zero_acc(acc);
        mm_ll<4, 2, 2>(KDT + k0 * 72, 72, VT + v0 * 72, 72, acc, X.lane);
        bf16* dst = (bf16*)(a.ws + WS_HS) + (size_t)u * 16384;
#pragma unroll
        for (int tp = 0; tp < 4; ++tp)
#pragma unroll
            for (int tq = 0; tq < 2; ++tq) { u32x2 o; o.x = cvt_pk(acc[tp][tq][0], acc[tp][tq][1]); o.y = cvt_pk(acc[tp][tq][2], acc[tp][tq][3]);
                *(u32x2*)(dst + (v0 + 16 * tq + r) * 128 + k0 + 16 * tp + 4 * g) = o; }
    }
    __syncthreads();
}

DI void hg2_scan(const Ctx& X, const Args& a, bool dry = false) {
    const float* gc = (const float*)(a.ws + WS_HGC);
    for (int it = X.blk * 512 + X.tid; it < 65536; it += X.nblk * 512) {
        const int pair = it >> 13, rem = it & 8191;
        const int kp = rem & 63;
        unsigned* base = (unsigned*)(a.ws + WS_HS) + (size_t)pair * 128 * 8192 + rem;
        const float* gb = gc + (size_t)pair * 128 * 128 + kp * 2;
        float s0 = 0.f, s1 = 0.f;
        for (int cb = 0; cb < 128; cb += 8) {
            unsigned uu[8]; f32x2 gg[8];
#pragma unroll
            for (int i = 0; i < 8; ++i) { uu[i] = base[(size_t)(cb + i) * 8192]; gg[i] = *(const f32x2*)(gb + (cb + i) * 128); }
#pragma unroll
            for (int i = 0; i < 8; ++i) { if (!dry || s0 == 1.2345e33f) base[(size_t)(cb + i) * 8192] = cvt_pk(s0, s1); s0 = gg[i].x * s0 + bflo(uu[i]); s1 = gg[i].y * s1 + bfhi(uu[i]); }
        }
    }
}

DI void hg3_unit(const Ctx& X, const Args& a, int u, bool dry = false) {
    bf16* proj = (bf16*)(a.ws + WS_PROJ);
    const int pair = u >> 7, c = u & 127, b = pair >> 2, hh = pair & 3, row0 = b * SEQ + c * 64;
    LAS float* CUM = (LAS float*)X.lds; LAS float* TOT = (LAS float*)(X.lds + 33792);
    LAS float* RED = (LAS float*)(X.lds + 36352);
    LAS bf16* QD = (LAS bf16*)(X.lds + 36864); LAS bf16* QT = (LAS bf16*)(X.lds + 54272); LAS bf16* KT = (LAS bf16*)(X.lds + 71680);
    LAS bf16* VT = (LAS bf16*)(X.lds + 89088); LAS bf16* PM = (LAS bf16*)(X.lds + 107520);
    float f[16];
    hg_load_f(X, proj, a.in[6], row0, hh, CUM, f);
    __syncthreads();
    hg_scan(X, CUM, TOT);
    {
        const int t = X.tid >> 3, cg = (X.tid & 7) * 16;
        const u32x4* sq = (const u32x4*)(proj + (size_t)(row0 + t) * LDP + C_HQ + hh * 128 + cg);
        const u32x4* sv = (const u32x4*)(proj + (size_t)(row0 + t) * LDP + C_HI + hh * 128 + cg);
        const u32x4 q0 = sq[0], q1 = sq[1], i0 = sv[0], i1 = sv[1];
        const unsigned qw[8] = {q0.x, q0.y, q0.z, q0.w, q1.x, q1.y, q1.z, q1.w};
        const unsigned iw[8] = {i0.x, i0.y, i0.z, i0.w, i1.x, i1.y, i1.z, i1.w};
        unsigned oqd[8], oqt[8], okt[8];
#pragma unroll
        for (int e = 0; e < 8; ++e) {
            float qd[2], qt[2], kt[2];
#pragma unroll
            for (int hb = 0; hb < 2; ++hb) {
                const int k = cg + 2 * e + hb;
                const float cum = CUM[t * HG_CUMLD + k], ref = CUM[31 * HG_CUMLD + k];
                const float qs = siluf_(hb ? bfhi(qw[e]) : bflo(qw[e]));
                qd[hb] = qs * __expf(cum); qt[hb] = qs * __expf(cum - ref); kt[hb] = (1.0f - f[2 * e + hb]) * __expf(ref - cum);
                VT[k * 72 + t] = (bf16)(hb ? (iw[e] >> 16) : (iw[e] & 0xffffu));
            }
            oqd[e] = cvt_pk(qd[0], qd[1]); oqt[e] = cvt_pk(qt[0], qt[1]); okt[e] = cvt_pk(kt[0], kt[1]);
        }
        *(LAS u32x4*)(QD + t * 136 + cg) = (u32x4){oqd[0], oqd[1], oqd[2], oqd[3]}; *(LAS u32x4*)(QD + t * 136 + cg + 8) = (u32x4){oqd[4], oqd[5], oqd[6], oqd[7]};
        *(LAS u32x4*)(QT + t * 136 + cg) = (u32x4){oqt[0], oqt[1], oqt[2], oqt[3]}; *(LAS u32x4*)(QT + t * 136 + cg + 8) = (u32x4){oqt[4], oqt[5], oqt[6], oqt[7]};
        *(LAS u32x4*)(KT + t * 136 + cg) = (u32x4){okt[0], okt[1], okt[2], okt[3]}; *(LAS u32x4*)(KT + t * 136 + cg + 8) = (u32x4){okt[4], okt[5], okt[6], okt[7]};
    }
    __syncthreads();
    const int w = X.wave, r = X.lane & 15, g = X.lane >> 4, tq0 = 16 * (w >> 1);
    {
        f32x4 acc[2][1]; zero_acc(acc);
        const int s0 = 32 * (w & 1);
        mm_ll<2, 1, 4>(KT + s0 * 136, 136, QT + tq0 * 136, 136, acc, X.lane);
        const int t = tq0 + r;
#pragma unroll
        for (int tp = 0; tp < 2; ++tp) { const int sb = s0 + 16 * tp + 4 * g; float v[4];
#pragma unroll
            for (int e = 0; e < 4; ++e) v[e] = (sb + e <= t) ? acc[tp][0][e] : 0.f;
            u32x2 o; o.x = cvt_pk(v[0], v[1]); o.y = cvt_pk(v[2], v[3]); *(LAS u32x2*)(PM + t * 72 + sb) = o; }
    }
    __syncthreads();
    {
        const int v0 = 64 * (w & 1), t = tq0 + r;
        f32x4 acc[4][1]; zero_acc(acc);
        mm_gl<4, 1, 4>((const bf16*)(a.ws + WS_HS) + (size_t)u * 16384 + (size_t)v0 * 128, 128, QD + tq0 * 136, 136, acc, X.lane);
        mm_ll<4, 1, 2>(VT + v0 * 72, 72, PM + tq0 * 72, 72, acc, X.lane);
        float ss = 0.f;
#pragma unroll
        for (int tp = 0; tp < 4; ++tp)
#pragma unroll
            for (int e = 0; e < 4; ++e) ss += acc[tp][0][e] * acc[tp][0][e];
        ss += __shfl_xor(ss, 16); ss += __shfl_xor(ss, 32);
        if (g == 0) RED[t * 2 + (w & 1)] = ss;
        __syncthreads();
        const float rs = 1.0f / sqrtf((RED[t * 2] + RED[t * 2 + 1]) * (1.0f / 128.0f) + 1e-6f);
        const float* ng = a.in[7];
#pragma unroll
        for (int tp = 0; tp < 4; ++tp) { const int v = v0 + 16 * tp + 4 * g;
            const u32x2 gw = *(const u32x2*)(proj + (size_t)(row0 + t) * LDP + C_HG + hh * 128 + v);
            const f32x4 n4 = *(const f32x4*)(ng + hh * 128 + v);
            const float o0 = acc[tp][0][0] * rs * n4.x * siluf_(bflo(gw.x)), o1 = acc[tp][0][1] * rs * n4.y * siluf_(bfhi(gw.x));
            const float o2 = acc[tp][0][2] * rs * n4.z * siluf_(bflo(gw.y)), o3 = acc[tp][0][3] * rs * n4.w * siluf_(bfhi(gw.y));
            u32x2 o; o.x = cvt_pk(o0, o1); o.y = cvt_pk(o2, o3);
            if (dry) *(u32x2*)((bf16*)a.out + (size_t)16 * 1024 * 1024 + (size_t)(row0 + t) * 512 + hh * 128 + v) = o;
            else *(u32x2*)(proj + (size_t)(row0 + t) * LDP + C_HQ + hh * 128 + v) = o; }
    }
    __syncthreads();
}

constexpr int R_AT = 0, R_RT = 9216, R_BH = 18432, R_KH = 27648, R_BHT = 36864, R_KHT = 46080, R_VT = 55296, R_AAK = 64512, R_ARB = 73728, R_ARK = 82944,
              R_WT = 92160, R_U0T = 101376, R_XB = 110592, R_CUM = 144384, R_GC = 161792;
constexpr int R_LW = 64512, R_LA = 69632, R_W2T = 74752, R_A2T = 79872;
constexpr int R_TOT = 92160, R_RED = 94208;
constexpr int XBLD = 132, CUMLD = 68;

DI f32x4 rw_shift4(const bf16* proj, const float* mu, int row, int col, bool first) {
    const u32x2 cw = *(const u32x2*)(proj + (size_t)row * LDP + col);
    u32x2 pw = (u32x2){0u, 0u};
    if (!first) pw = *(const u32x2*)(proj + (size_t)(row - 1) * LDP + col);
    const f32x4 m = *(const f32x4*)(mu + (col - C_RR));
    const f32x4 c = (f32x4){bflo(cw.x), bfhi(cw.x), bflo(cw.y), bfhi(cw.y)}, p = (f32x4){bflo(pw.x), bfhi(pw.x), bflo(pw.y), bfhi(pw.y)};
    return c + m * (p - c);
}

DI void rw_subst_col(const LAS float* AAB, LAS float* XB, int cidx) {
    for (int bk = 0; bk < 4; ++bk) {
        const int t0 = 16 * bk;
        float acc[16];
#pragma unroll
        for (int i = 0; i < 16; ++i) acc[i] = XB[(t0 + i) * XBLD + cidx];
        for (int s = 0; s < t0; s += 4) {
            const float x0 = XB[(s + 0) * XBLD + cidx], x1 = XB[(s + 1) * XBLD + cidx], x2 = XB[(s + 2) * XBLD + cidx], x3 = XB[(s + 3) * XBLD + cidx];
#pragma unroll
            for (int i = 0; i < 16; ++i) { const f32x4 a4 = *(const LAS f32x4*)(AAB + (t0 + i) * CUMLD + s); acc[i] += (a4[0] * x0 + a4[1] * x1) + (a4[2] * x2 + a4[3] * x3); }
        }
#pragma unroll
        for (int i = 1; i < 16; ++i) {
#pragma unroll
            for (int s4 = 0; s4 < (i + 3) / 4; ++s4) { const f32x4 a4 = *(const LAS f32x4*)(AAB + (t0 + i) * CUMLD + t0 + 4 * s4);
#pragma unroll
                for (int e = 0; e < 4; ++e) if (4 * s4 + e < i) acc[i] += a4[e] * acc[4 * s4 + e]; }
        }
#pragma unroll
        for (int i = 0; i < 16; ++i) XB[(t0 + i) * XBLD + cidx] = acc[i];
    }
}

DI void rw1_unit(const Ctx& X, const Args& a, int u) {
    const bf16* proj = (const bf16*)(a.ws + WS_PROJ);
    const float* mu = a.in[8];
    const int pair = u >> 7, c = u & 127, b = pair >> 3, h = pair & 7, row0 = b * SEQ + c * 64;
    LAS unsigned char* L = X.lds;
    LAS bf16 *AT = (LAS bf16*)(L + R_AT), *RT = (LAS bf16*)(L + R_RT), *BH = (LAS bf16*)(L + R_BH), *KH = (LAS bf16*)(L + R_KH), *BHT = (LAS bf16*)(L + R_BHT), *KHT = (LAS bf16*)(L + R_KHT),
             *VT = (LAS bf16*)(L + R_VT), *AAK = (LAS bf16*)(L + R_AAK), *ARB = (LAS bf16*)(L + R_ARB), *ARK = (LAS bf16*)(L + R_ARK), *WT = (LAS bf16*)(L + R_WT), *U0T = (LAS bf16*)(L + R_U0T),
             *LW = (LAS bf16*)(L + R_LW), *LA = (LAS bf16*)(L + R_LA), *W2T = (LAS bf16*)(L + R_W2T), *A2T = (LAS bf16*)(L + R_A2T);
    LAS float *XB = (LAS float*)(L + R_XB), *CUM = (LAS float*)(L + R_CUM), *GC = (LAS float*)(L + R_GC), *TOT = (LAS float*)(L + R_TOT), *RED = (LAS float*)(L + R_RED);
    const int w = X.wave, r = X.lane & 15, g = X.lane >> 4;
    {
        const int t = X.tid >> 3, c8 = (X.tid & 7) * 8; const bool first = (c == 0 && t == 0);
        const f32x4 v0 = rw_shift4(proj, mu, row0 + t, C_WD + c8, first), v1 = rw_shift4(proj, mu, row0 + t, C_WD + c8 + 4, first);
        if (c8 < 32) { u32x4 o; o.x = cvt_pk(tanhf(v0.x), tanhf(v0.y)); o.y = cvt_pk(tanhf(v0.z), tanhf(v0.w)); o.z = cvt_pk(tanhf(v1.x), tanhf(v1.y)); o.w = cvt_pk(tanhf(v1.z), tanhf(v1.w));
            *(LAS u32x4*)(LW + t * 40 + c8) = o; }
        else { u32x4 o; o.x = cvt_pk(v0.x, v0.y); o.y = cvt_pk(v0.z, v0.w); o.z = cvt_pk(v1.x, v1.y); o.w = cvt_pk(v1.z, v1.w);
            *(LAS u32x4*)(LA + t * 40 + (c8 - 32)) = o; }
        const int m = X.tid >> 4, j4 = (X.tid & 15) * 4;
        const f32x4 w2 = *(const f32x4*)(a.in[10] + m * 512 + h * 64 + j4), a2 = *(const f32x4*)(a.in[12] + m * 512 + h * 64 + j4);
#pragma unroll
        for (int e = 0; e < 4; ++e) { W2T[(j4 + e) * 40 + m] = f2bf(w2[e]); A2T[(j4 + e) * 40 + m] = f2bf(a2[e]); }
    }
    __syncthreads();
    const int t = 16 * (w >> 1) + r, jb = 32 * (w & 1) + 4 * g;
    float rs_[8], kf_[8], vs_[8], kkv_[8], aa_[8], lw_[8];
    {
        f32x4 accw[2][1], acca[2][1]; zero_acc(accw); zero_acc(acca);
        mm_ll<2, 1, 1>(W2T + 32 * (w & 1) * 40, 40, LW + 16 * (w >> 1) * 40, 40, accw, X.lane);
        mm_ll<2, 1, 1>(A2T + 32 * (w & 1) * 40, 40, LA + 16 * (w >> 1) * 40, 40, acca, X.lane);
        const bool first = (c == 0 && t == 0);
        float ss = 0.f, bon = 0.f;
#pragma unroll
        for (int i = 0; i < 2; ++i) {
            const int j = jb + 16 * i, col = h * 64 + j;
            const f32x4 rr = rw_shift4(proj, mu, row0 + t, C_RR + col, first), kk = rw_shift4(proj, mu, row0 + t, C_RK + col, first), vv = rw_shift4(proj, mu, row0 + t, C_RV + col, first);
            const f32x4 w0 = *(const f32x4*)(a.in[9] + col), a0 = *(const f32x4*)(a.in[11] + col), k_k = *(const f32x4*)(a.in[14] + col), k_a = *(const f32x4*)(a.in[15] + col), r_k = *(const f32x4*)(a.in[16] + col);
            f32x4 lw4;
#pragma unroll
            for (int e = 0; e < 4; ++e) {
                const float y = -(w0[e] + accw[i][0][e]);
                const float sp = fmaxf(y, 0.f) + log1pf(__expf(-fabsf(y)));
                const float wlog = -sp - 0.5f;
                const float lw = -__expf(wlog);
                const float aa = sigmoidf_(a0[e] + acca[i][0][e]);
                const float kkv = kk[e] * k_k[e];
                const float kf = kk[e] * (1.0f + (aa - 1.0f) * k_a[e]);
                ss += kkv * kkv; bon += rr[e] * kf * r_k[e];
                rs_[4 * i + e] = rr[e]; kf_[4 * i + e] = kf; vs_[4 * i + e] = vv[e]; kkv_[4 * i + e] = kkv; aa_[4 * i + e] = aa; lw_[4 * i + e] = lw; lw4[e] = lw;
            }
            *(LAS f32x4*)(CUM + t * CUMLD + j) = lw4;
        }
        ss += __shfl_xor(ss, 16); ss += __shfl_xor(ss, 32); bon += __shfl_xor(bon, 16); bon += __shfl_xor(bon, 32);
        if (g == 0) { RED[(t * 2 + (w & 1)) * 2] = ss; RED[(t * 2 + (w & 1)) * 2 + 1] = bon; }
    }
    __syncthreads();
    {
        const int j = X.tid & 63, seg = X.tid >> 6; float v[8]; float run = 0.f;
#pragma unroll
        for (int i = 0; i < 8; ++i) { run += CUM[(seg * 8 + i) * CUMLD + j]; v[i] = run; }
        TOT[seg * 64 + j] = run;
        __syncthreads();
        float off = 0.f;
#pragma unroll
        for (int s = 0; s < 7; ++s) off += (s < seg) ? TOT[s * 64 + j] : 0.f;
#pragma unroll
        for (int i = 0; i < 8; ++i) CUM[(seg * 8 + i) * CUMLD + j] = v[i] + off;
        if (seg == 7) { const float gc = __expf(v[7] + off); GC[j] = gc; ((float*)(a.ws + WS_RGC))[(size_t)u * 64 + j] = gc; }
    }
    __syncthreads();
    {
        const float ssT = RED[(t * 2) * 2] + RED[(t * 2 + 1) * 2];
        const float inv = 1.0f / sqrtf(fmaxf(ssT, 1e-24f));
        if (g == 0 && (w & 1) == 0) ((float*)(a.ws + WS_BONUS))[(size_t)(row0 + t) * 8 + h] = RED[(t * 2) * 2 + 1] + RED[(t * 2 + 1) * 2 + 1];
#pragma unroll
        for (int i = 0; i < 2; ++i) {
            const int j = jb + 16 * i;
            const f32x4 cum = *(const LAS f32x4*)(CUM + t * CUMLD + j);
            float at[4], rt[4], bh[4], kh[4];
#pragma unroll
            for (int e = 0; e < 4; ++e) {
                const float kkn = kkv_[4 * i + e] * inv;
                const float eneg = __expf(-cum[e]);
                at[e] = -kkn * __expf(cum[e] - lw_[4 * i + e]); rt[e] = rs_[4 * i + e] * __expf(cum[e]);
                bh[e] = kkn * aa_[4 * i + e] * eneg; kh[e] = kf_[4 * i + e] * eneg;
                BHT[(j + e) * 72 + t] = f2bf(bh[e]); KHT[(j + e) * 72 + t] = f2bf(kh[e]); VT[(j + e) * 72 + t] = f2bf(vs_[4 * i + e]);
            }
            *(LAS u32x2*)(AT + t * 72 + j) = (u32x2){cvt_pk(at[0], at[1]), cvt_pk(at[2], at[3])};
            *(LAS u32x2*)(RT + t * 72 + j) = (u32x2){cvt_pk(rt[0], rt[1]), cvt_pk(rt[2], rt[3])};
            *(LAS u32x2*)(BH + t * 72 + j) = (u32x2){cvt_pk(bh[0], bh[1]), cvt_pk(bh[2], bh[3])};
            *(LAS u32x2*)(KH + t * 72 + j) = (u32x2){cvt_pk(kh[0], kh[1]), cvt_pk(kh[2], kh[3])};
            *(LAS f32x4*)(XB + t * XBLD + j) = (f32x4){at[0], at[1], at[2], at[3]};
        }
    }
    __syncthreads();
    {
        LAS float* AAB = CUM;
        const int tq0 = 16 * (w >> 1), s0 = 32 * (w & 1);
        f32x4 ab[2][1], ak[2][1], rb[2][1], rk[2][1]; zero_acc(ab); zero_acc(ak); zero_acc(rb); zero_acc(rk);
        mm_ll<2, 1, 2>(BH + s0 * 72, 72, AT + tq0 * 72, 72, ab, X.lane);
        mm_ll<2, 1, 2>(KH + s0 * 72, 72, AT + tq0 * 72, 72, ak, X.lane);
        mm_ll<2, 1, 2>(BH + s0 * 72, 72, RT + tq0 * 72, 72, rb, X.lane);
        mm_ll<2, 1, 2>(KH + s0 * 72, 72, RT + tq0 * 72, 72, rk, X.lane);
#pragma unroll
        for (int tp = 0; tp < 2; ++tp) { const int sb = s0 + 16 * tp + 4 * g; f32x4 vab; float vak[4], vrb[4], vrk[4];
#pragma unroll
            for (int e = 0; e < 4; ++e) { const bool lo = (sb + e < t), le = (sb + e <= t);
                vab[e] = lo ? ab[tp][0][e] : 0.f; vak[e] = lo ? ak[tp][0][e] : 0.f; vrb[e] = le ? rb[tp][0][e] : 0.f; vrk[e] = le ? rk[tp][0][e] : 0.f; }
            *(LAS f32x4*)(AAB + t * CUMLD + sb) = vab;
            *(LAS u32x2*)(AAK + t * 72 + sb) = (u32x2){cvt_pk(vak[0], vak[1]), cvt_pk(vak[2], vak[3])};
            *(LAS u32x2*)(ARB + t * 72 + sb) = (u32x2){cvt_pk(vrb[0], vrb[1]), cvt_pk(vrb[2], vrb[3])};
            *(LAS u32x2*)(ARK + t * 72 + sb) = (u32x2){cvt_pk(vrk[0], vrk[1]), cvt_pk(vrk[2], vrk[3])}; }
    }
    __syncthreads();
    {
        const int tq0 = 16 * (w >> 1), i0 = 32 * (w & 1);
        f32x4 acc[2][1]; zero_acc(acc);
        mm_ll<2, 1, 2>(VT + i0 * 72, 72, AAK + tq0 * 72, 72, acc, X.lane);
#pragma unroll
        for (int tp = 0; tp < 2; ++tp) *(LAS f32x4*)(XB + t * XBLD + 64 + i0 + 16 * tp + 4 * g) = acc[tp][0];
    }
    __syncthreads();
    if (w < 2) {
        const int cidx = w * 64 + X.lane;
        rw_subst_col(CUM, XB, cidx);
        LAS bf16* dst = (w == 0 ? WT : U0T) + X.lane * 72;
#pragma unroll
        for (int q = 0; q < 8; ++q) { float x[8];
#pragma unroll
            for (int e = 0; e < 8; ++e) x[e] = XB[(8 * q + e) * XBLD + cidx];
            *(LAS u32x4*)(dst + 8 * q) = (u32x4){cvt_pk(x[0], x[1]), cvt_pk(x[2], x[3]), cvt_pk(x[4], x[5]), cvt_pk(x[6], x[7])}; }
    }
    __syncthreads();
    {
        bf16* out = (bf16*)(a.ws + WS_RM) + (size_t)u * 16384;
        const int q0 = 16 * (w >> 1), p0 = 32 * (w & 1), qq = q0 + r;
        f32x4 accG[2][1], accY[2][1], accM[2][1], accN[2][1]; zero_acc(accG); zero_acc(accY); zero_acc(accM); zero_acc(accN);
        mm_ll<2, 1, 2>(WT + p0 * 72, 72, ARB + q0 * 72, 72, accG, X.lane);
        mm_ll<2, 1, 2>(U0T + p0 * 72, 72, ARB + q0 * 72, 72, accY, X.lane);
        mm_ll<2, 1, 2>(VT + p0 * 72, 72, ARK + q0 * 72, 72, accY, X.lane);
        mm_ll<2, 1, 2>(WT + p0 * 72, 72, BHT + q0 * 72, 72, accM, X.lane);
        mm_ll<2, 1, 2>(BHT + p0 * 72, 72, U0T + q0 * 72, 72, accN, X.lane);
        mm_ll<2, 1, 2>(KHT + p0 * 72, 72, VT + q0 * 72, 72, accN, X.lane);
        const float gq = GC[qq];
        unsigned mw[4], nw_[4];
#pragma unroll
        for (int tp = 0; tp < 2; ++tp) { const int pp = p0 + 16 * tp + 4 * g;
            const u32x2 rtw = *(const LAS u32x2*)(RT + qq * 72 + pp);
            const f32x4 gp = *(const LAS f32x4*)(GC + pp);
            const f32x4 G4 = accG[tp][0] + (f32x4){bflo(rtw.x), bfhi(rtw.x), bflo(rtw.y), bfhi(rtw.y)};
            const f32x4 M4 = accM[tp][0] * gq, N4 = accN[tp][0] * gp;
            mw[2 * tp] = cvt_pk(M4[0], M4[1]); mw[2 * tp + 1] = cvt_pk(M4[2], M4[3]);
            nw_[2 * tp] = cvt_pk(N4[0], N4[1]); nw_[2 * tp + 1] = cvt_pk(N4[2], N4[3]);
            *(u32x2*)(out + 2 * 4096 + qq * 64 + pp) = (u32x2){cvt_pk(G4[0], G4[1]), cvt_pk(G4[2], G4[3])};
            *(u32x2*)(out + 3 * 4096 + qq * 64 + pp) = (u32x2){cvt_pk(accY[tp][0][0], accY[tp][0][1]), cvt_pk(accY[tp][0][2], accY[tp][0][3])}; }
        *(u32x4*)(out + 0 * 4096 + X.tid * 8) = (u32x4){mw[0], mw[1], mw[2], mw[3]};
        *(u32x4*)(out + 1 * 4096 + ((w >> 1) * 64 + X.lane) * 16 + (w & 1) * 8) = (u32x4){nw_[0], nw_[1], nw_[2], nw_[3]};
    }
    __syncthreads();
}

constexpr int R2D = 4;
DI void rw2_chain(const Ctx& X, const Args& a, int ch) {
    const int pair = ch >> 2, it = ch & 3, r = X.lane & 15, g = X.lane >> 4, i = 16 * it + r;
    const bf16* RM = (const bf16*)(a.ws + WS_RM); bf16* RS = (bf16*)(a.ws + WS_RS);
    LAS float* GCL = (LAS float*)X.lds;
    { const f32x4* src = (const f32x4*)((const float*)(a.ws + WS_RGC) + (size_t)pair * 128 * 64);
      for (int q = X.lane; q < 2048; q += 64) *(LAS f32x4*)(GCL + 4 * q) = src[q]; }
    f32x4 acc[4];
#pragma unroll
    for (int pt = 0; pt < 4; ++pt) acc[pt] = (f32x4){0.f, 0.f, 0.f, 0.f};
    u32x4 mreg[R2D][8], nreg[R2D][2];
#define R2_LOAD(s, c) do { const bf16* M_ = RM + ((size_t)pair * 128 + (c)) * 16384; \
        _Pragma("unroll") for (int q = 0; q < 8; ++q) mreg[s][q] = *(const u32x4*)(M_ + (q * 64 + X.lane) * 8); \
        _Pragma("unroll") for (int q = 0; q < 2; ++q) nreg[s][q] = *(const u32x4*)(M_ + 4096 + (it * 64 + X.lane) * 16 + q * 8); } while (0)
#pragma unroll
    for (int s = 0; s < R2D; ++s) R2_LOAD(s, s);
    LDS_WAIT();
    for (int c0 = 0; c0 < 128; c0 += R2D) {
#pragma unroll
        for (int s = 0; s < R2D; ++s) {
            const int c = c0 + s; const size_t u = (size_t)pair * 128 + c;
            f32x4 nw[4];
#pragma unroll
            for (int pt = 0; pt < 4; ++pt) { const unsigned lo = nreg[s][pt >> 1][(pt & 1) * 2], hi = nreg[s][pt >> 1][(pt & 1) * 2 + 1];
                const f32x4 gcv = *(const LAS f32x4*)(GCL + c * 64 + 16 * pt + 4 * g);
                nw[pt] = (f32x4){bflo(lo), bfhi(lo), bflo(hi), bfhi(hi)} + gcv * acc[pt]; }
            unsigned pk[4][2];
#pragma unroll
            for (int pt = 0; pt < 4; ++pt) { pk[pt][0] = cvt_pk(acc[pt][0], acc[pt][1]); pk[pt][1] = cvt_pk(acc[pt][2], acc[pt][3]);
                *(u32x2*)(RS + u * 4096 + i * 64 + 16 * pt + 4 * g) = (u32x2){pk[pt][0], pk[pt][1]}; }
            const bf16x8 sf0 = __builtin_bit_cast(bf16x8, (u32x4){pk[0][0], pk[0][1], pk[1][0], pk[1][1]});
            const bf16x8 sf1 = __builtin_bit_cast(bf16x8, (u32x4){pk[2][0], pk[2][1], pk[3][0], pk[3][1]});
#pragma unroll
            for (int pt = 0; pt < 4; ++pt) { nw[pt] = mfma16(__builtin_bit_cast(bf16x8, mreg[s][2 * pt]), sf0, nw[pt]); nw[pt] = mfma16(__builtin_bit_cast(bf16x8, mreg[s][2 * pt + 1]), sf1, nw[pt]); acc[pt] = nw[pt]; }
            if (c + R2D < 128) R2_LOAD(s, c + R2D);
        }
    }
#undef R2_LOAD
}

DI void rw3_unit(const Ctx& X, const Args& a, int u) {
    bf16* proj = (bf16*)(a.ws + WS_PROJ);
    const float* mu = a.in[8];
    const int pair = u >> 7, c = u & 127, b = pair >> 3, h = pair & 7, row0 = b * SEQ + c * 64;
    LAS bf16* SG = (LAS bf16*)X.lds;
    LAS bf16* G2T = (LAS bf16*)(X.lds + 13312);
    LAS float* RED = (LAS float*)(X.lds + 26624);
    const int w = X.wave, r = X.lane & 15, g = X.lane >> 4;
    for (int idx = X.tid; idx < 64 * 24; idx += 512) {
        const int t = idx / 24, c4 = (idx % 24) * 4; const bool first = (c == 0 && t == 0);
        const f32x4 v = rw_shift4(proj, mu, row0 + t, C_GD + c4, first);
        *(LAS u32x2*)(SG + t * 104 + c4) = (u32x2){cvt_pk(sigmoidf_(v.x), sigmoidf_(v.y)), cvt_pk(sigmoidf_(v.z), sigmoidf_(v.w))};
    }
    for (int idx = X.tid; idx < 96 * 16; idx += 512) {
        const int m = idx >> 4, j4 = (idx & 15) * 4;
        const f32x4 g2 = *(const f32x4*)(a.in[13] + m * 512 + h * 64 + j4);
#pragma unroll
        for (int e = 0; e < 4; ++e) G2T[(j4 + e) * 104 + m] = f2bf(g2[e]);
    }
    __syncthreads();
    const int t = 16 * (w >> 1) + r, i0 = 32 * (w & 1);
    const bf16* RMu = (const bf16*)(a.ws + WS_RM) + (size_t)u * 16384;
    f32x4 acc[2][1], gg[2][1]; zero_acc(acc); zero_acc(gg);
    mm_gg<2, 1, 2>((const bf16*)(a.ws + WS_RS) + (size_t)u * 4096 + (size_t)i0 * 64, 64, RMu + 2 * 4096 + 16 * (w >> 1) * 64, 64, acc, X.lane);
    mm_ll<2, 1, 3>(G2T + i0 * 104, 104, SG + 16 * (w >> 1) * 104, 104, gg, X.lane);
    float s = 0.f;
#pragma unroll
    for (int tp = 0; tp < 2; ++tp) { const u32x2 y0 = *(const u32x2*)(RMu + 3 * 4096 + t * 64 + i0 + 16 * tp + 4 * g);
        acc[tp][0] += (f32x4){bflo(y0.x), bfhi(y0.x), bflo(y0.y), bfhi(y0.y)};
        s += (acc[tp][0][0] + acc[tp][0][1]) + (acc[tp][0][2] + acc[tp][0][3]); }
    s += __shfl_xor(s, 16); s += __shfl_xor(s, 32);
    if (g == 0) RED[(t * 2 + (w & 1)) * 2] = s;
    __syncthreads();
    const float mean = (RED[(t * 2) * 2] + RED[(t * 2 + 1) * 2]) * (1.0f / 64.0f);
    float q = 0.f;
#pragma unroll
    for (int tp = 0; tp < 2; ++tp)
#pragma unroll
        for (int e = 0; e < 4; ++e) { const float d = acc[tp][0][e] - mean; q += d * d; }
    q += __shfl_xor(q, 16); q += __shfl_xor(q, 32);
    if (g == 0) RED[(t * 2 + (w & 1)) * 2 + 1] = q;
    __syncthreads();
    const float rstd = 1.0f / sqrtf((RED[(t * 2) * 2 + 1] + RED[(t * 2 + 1) * 2 + 1]) * (1.0f / 64.0f) + 64e-5f);
    const float bonus = ((const float*)(a.ws + WS_BONUS))[(size_t)(row0 + t) * 8 + h];
    const bool first = (c == 0 && t == 0);
#pragma unroll
    for (int tp = 0; tp < 2; ++tp) { const int i = i0 + 16 * tp + 4 * g, col = h * 64 + i;
        const f32x4 vv = rw_shift4(proj, mu, row0 + t, C_RV + col, first);
        const f32x4 gw = *(const f32x4*)(a.in[17] + col), gb = *(const f32x4*)(a.in[18] + col);
        f32x4 o;
#pragma unroll
        for (int e = 0; e < 4; ++e) o[e] = ((acc[tp][0][e] - mean) * rstd * gw[e] + gb[e] + bonus * vv[e]) * gg[tp][0][e];
        *(u32x2*)(proj + (size_t)(row0 + t) * LDP + C_RR + col) = (u32x2){cvt_pk(o[0], o[1]), cvt_pk(o[2], o[3])}; }
    __syncthreads();
}

namespace epi {
using pg8::Unit; using pg8::BM; using pg8::HALF;
struct InProj {
    static constexpr bool PERM = true, AFTER_DRAIN = false;
    bf16* proj; bf16* ga; bf16* gb;
    DI void operator()(const f32x4 (&acc)[2][2][4][2], const Unit& u, int wr, int wc, int fr, int fq) const {
        const int row0 = u.pm * BM + wr * 64 + fr;
        const bool gate = u.pn >= 15;
        bf16* base = !gate ? proj + u.pn * BM : (u.pn < 19 ? ga + (u.pn - 15) * BM : gb + (u.pn - 19) * BM);
        const int ldc = gate ? 1024 : LDP, col0 = wc * 32 + 8 * fq;
#pragma unroll
        for (int ai = 0; ai < 2; ++ai)
#pragma unroll
            for (int m = 0; m < 4; ++m) { bf16* rowp = base + (size_t)(row0 + ai * HALF + m * 16) * ldc + col0;
#pragma unroll
                for (int bj = 0; bj < 2; ++bj) { f32x4 v0 = acc[ai][bj][m][0], v1 = acc[ai][bj][m][1];
                    if (gate) {
#pragma unroll
                        for (int e = 0; e < 4; ++e) { v0[e] = sigmoidf_(v0[e]); v1[e] = sigmoidf_(v1[e]); } }
                    *(u32x4*)(rowp + bj * HALF) = (u32x4){cvt_pk(v0[0], v0[1]), cvt_pk(v0[2], v0[3]), cvt_pk(v1[0], v1[1]), cvt_pk(v1[2], v1[3])}; } }
    }
};
template <bool ADD> struct GateMix {
    static constexpr bool PERM = true, AFTER_DRAIN = false;
    bf16* O; int ldc; const bf16* gate; int ldg;
    DI void operator()(const f32x4 (&acc)[2][2][4][2], const Unit& u, int wr, int wc, int fr, int fq) const {
        const int row0 = u.pm * BM + wr * 64 + fr, col0 = u.pn * BM + wc * 32 + 8 * fq;
#pragma unroll
        for (int ai = 0; ai < 2; ++ai)
#pragma unroll
            for (int m = 0; m < 4; ++m) { const size_t row = (size_t)(row0 + ai * HALF + m * 16);
#pragma unroll
                for (int bj = 0; bj < 2; ++bj) { const f32x4 v0 = acc[ai][bj][m][0], v1 = acc[ai][bj][m][1];
                    const u32x4 gw = *(const u32x4*)(gate + row * ldg + col0 + bj * HALF);
                    float o[8] = {v0[0] * bflo(gw.x), v0[1] * bfhi(gw.x), v0[2] * bflo(gw.y), v0[3] * bfhi(gw.y), v1[0] * bflo(gw.z), v1[1] * bfhi(gw.z), v1[2] * bflo(gw.w), v1[3] * bfhi(gw.w)};
                    bf16* op = O + row * ldc + col0 + bj * HALF;
                    if (ADD) { const u32x4 pw = *(const u32x4*)op;
                        o[0] += bflo(pw.x); o[1] += bfhi(pw.x); o[2] += bflo(pw.y); o[3] += bfhi(pw.y); o[4] += bflo(pw.z); o[5] += bfhi(pw.z); o[6] += bflo(pw.w); o[7] += bfhi(pw.w); }
                    *(u32x4*)op = (u32x4){cvt_pk(o[0], o[1]), cvt_pk(o[2], o[3]), cvt_pk(o[4], o[5]), cvt_pk(o[6], o[7])}; } }
    }
};
struct Resid {
    static constexpr bool PERM = false, AFTER_DRAIN = false;
    const float* base; float* C; const float* gt;
    DI void operator()(const f32x4 (&acc)[2][2][4][2], const Unit& u, int wr, int wc, int fr, int fq) const {
        const int row0 = u.pm * BM + wr * 64 + fr, col0 = u.pn * BM + wc * 32 + 4 * fq;
        const int b = (u.pm * BM) >> 13;
        f32x4 gv[2][2];
#pragma unroll
        for (int bj = 0; bj < 2; ++bj)
#pragma unroll
            for (int n = 0; n < 2; ++n) gv[bj][n] = *(const f32x4*)(gt + b * 6144 + col0 + bj * HALF + n * 16);
#pragma unroll
        for (int ai = 0; ai < 2; ++ai)
#pragma unroll
            for (int m = 0; m < 4; ++m) { const size_t off = (size_t)(row0 + ai * HALF + m * 16) * DM + col0;
#pragma unroll
                for (int bj = 0; bj < 2; ++bj)
#pragma unroll
                    for (int n = 0; n < 2; ++n) { const f32x4 bs = *(const f32x4*)(base + off + bj * HALF + n * 16);
                        *(f32x4*)(C + off + bj * HALF + n * 16) = bs + gv[bj][n] * acc[ai][bj][m][n]; } }
    }
};
struct SwiGlu {
    static constexpr bool PERM = true, AFTER_DRAIN = false;
    bf16* O;
    DI void operator()(const f32x4 (&acc)[2][2][4][2], const Unit& u, int wr, int wc, int fr, int fq) const {
        const int row0 = u.pm * BM + wr * 64 + fr, col0 = (u.pn & 3) * 128 + wc * 32 + 8 * fq;
#pragma unroll
        for (int ai = 0; ai < 2; ++ai)
#pragma unroll
            for (int m = 0; m < 4; ++m) { const f32x4 g0 = acc[ai][0][m][0], g1 = acc[ai][0][m][1], u0 = acc[ai][1][m][0], u1 = acc[ai][1][m][1];
                u32x4 w; w.x = cvt_pk(siluf_(g0[0]) * u0[0], siluf_(g0[1]) * u0[1]); w.y = cvt_pk(siluf_(g0[2]) * u0[2], siluf_(g0[3]) * u0[3]);
                w.z = cvt_pk(siluf_(g1[0]) * u1[0], siluf_(g1[1]) * u1[1]); w.w = cvt_pk(siluf_(g1[2]) * u1[2], siluf_(g1[3]) * u1[3]);
                *(u32x4*)(O + (size_t)(row0 + ai * HALF + m * 16) * 512 + col0) = w; }
    }
};
struct MoeOut {
    static constexpr bool PERM = true, AFTER_DRAIN = false;
    bf16* O;
    DI void operator()(const f32x4 (&acc)[2][2][4][2], const Unit& u, int wr, int wc, int fr, int fq) const {
        const int row0 = u.pm * BM + wr * 64 + fr, col0 = (u.pn & 3) * BM + wc * 32 + 8 * fq;
#pragma unroll
        for (int ai = 0; ai < 2; ++ai)
#pragma unroll
            for (int m = 0; m < 4; ++m) { bf16* rowp = O + (size_t)(row0 + ai * HALF + m * 16) * DM + col0;
#pragma unroll
                for (int bj = 0; bj < 2; ++bj) { const f32x4 v0 = acc[ai][bj][m][0], v1 = acc[ai][bj][m][1];
                    *(u32x4*)(rowp + bj * HALF) = (u32x4){cvt_pk(v0[0], v0[1]), cvt_pk(v0[2], v0[3]), cvt_pk(v1[0], v1[1]), cvt_pk(v1[2], v1[3])}; } }
    }
};
struct MoeOrder {
    const LAS int* tile_e; int ntiles, G, c;
    DI bool next(int i, Unit& u) const { const int L = i * G + c; if (L >= ntiles * 4) return false; const int pm = L >> 2; u.pm = pm; u.pn = tile_e[pm] * 4 + (L & 3); return true; }
    DI void a_ready(const Unit&) const {}
    DI void done(const Unit&) const {}
};
}

constexpr int L_TILE_E = 131072, L_PADSTART = 131072 + 1024, L_NTILES = 131072 + 1024 + 256;
DI void moe_tables(const Ctx& X, const Args& a) {
    LAS int* tile_e = (LAS int*)(X.lds + L_TILE_E); LAS int* pad_start = (LAS int*)(X.lds + L_PADSTART); LAS int* ntl = (LAS int*)(X.lds + L_NTILES);
    if (X.tid == 0) {
        const unsigned* cnt = (const unsigned*)(a.ws + WS_CTL) + CW_ECNT; int tiles = 0;
        for (int e = 0; e < 32; ++e) { const int n = (int)__hip_atomic_load(cnt + e, __ATOMIC_RELAXED, __HIP_MEMORY_SCOPE_AGENT); const int nt = (n + 255) >> 8;
            pad_start[e] = tiles * 256; for (int q = 0; q < nt; ++q) tile_e[tiles + q] = e; tiles += nt; }
        pad_start[32] = tiles * 256; ntl[0] = tiles;
    }
    __syncthreads();
}

DI void phase_expert_weights(const Ctx& X, const Args& a) {
    LAS float* scr = (LAS float*)(X.lds + X.wave * 16384);
    const int gw = X.blk * 8 + X.wave, NGW = X.nblk * 8;
    bf16* WGU = (bf16*)(a.ws + WS_EWGU); bf16* WD = (bf16*)(a.ws + WS_EWD);
    for (int it = gw; it < 3 * 8192; it += NGW) {
        const int which = it >> 13, r = it & 8191, e = r >> 8, q = r & 255;
        if (which < 2) { const int kb = q >> 4, nb = q & 15;
            transpose_item(a.in[27 + which] + (size_t)e * 1024 * 512, 512, nb * 32, kb * 64, WGU + ((size_t)e * 1024 + (nb >> 2) * 256 + which * 128 + (nb & 3) * 32) * 1024, 1024, false, scr, X.lane); }
        else { const int kb = q >> 5, nb = q & 31;
            transpose_item(a.in[29] + (size_t)e * 512 * 1024, 1024, nb * 32, kb * 64, WD + ((size_t)e * 1024 + nb * 32) * 512, 512, false, scr, X.lane); }
    }
}

DI void phase_router(const Ctx& X, const Args& a, bool dry = false) {
    const float* x1 = a.out;
    const bf16* WRH = (const bf16*)(a.ws + WS_WRH); const bf16* WRL = (const bf16*)(a.ws + WS_WRL); const float* CB = (const float*)(a.ws + WS_CB);
    LAS float* PLG = (LAS float*)X.lds;
    LAS float* PSS = (LAS float*)(X.lds + 24576);
    LAS int* EL = (LAS int*)(X.lds + 25088);
    LAS int* PL = (LAS int*)(X.lds + 25600);
    unsigned* cnt = (unsigned*)(a.ws + WS_CTL) + CW_ECNT;
    const int w = X.wave, r = X.lane & 15, g = X.lane >> 4, tg = w & 3, kh = w >> 2;
    for (int tb = X.blk; tb < 256; tb += X.nblk) {
        const int m = tb * 64 + 16 * tg + r, b = (tb * 64) >> 13;
        const float* xp = x1 + (size_t)m * DM + 512 * kh + 8 * g;
        const bf16* wh = WRH + ((size_t)b * 48 + r) * 1024 + 512 * kh + 8 * g; const bf16* wl = WRL + ((size_t)b * 48 + r) * 1024 + 512 * kh + 8 * g;
        f32x4 acc[3]; float ssq = 0.f;
#pragma unroll
        for (int ot = 0; ot < 3; ++ot) acc[ot] = (f32x4){0.f, 0.f, 0.f, 0.f};
#pragma unroll 4
        for (int ks = 0; ks < 16; ++ks) {
            const f32x4 xa = *(const f32x4*)(xp + 32 * ks), xb = *(const f32x4*)(xp + 32 * ks + 4);
            ssq += (xa[0] * xa[0] + xa[1] * xa[1]) + (xa[2] * xa[2] + xa[3] * xa[3]) + (xb[0] * xb[0] + xb[1] * xb[1]) + (xb[2] * xb[2] + xb[3] * xb[3]);
            const unsigned h0 = cvt_pk(xa[0], xa[1]), h1 = cvt_pk(xa[2], xa[3]), h2 = cvt_pk(xb[0], xb[1]), h3 = cvt_pk(xb[2], xb[3]);
            const unsigned l0 = cvt_pk(xa[0] - bflo(h0), xa[1] - bfhi(h0)), l1 = cvt_pk(xa[2] - bflo(h1), xa[3] - bfhi(h1)), l2 = cvt_pk(xb[0] - bflo(h2), xb[1] - bfhi(h2)), l3 = cvt_pk(xb[2] - bflo(h3), xb[3] - bfhi(h3));
            const bf16x8 ahi = __builtin_bit_cast(bf16x8, (u32x4){h0, h1, h2, h3}), alo = __builtin_bit_cast(bf16x8, (u32x4){l0, l1, l2, l3});
#pragma unroll
            for (int ot = 0; ot < 3; ++ot) {
                const bf16x8 bh = *(const bf16x8*)(wh + (size_t)ot * 16 * 1024 + 32 * ks), bl = *(const bf16x8*)(wl + (size_t)ot * 16 * 1024 + 32 * ks);
                acc[ot] = mfma16(bh, ahi, acc[ot]); acc[ot] = mfma16(bl, ahi, acc[ot]); acc[ot] = mfma16(bh, alo, acc[ot]); }
        }
        ssq += __shfl_xor(ssq, 16); ssq += __shfl_xor(ssq, 32);
        const int tl = 16 * tg + r;
#pragma unroll
        for (int ot = 0; ot < 3; ++ot) *(LAS f32x4*)(PLG + (kh * 64 + tl) * 48 + 16 * ot + 4 * g) = acc[ot];
        if (g == 0) PSS[kh * 64 + tl] = ssq;
        __syncthreads();
        if (X.tid < 64) {
            const int t = X.tid, mm = tb * 64 + t;
            const float rs = 1.0f / sqrtf((PSS[t] + PSS[64 + t]) * (1.f / DM) + 1e-6f);
            ((float*)(a.ws + WS_RSV))[mm] = rs;
            const LAS float* p0 = PLG + t * 48; const LAS float* p1 = PLG + (64 + t) * 48; const float* cb = CB + b * 48;
            float lg[4];
#pragma unroll
            for (int o = 0; o < 4; ++o) lg[o] = rs * (p0[o] + p1[o]) + cb[o];
            int gi = 0; float gm = lg[0];
#pragma unroll
            for (int o = 1; o < 4; ++o) if (lg[o] > gm) { gm = lg[o]; gi = o; }
            float gs = 0.f;
#pragma unroll
            for (int o = 0; o < 4; ++o) gs += __expf(lg[o] - gm);
            const float pgrp = 1.0f / gs;
            float sel[8];
#pragma unroll
            for (int o = 0; o < 8; ++o) sel[o] = rs * (p0[4 + gi * 8 + o] + p1[4 + gi * 8 + o]) + cb[4 + gi * 8 + o];
            int i0 = 0; float m0 = sel[0];
#pragma unroll
            for (int o = 1; o < 8; ++o) if (sel[o] > m0) { m0 = sel[o]; i0 = o; }
            int i1 = -1; float m1 = -3.0e38f;
#pragma unroll
            for (int o = 0; o < 8; ++o) if (o != i0 && sel[o] > m1) { m1 = sel[o]; i1 = o; }
            const float e1 = __expf(m1 - m0), den = 1.0f + e1;
            EL[t * 2] = gi * 8 + i0; EL[t * 2 + 1] = gi * 8 + i1;
            float* wt = (float*)(a.ws + WS_WTS) + (size_t)mm * 2; wt[0] = pgrp / den; wt[1] = pgrp * e1 / den;
        }
        __syncthreads();
        if (!dry && X.tid < 32) { int n = 0;
            for (int q = 0; q < 128; ++q) n += (EL[q] == X.tid) ? 1 : 0;
            int base = 0; if (n) base = (int)__hip_atomic_fetch_add(cnt + X.tid, (unsigned)n, __ATOMIC_RELAXED, __HIP_MEMORY_SCOPE_AGENT);
            for (int q = 0; q < 128; ++q) if (EL[q] == X.tid) PL[q] = base++; }
        __syncthreads();
        if (!dry && X.tid < 128) { ((int*)(a.ws + WS_EID))[(size_t)tb * 128 + X.tid] = EL[X.tid]; ((int*)(a.ws + WS_POS))[(size_t)tb * 128 + X.tid] = PL[X.tid]; }
        __syncthreads();
    }
}

DI void phase_gather(const Ctx& X, const Args& a) {
    moe_tables(X, a);
    const LAS int* pad_start = (const LAS int*)(X.lds + L_PADSTART);
    const int* EID = (const int*)(a.ws + WS_EID); const int* POS = (const int*)(a.ws + WS_POS); int* SLOT = (int*)(a.ws + WS_SLOT);
    const float* x1 = a.out; const float* RSV = (const float*)(a.ws + WS_RSV); const float* g2 = a.in[22]; const float* mod = (const float*)(a.ws + WS_MOD);
    bf16* xg = (bf16*)(a.ws + WS_XG);
    const int gw = X.blk * 8 + X.wave, NGW = X.nblk * 8;
    for (int m = gw; m < NTOK; m += NGW) {
        const int b = m >> 13; const float rs = RSV[m];
        const int d0 = pad_start[EID[2 * m]] + POS[2 * m], d1 = pad_start[EID[2 * m + 1]] + POS[2 * m + 1];
        if (X.lane == 0) { SLOT[2 * m] = d0; SLOT[2 * m + 1] = d1; }
        const f32x4* xr = (const f32x4*)(x1 + (size_t)m * DM) + X.lane;
        u32x2* o0 = (u32x2*)(xg + (size_t)d0 * DM) + X.lane; u32x2* o1 = (u32x2*)(xg + (size_t)d1 * DM) + X.lane;
#pragma unroll
        for (int j = 0; j < 4; ++j) { const int col = 4 * X.lane + 256 * j;
            const f32x4 g = *(const f32x4*)(g2 + col), sh = *(const f32x4*)(mod + b * 6144 + 3072 + col), sc = *(const f32x4*)(mod + b * 6144 + 4096 + col);
            const f32x4 y = xr[64 * j] * rs * g * (1.0f + sc) + sh;
            const u32x2 wv = (u32x2){cvt_pk(y.x, y.y), cvt_pk(y.z, y.w)}; o0[64 * j] = wv; o1[64 * j] = wv; }
    }
}

DI void phase_final(const Ctx& X, const Args& a, bool with_moe, bool dry = false) {
    float* out = a.out; float* dst = dry ? (float*)(a.ws + WS_HID) : a.out; const float* fg = a.in[30]; const float* mod = (const float*)(a.ws + WS_MOD);
    const int* SLOT = (const int*)(a.ws + WS_SLOT); const float* WTS = (const float*)(a.ws + WS_WTS); const bf16* Y = (const bf16*)(a.ws + WS_XG);
    const int gw = X.blk * 8 + X.wave, NGW = X.nblk * 8;
    for (int m = gw; m < NTOK; m += NGW) {
        const int b = m >> 13;
        f32x4* xr = (f32x4*)(out + (size_t)m * DM) + X.lane;
        f32x4 v[4]; float s = 0.f;
        int s0 = 0, s1 = 0; float w0 = 0.f, w1 = 0.f;
        if (with_moe) { s0 = SLOT[m * 2]; s1 = SLOT[m * 2 + 1]; w0 = WTS[m * 2]; w1 = WTS[m * 2 + 1]; }
#pragma unroll
        for (int j = 0; j < 4; ++j) { const int col = 4 * X.lane + 256 * j; v[j] = xr[64 * j];
            if (with_moe) {
                const u32x2 y0 = *(const u32x2*)(Y + (size_t)s0 * DM + col), y1 = *(const u32x2*)(Y + (size_t)s1 * DM + col);
                const f32x4 gt = *(const f32x4*)(mod + b * 6144 + 5120 + col);
                const f32x4 mo = w0 * (f32x4){bflo(y0.x), bfhi(y0.x), bflo(y0.y), bfhi(y0.y)} + w1 * (f32x4){bflo(y1.x), bfhi(y1.x), bflo(y1.y), bfhi(y1.y)};
                v[j] = v[j] + gt * mo; }
            s += (v[j].x * v[j].x + v[j].y * v[j].y) + (v[j].z * v[j].z + v[j].w * v[j].w); }
        const float rs = 1.0f / sqrtf(wave_sum(s) * (1.f / DM) + 1e-6f);
#pragma unroll
        for (int j = 0; j < 4; ++j) { const f32x4 g = *(const f32x4*)(fg + 4 * X.lane + 256 * j); ((f32x4*)(dst + (size_t)(dry ? (m & 4095) : m) * DM) + X.lane)[64 * j] = v[j] * rs * g; }
    }
}

#ifndef MK_DUP
#define MK_DUP 0
#endif
constexpr int NPH = 13;
__global__ void __launch_bounds__(512, 2) mk_fwd(Args a) {
    extern __shared__ __attribute__((aligned(16))) unsigned char lds_raw[];
    Ctx X; X.lds = (LAS unsigned char*)lds_raw; X.tid = threadIdx.x; X.lane = X.tid & 63; X.wave = __builtin_amdgcn_readfirstlane(X.tid >> 6); X.nblk = gridDim.x; X.blk = blockIdx.x;
    if (X.tid < 8) ((LAS unsigned*)(X.lds + LDS_MISC))[X.tid] = 0u;
    __syncthreads();
    XcdBarrier bar = xcd_barrier_post((unsigned*)(a.ws + WS_CTL) + CW_BAR, (volatile LAS unsigned*)(X.lds + LDS_MISC));
    const int lo = a.ph_lo, hi = a.ph_hi;
#define IN(k) (lo <= (k) && (k) < hi)
#define SEAM(k) do { if (IN(k) && IN((k) + 1)) xcd_barrier(bar); } while (0)
    unsigned char* ws = a.ws;
    bf16* hbuf = (bf16*)a.out;
    bf16* gate_a = (bf16*)a.out + (size_t)16 * 1024 * 1024;
    bf16* gate_b = (bf16*)(ws + WS_GATEB);
    if (IN(0)) { phase_prologue(X, a); } SEAM(0);
    if (IN(1)) { phase_norm1(X, a); } SEAM(1);
    if (IN(2)) {
        pg8::Gemm g{hbuf, (const bf16*)(ws + WS_WIN), NTOK, NWIN, 1024, 1024}; pg8::StaticOrder S; S.init(NTOK, NWIN, X.nblk, X.blk);
        epi::InProj E{(bf16*)(ws + WS_PROJ), gate_a, gate_b};
        pg8::gemm_phase<epi::InProj, pg8::StaticOrder>(X.lds, g, S, E, nullptr);
    } SEAM(2);
    if (IN(3)) {
        for (int rep = 0; rep < 1 + (MK_DUP & 1); ++rep) for (int u = X.blk; u < 1024; u += X.nblk) hg1_unit(X, a, u);
        for (int rep = 0; rep < 1 + ((MK_DUP >> 1) & 1); ++rep) for (int u = X.blk; u < 2048; u += X.nblk) rw1_unit(X, a, u);
    } SEAM(3);
    if (IN(4)) {
        hg2_scan(X, a);
        for (int rep = 0; rep < 1 + ((MK_DUP >> 2) & 1); ++rep) if (X.wave == 0) for (int ch = 0; ch < 64; ++ch) if ((128 + ch) % X.nblk == X.blk) rw2_chain(X, a, ch);
    } SEAM(4);
    if (IN(5)) {
        if ((MK_DUP >> 15) & 1) for (int u = X.blk; u < 1024; u += X.nblk) hg3_unit(X, a, u, true);
        for (int u = X.blk; u < 1024; u += X.nblk) hg3_unit(X, a, u);
        for (int rep = 0; rep < 1 + ((MK_DUP >> 3) & 1); ++rep) for (int u = X.blk; u < 2048; u += X.nblk) rw3_unit(X, a, u);
    } SEAM(5);
    if (IN(6)) {
        pg8::StaticOrder S; S.init(NTOK, 1024, X.nblk, X.blk);
        { pg8::Gemm g{(const bf16*)(ws + WS_PROJ) + C_HQ, (const bf16*)(ws + WS_WPA), NTOK, 1024, 512, LDP};
          epi::GateMix<false> E{(bf16*)(ws + WS_MIXED), 1024, gate_a, 1024};
          pg8::gemm_phase<epi::GateMix<false>, pg8::StaticOrder>(X.lds, g, S, E, nullptr); }
        __syncthreads();
        { pg8::Gemm g{(const bf16*)(ws + WS_PROJ) + C_RR, (const bf16*)(ws + WS_WPB), NTOK, 1024, 512, LDP};
          epi::GateMix<true> E{(bf16*)(ws + WS_MIXED), 1024, gate_b, 1024};
          pg8::gemm_phase<epi::GateMix<true>, pg8::StaticOrder>(X.lds, g, S, E, nullptr); }
    } SEAM(6);
    if (IN(7)) {
        pg8::Gemm g{(const bf16*)(ws + WS_MIXED), (const bf16*)(ws + WS_WOUT), NTOK, 1024, 1024, 1024}; pg8::StaticOrder S; S.init(NTOK, 1024, X.nblk, X.blk);
        epi::Resid E{a.in[0], a.out, (const float*)(ws + WS_MOD) + 2048};
        pg8::gemm_phase<epi::Resid, pg8::StaticOrder>(X.lds, g, S, E, nullptr);
        __syncthreads();
        phase_expert_weights(X, a);
    } SEAM(7);
    if (IN(8)) { if ((MK_DUP >> 16) & 1) { phase_router(X, a, true); __syncthreads(); } phase_router(X, a); } SEAM(8);
    if (IN(9)) { phase_gather(X, a); } SEAM(9);
    if (IN(10)) {
        moe_tables(X, a);
        const int ntiles = ((const LAS int*)(X.lds + L_NTILES))[0];
        pg8::Gemm g{(const bf16*)(ws + WS_XG), (const bf16*)(ws + WS_EWGU), ntiles * 256, 32 * 1024, 1024, 1024};
        epi::MoeOrder S{(const LAS int*)(X.lds + L_TILE_E), ntiles, X.nblk, X.blk};
        epi::SwiGlu E{(bf16*)(ws + WS_HID)};
        pg8::gemm_phase<epi::SwiGlu, epi::MoeOrder>(X.lds, g, S, E, nullptr);
    } SEAM(10);
    if (IN(11)) {
        moe_tables(X, a);
        const int ntiles = ((const LAS int*)(X.lds + L_NTILES))[0];
        pg8::Gemm g{(const bf16*)(ws + WS_HID), (const bf16*)(ws + WS_EWD), ntiles * 256, 32 * 1024, 512, 512};
        epi::MoeOrder S{(const LAS int*)(X.lds + L_TILE_E), ntiles, X.nblk, X.blk};
        epi::MoeOut E{(bf16*)(ws + WS_XG)};
        pg8::gemm_phase<epi::MoeOut, epi::MoeOrder>(X.lds, g, S, E, nullptr);
    } SEAM(11);
    if (IN(12)) { phase_final(X, a, true); }
#undef IN
#undef SEAM
}

extern "C" void kernel_launch(void* const* d_in, const int* in_sizes, int n_in, void* d_out, int out_size, void* d_ws, size_t ws_size, hipStream_t stream) {
    static int grid = 0;
    if (grid == 0) {
        int dev = 0, cus = 0;
        if (n_in != 31 || out_size != NTOK * DM || ws_size < WS_END) { fprintf(stderr, "kernel_launch: unexpected shapes (n_in %d out %d ws %zu)\n", n_in, out_size, ws_size); grid = -1; return; }
        if (hipGetDevice(&dev) != hipSuccess || hipDeviceGetAttribute(&cus, hipDeviceAttributeMultiprocessorCount, dev) != hipSuccess) { grid = -1; return; }
        if (hipFuncSetAttribute((const void*)mk_fwd, hipFuncAttributeMaxDynamicSharedMemorySize, LDS_BYTES) != hipSuccess) { fprintf(stderr, "kernel_launch: hipFuncSetAttribute failed\n"); grid = -1; return; }
        int per_cu = 0;
        if (hipOccupancyMaxActiveBlocksPerMultiprocessor(&per_cu, (const void*)mk_fwd, 512, LDS_BYTES) != hipSuccess || per_cu < 1) fprintf(stderr, "kernel_launch: occupancy query reports %d\n", per_cu);
        (void)hipGetLastError();
        grid = cus;
    }
    if (grid < 0) return;
    (void)hipMemsetAsync((char*)d_ws + WS_CTL, 0, CTL_ZERO_BYTES, stream);
    Args a{};
    for (int i = 0; i < 31; ++i) a.in[i] = (const float*)d_in[i];
    a.out = (float*)d_out; a.ws = (unsigned char*)d_ws;
#if MK_ONE_LAUNCH
    a.ph_lo = 0; a.ph_hi = NPH;
    hipLaunchKernelGGL(mk_fwd, dim3(grid), dim3(512), LDS_BYTES, stream, a);
#else
    for (int ph = 0; ph < NPH; ++ph) {
        a.ph_lo = ph; a.ph_hi = ph + 1;
        hipLaunchKernelGGL(mk_fwd, dim3(grid), dim3(512), LDS_BYTES, stream, a);
    }
#endif
}
```

```cpp
#define MK_ONE_LAUNCH 1
#include <hip/hip_runtime.h>
#include <stdint.h>
#include <stdio.h>

#ifndef MK_ONE_LAUNCH
#define MK_ONE_LAUNCH 0
#endif
#ifndef MK_LAST_PHASE
#define MK_LAST_PHASE 99
#endif

#define DI __device__ __forceinline__
#define LAS __attribute__((address_space(3)))
typedef unsigned short bf16;
typedef short bf16x8 __attribute__((ext_vector_type(8)));
typedef float f32x4 __attribute__((ext_vector_type(4)));
typedef float f32x2 __attribute__((ext_vector_type(2)));
typedef unsigned u32x4 __attribute__((ext_vector_type(4)));
typedef unsigned u32x2 __attribute__((ext_vector_type(2)));

constexpr int NTOK = 16384, DM = 1024, SEQ = 8192;
constexpr int LDP = 3840;
constexpr int NWIN = 5888;
constexpr int C_HQ = 0, C_HF = 512, C_HI = 1024, C_HG = 1536, C_RR = 2048, C_RK = 2560, C_RV = 3072, C_WD = 3584, C_AD = 3616, C_GD = 3648;
constexpr int MOE_PMAX = 40960;

constexpr size_t MiB = 1u << 20;
constexpr size_t WS_CTL = 0, CTL_ZERO_BYTES = 1 * MiB;
constexpr size_t WS_MOD = 1 * MiB;
constexpr size_t WS_SLOT = 1 * MiB + 64 * 1024;
constexpr size_t WS_WTS = WS_SLOT + 128 * 1024;
constexpr size_t WS_EID = WS_WTS + 128 * 1024;
constexpr size_t WS_POS = WS_EID + 128 * 1024;
constexpr size_t WS_RSV = WS_POS + 128 * 1024;
constexpr size_t WS_BONUS = 2 * MiB;
constexpr size_t WS_HGC = 2 * MiB + 512 * 1024;
constexpr size_t WS_RGC = 3 * MiB;
constexpr size_t WS_WRH = 3 * MiB + 512 * 1024;
constexpr size_t WS_WRL = WS_WRH + 196608;
constexpr size_t WS_CB = WS_WRL + 196608;
constexpr size_t WS_WIN = 4 * MiB;
constexpr size_t WS_WPA = 16 * MiB, WS_WPB = 17 * MiB, WS_WOUT = 18 * MiB;
constexpr size_t WS_PROJ = 20 * MiB;
constexpr size_t WS_HS = 140 * MiB;
constexpr size_t WS_RM = 172 * MiB;
constexpr size_t WS_RS = 236 * MiB;
constexpr size_t WS_MIXED = 204 * MiB;
constexpr size_t WS_EWGU = 20 * MiB;
constexpr size_t WS_EWD = 84 * MiB;
constexpr size_t WS_XG = 116 * MiB;
constexpr size_t WS_HID = 196 * MiB;
constexpr size_t WS_GATEB = 252 * MiB;
constexpr size_t WS_END = 284 * MiB;
constexpr int CW_BAR = 4096, CW_ECNT = 16384;

constexpr int LDS_BYTES = 163840;
constexpr int LDS_MISC = 163840 - 256;

typedef __bf16 bf16x2_t __attribute__((ext_vector_type(2)));
DI unsigned cvt_pk(float lo, float hi) { bf16x2_t v = {(__bf16)lo, (__bf16)hi}; return __builtin_bit_cast(unsigned, v); }
DI bf16 f2bf(float x) { return (bf16)(cvt_pk(x, 0.f) & 0xffffu); }
DI float bf2f(bf16 b) { return __uint_as_float(((unsigned)b) << 16); }
DI float bflo(unsigned w) { return __uint_as_float(w << 16); }
DI float bfhi(unsigned w) { return __uint_as_float(w & 0xffff0000u); }
DI float sigmoidf_(float x) { return 1.0f / (1.0f + __expf(-x)); }
DI float siluf_(float x) { return x / (1.0f + __expf(-x)); }
DI float wave_sum(float v) {
#pragma unroll
    for (int o = 1; o < 64; o <<= 1) v += __shfl_xor(v, o);
    return v;
}
DI f32x4 mfma16(bf16x8 a, bf16x8 b, f32x4 c) { return __builtin_amdgcn_mfma_f32_16x16x32_bf16(a, b, c, 0, 0, 0); }
#define LDS_WAIT() asm volatile("s_waitcnt lgkmcnt(0)" ::: "memory")
#define VM_WAIT() asm volatile("s_waitcnt vmcnt(0)" ::: "memory")

template <int TP, int TQ, int KS>
DI void mm_ll(const LAS bf16* P, int ldp, const LAS bf16* Q, int ldq, f32x4 (&acc)[TP][TQ], int lane) {
    const int r = lane & 15, g = lane >> 4;
#pragma unroll
    for (int ks = 0; ks < KS; ++ks) {
        bf16x8 pf[TP], qf[TQ];
#pragma unroll
        for (int tp = 0; tp < TP; ++tp) pf[tp] = *(const LAS bf16x8*)(P + (tp * 16 + r) * ldp + ks * 32 + g * 8);
#pragma unroll
        for (int tq = 0; tq < TQ; ++tq) qf[tq] = *(const LAS bf16x8*)(Q + (tq * 16 + r) * ldq + ks * 32 + g * 8);
#pragma unroll
        for (int tp = 0; tp < TP; ++tp)
#pragma unroll
            for (int tq = 0; tq < TQ; ++tq) acc[tp][tq] = mfma16(pf[tp], qf[tq], acc[tp][tq]);
    }
}
template <int TP, int TQ, int KS>
DI void mm_gl(const bf16* P, int ldp, const LAS bf16* Q, int ldq, f32x4 (&acc)[TP][TQ], int lane) {
    const int r = lane & 15, g = lane >> 4;
#pragma unroll
    for (int ks = 0; ks < KS; ++ks) {
        bf16x8 pf[TP], qf[TQ];
#pragma unroll
        for (int tp = 0; tp < TP; ++tp) pf[tp] = *(const bf16x8*)(P + (size_t)(tp * 16 + r) * ldp + ks * 32 + g * 8);
#pragma unroll
        for (int tq = 0; tq < TQ; ++tq) qf[tq] = *(const LAS bf16x8*)(Q + (tq * 16 + r) * ldq + ks * 32 + g * 8);
#pragma unroll
        for (int tp = 0; tp < TP; ++tp)
#pragma unroll
            for (int tq = 0; tq < TQ; ++tq) acc[tp][tq] = mfma16(pf[tp], qf[tq], acc[tp][tq]);
    }
}
template <int TP, int TQ, int KS>
DI void mm_gg(const bf16* P, int ldp, const bf16* Q, int ldq, f32x4 (&acc)[TP][TQ], int lane) {
    const int r = lane & 15, g = lane >> 4;
#pragma unroll
    for (int ks = 0; ks < KS; ++ks) {
        bf16x8 pf[TP], qf[TQ];
#pragma unroll
        for (int tp = 0; tp < TP; ++tp) pf[tp] = *(const bf16x8*)(P + (size_t)(tp * 16 + r) * ldp + ks * 32 + g * 8);
#pragma unroll
        for (int tq = 0; tq < TQ; ++tq) qf[tq] = *(const bf16x8*)(Q + (size_t)(tq * 16 + r) * ldq + ks * 32 + g * 8);
#pragma unroll
        for (int tp = 0; tp < TP; ++tp)
#pragma unroll
            for (int tq = 0; tq < TQ; ++tq) acc[tp][tq] = mfma16(pf[tp], qf[tq], acc[tp][tq]);
    }
}
template <int A, int B> DI void zero_acc(f32x4 (&acc)[A][B]) {
#pragma unroll
    for (int a = 0; a < A; ++a)
#pragma unroll
        for (int b = 0; b < B; ++b) acc[a][b] = (f32x4){0.f, 0.f, 0.f, 0.f};
}
namespace pg8 {
#define PG8_LAS __attribute__((address_space(3)))
typedef unsigned short bf16_t;
typedef short bf16x8 __attribute__((ext_vector_type(8)));
typedef float f32x4 __attribute__((ext_vector_type(4)));
typedef unsigned u32x4 __attribute__((ext_vector_type(4)));
constexpr int BM = 256, BK = 64, HALF = 128, HTB = HALF * BK * 2  , STAGE_BYTES = 8 * HTB, NXCD = 8, WGM = 8;

__host__ __device__ __forceinline__ int lds_byte(int r, int c) { const int st = (r >> 4) * 2 + (c >> 5), rr = r & 15, cc = c & 31, ob = rr * 64 + cc * 2; return st * 1024 + (ob ^ (((ob >> 9) & 1) << 5)); }
__host__ __device__ __forceinline__ void stage_rc(int b, int& R, int& C) { const int st = b / 1024, sb = b % 1024, swz = sb ^ (((sb >> 9) & 1) << 5); R = (st >> 1) * 16 + swz / 64; C = (st & 1) * 32 + (swz % 64) / 2; }
__host__ __device__ __forceinline__ int perm32(int rho) { const int n = rho >> 4, i = rho & 15; return 8 * (i >> 2) + 4 * n + (i & 3); }

struct Unit { int pm, pn; };
struct Gemm { const bf16_t* A; const bf16_t* Bt; int M, N, K, lda; };

struct StaticOrder {
    int nM, nN, nwg, G, c;
    __host__ __device__ void init(int M, int N, int G_, int c_) { nM = M / BM; nN = N / BM; nwg = nM * nN; G = G_; c = c_; }
    __host__ __device__ bool next(int i, Unit& u) const {
        const long L = (long)i * G + c; if (L >= nwg) return false;
        int wgid = (int)L; { const int q = nwg / NXCD, r = nwg % NXCD, xcd = wgid % NXCD, off = wgid / NXCD; wgid = (xcd < r ? xcd * (q + 1) : r * (q + 1) + (xcd - r) * q) + off; }
        const int nig = WGM * nN, gid = wgid / nig, fm = gid * WGM, gsz = (nM - fm) < WGM ? (nM - fm) : WGM;
        u.pm = fm + ((wgid % nig) % gsz); u.pn = (wgid % nig) / gsz; return true;
    }
    __device__ __forceinline__ void a_ready(const Unit&) const {}
    __device__ __forceinline__ void done(const Unit&) const {}
};
struct CountedOrder : StaticOrder {
    const unsigned* ready; unsigned need; unsigned* tmo;
    __device__ __forceinline__ void a_ready(const Unit& u) const {
        if (threadIdx.x < 64) {
            const unsigned long long t0 = __builtin_amdgcn_s_memrealtime(); unsigned polls = 0;
            while ((unsigned)__builtin_amdgcn_readfirstlane(__hip_atomic_load(ready + 64 * u.pm, __ATOMIC_RELAXED, __HIP_MEMORY_SCOPE_AGENT)) < need) {
                if ((++polls & 255u) == 0u && __builtin_amdgcn_readfirstlane(__hip_atomic_load(tmo, __ATOMIC_RELAXED, __HIP_MEMORY_SCOPE_AGENT)) != 0u) break;
                if (__builtin_amdgcn_s_memrealtime() - t0 > 2000000ull) {
                    if (threadIdx.x == 0) { unsigned expect = 0u; __hip_atomic_compare_exchange_strong(tmo + 1, &expect, 0x600u | (unsigned)(u.pm & 0xff), __ATOMIC_RELAXED, __ATOMIC_RELAXED, __HIP_MEMORY_SCOPE_AGENT); __hip_atomic_store(tmo, 1u, __ATOMIC_RELAXED, __HIP_MEMORY_SCOPE_AGENT); }
                    break; }
                __builtin_amdgcn_s_sleep(2); }
            __builtin_amdgcn_fence(__ATOMIC_ACQUIRE, "agent");
            asm volatile("s_waitcnt vmcnt(0)" ::: "memory");
        }
#if !defined(BROKEN_HOOK_NO_BARRIER)
        asm volatile("" ::: "memory"); __builtin_amdgcn_s_barrier(); asm volatile("" ::: "memory");
#endif
    }
};

__device__ __forceinline__ unsigned cvt_pk_bf16(float lo, float hi) { return ::cvt_pk(lo, hi); }
typedef float f32x2 __attribute__((ext_vector_type(2)));
__device__ __forceinline__ f32x2 gelu_pk(f32x2 v) {
    const f32x2 av = __builtin_elementwise_abs(v), d = av * 0.2316418882f + 1.0f;
    f32x2 t; t.x = __builtin_amdgcn_rcpf(d.x); t.y = __builtin_amdgcn_rcpf(d.y);
    f32x2 q = t * 0.5307027145f + (-0.7265760135f); q = q * t + 0.7107068705f; q = q * t + (-0.142248368f); q = q * t + 0.127414796f; q = q * t;
    const f32x2 s = (v * v) * (-0.72134752044f);
    f32x2 e; e.x = __builtin_amdgcn_exp2f(s.x); e.y = __builtin_amdgcn_exp2f(s.y);
    const f32x2 m = v * (q * e), r = v - m;
    f32x2 o; o.x = v.x < 0.f ? m.x : r.x; o.y = v.y < 0.f ? m.y : r.y; return o;
}

struct EpiF32 {
    static constexpr bool PERM = false, AFTER_DRAIN = false;
    float* C; int ldc; const float* bias;
    __device__ __forceinline__ void operator()(const f32x4 (&acc)[2][2][4][2], const Unit& u, int wr, int wc, int fr, int fq) const {
        const int row0 = u.pm * BM + wr * 64 + fr, col0 = u.pn * BM + wc * 32 + 4 * fq;
        f32x4 bv[2][2];
#pragma unroll
        for (int bj = 0; bj < 2; ++bj)
#pragma unroll
            for (int n = 0; n < 2; ++n) bv[bj][n] = bias ? *(const f32x4*)(bias + col0 + bj * HALF + n * 16) : (f32x4){0.f, 0.f, 0.f, 0.f};
#pragma unroll
        for (int ai = 0; ai < 2; ++ai)
#pragma unroll
            for (int m = 0; m < 4; ++m) { float* rowp = C + (size_t)(row0 + ai * HALF + m * 16) * ldc + col0;
#pragma unroll
                for (int bj = 0; bj < 2; ++bj)
#pragma unroll
                    for (int n = 0; n < 2; ++n) *(f32x4*)(rowp + bj * HALF + n * 16) = acc[ai][bj][m][n] + bv[bj][n]; }
    }
};
template <int ACT  > struct EpiBf16 {
    static constexpr bool PERM = true, AFTER_DRAIN = false;
    bf16_t* O; int ldc; const float* bias; int split_cols; size_t split_stride;
    __device__ __forceinline__ void operator()(const f32x4 (&acc)[2][2][4][2], const Unit& u, int wr, int wc, int fr, int fq) const {
        const int row0 = u.pm * BM + wr * 64 + fr; int colt = u.pn * BM; bf16_t* base = O;
        if (split_cols) { const int t = colt / split_cols; base += (size_t)t * split_stride; colt -= t * split_cols; }
        const int col0 = colt + wc * 32 + 8 * fq, bcol0 = u.pn * BM + wc * 32 + 8 * fq;
        f32x4 bv[2][2];
#pragma unroll
        for (int bj = 0; bj < 2; ++bj)
#pragma unroll
            for (int n = 0; n < 2; ++n) bv[bj][n] = bias ? *(const f32x4*)(bias + bcol0 + bj * HALF + 4 * n) : (f32x4){0.f, 0.f, 0.f, 0.f};
#pragma unroll
        for (int ai = 0; ai < 2; ++ai)
#pragma unroll
            for (int m = 0; m < 4; ++m) { bf16_t* rowp = base + (size_t)(row0 + ai * HALF + m * 16) * ldc + col0;
#pragma unroll
                for (int bj = 0; bj < 2; ++bj) { f32x4 v0 = acc[ai][bj][m][0] + bv[bj][0], v1 = acc[ai][bj][m][1] + bv[bj][1];
                    if (ACT == 1) { f32x2 a = gelu_pk((f32x2){v0[0], v0[1]}), b = gelu_pk((f32x2){v0[2], v0[3]}), c = gelu_pk((f32x2){v1[0], v1[1]}), d = gelu_pk((f32x2){v1[2], v1[3]});
                        v0 = (f32x4){a.x, a.y, b.x, b.y}; v1 = (f32x4){c.x, c.y, d.x, d.y}; }
                    if (ACT == 2) {
#pragma unroll
                        for (int j = 0; j < 4; ++j) { v0[j] = 0.5f * v0[j] * (1.0f + erff(v0[j] * 0.70710678f)); v1[j] = 0.5f * v1[j] * (1.0f + erff(v1[j] * 0.70710678f)); } }
                    u32x4 w; w.x = cvt_pk_bf16(v0[0], v0[1]); w.y = cvt_pk_bf16(v0[2], v0[3]); w.z = cvt_pk_bf16(v1[0], v1[1]); w.w = cvt_pk_bf16(v1[2], v1[3]);
                    *(u32x4*)(rowp + bj * HALF) = w; } }
    }
};
template <class Epi, class Sched, bool STAMP = false>
__device__ __forceinline__ void gemm_phase(PG8_LAS unsigned char* lds, const Gemm g, const Sched& S, const Epi& E, unsigned long long* stamps) {
    const int tid = threadIdx.x, wid = __builtin_amdgcn_readfirstlane(tid >> 6), lane = tid & 63, wr = wid >> 2, wc = wid & 3, fr = lane & 15, fq = lane >> 4;
    const int K = g.K, nt = K / BK;
    int ts_lo = 0, ts_hi = 0, nts = 0; const unsigned long long rt_entry = STAMP ? (unsigned long long)wall_clock64() : 0ull;
#define PG8_STAMP() do { if (STAMP && wid == 0 && nts < 64) { const unsigned long long _c = (unsigned long long)clock64(); \
        ts_lo = (lane == nts) ? (int)(unsigned)_c : ts_lo; ts_hi = (lane == nts) ? (int)(unsigned)(_c >> 32) : ts_hi; ++nts; } } while (0)
    PG8_STAMP();
    unsigned voffA[2], voffB[2];
#pragma unroll
    for (int i = 0; i < 2; ++i) { int R, C; stage_rc(tid * 16 + i * 8192, R, C); const int Rb = Epi::PERM ? ((R & ~31) + perm32(R & 31)) : R;
        voffA[i] = (unsigned)(R * g.lda + C) * 2u; voffB[i] = (unsigned)(Rb * K + C) * 2u; }
    const size_t kstep = (size_t)(BK * 2);
    const size_t hstep = (size_t)HALF * K * 2;
    const size_t tstep = 2 * hstep; const size_t hstepA = (size_t)HALF * g.lda * 2, tstepA = 2 * hstepA;
    const unsigned ldsw = (unsigned)wid * 1024u;
    const int aoff = lds_byte(wr * 64 + fr, fq * 8), boff = lds_byte(wc * 32 + fr, fq * 8);
#define PG8_SA(b, h) (((b) * 2 + (h)) * HTB)
#define PG8_SB(b, h) ((4 + (b) * 2 + (h)) * HTB)
#define PG8_STAGE(bufoff, gbase, voff) do { _Pragma("unroll") for (int _i = 0; _i < 2; ++_i) \
        __builtin_amdgcn_global_load_lds((const unsigned*)((const char*)(gbase) + (voff)[_i]), (PG8_LAS unsigned*)(lds + (bufoff) + ldsw + _i * 8192), 16, 0, 0); } while (0)
#define PG8_LDA(dst, b, h) do { _Pragma("unroll") for (int m = 0; m < 4; ++m) _Pragma("unroll") for (int k = 0; k < 2; ++k) dst[m][k] = *(const PG8_LAS bf16x8*)(lds + PG8_SA(b, h) + aoff + m * 2048 + k * 1024); } while (0)
#define PG8_LDB(dst, b, h) do { _Pragma("unroll") for (int n = 0; n < 2; ++n) _Pragma("unroll") for (int k = 0; k < 2; ++k) dst[n][k] = *(const PG8_LAS bf16x8*)(lds + PG8_SB(b, h) + boff + n * 2048 + k * 1024); } while (0)
#define PG8_MMA(ai, bj, At, Bt) do { __builtin_amdgcn_s_setprio(1); _Pragma("unroll") for (int m = 0; m < 4; ++m) _Pragma("unroll") for (int n = 0; n < 2; ++n) _Pragma("unroll") for (int k = 0; k < 2; ++k) \
        acc[ai][bj][m][n] = __builtin_amdgcn_mfma_f32_16x16x32_bf16(Bt[n][k], At[m][k], acc[ai][bj][m][n], 0, 0, 0); __builtin_amdgcn_s_setprio(0); } while (0)
#define PG8_WAIT_V(n) asm volatile("s_waitcnt vmcnt(" #n ")" ::: "memory")
#define PG8_WAIT_L(n) asm volatile("s_waitcnt lgkmcnt(" #n ")" ::: "memory")
#define PG8_BAR __builtin_amdgcn_s_barrier()
#define PG8_SCHED __builtin_amdgcn_sched_barrier(0)
    Unit cur, nxt; int ui = 0;
    if (!S.next(0, cur)) return;
    f32x4 acc[2][2][4][2];
#pragma unroll
    for (int a = 0; a < 2; ++a)
#pragma unroll
        for (int b = 0; b < 2; ++b)
#pragma unroll
            for (int m = 0; m < 4; ++m)
#pragma unroll
                for (int n = 0; n < 2; ++n) acc[a][b][m][n] = (f32x4){0.f, 0.f, 0.f, 0.f};
    bf16x8 At[4][2], B0[2][2], B1[2][2];
    const char* cA = (const char*)g.A + (size_t)cur.pm * tstepA; const char* cB = (const char*)g.Bt + (size_t)cur.pn * tstep;
    S.a_ready(cur);
    PG8_STAGE(PG8_SB(0, 0), cB, voffB); PG8_STAGE(PG8_SA(0, 0), cA, voffA); PG8_STAGE(PG8_SB(0, 1), cB + hstep, voffB); PG8_STAGE(PG8_SA(0, 1), cA + hstepA, voffA);
    if (wr == 1) PG8_BAR;
    PG8_WAIT_V(4); PG8_BAR;
    PG8_STAGE(PG8_SB(1, 0), cB + kstep, voffB); PG8_STAGE(PG8_SA(1, 0), cA + kstep, voffA); PG8_STAGE(PG8_SB(1, 1), cB + hstep + kstep, voffB);
    PG8_WAIT_V(6); PG8_BAR;
    PG8_STAMP();
    for (;;) {
        const bool has_next = S.next(ui + 1, nxt);
        const char* nA = has_next ? (const char*)g.A + (size_t)nxt.pm * tstepA : cA; const char* nB = has_next ? (const char*)g.Bt + (size_t)nxt.pn * tstep : cB;
        for (int t = 0; t < nt; t += 2) {
            const bool last = (t == nt - 2);
            const char* a1 = cA + (size_t)(t + 1) * kstep;
            const char* a2 = last ? nA : cA + (size_t)(t + 2) * kstep; const char* b2 = last ? nB : cB + (size_t)(t + 2) * kstep;
            const char* a3 = a2 + kstep; const char* b3 = b2 + kstep;
            if (last && has_next) S.a_ready(nxt);
            PG8_LDB(B0, 0, 0); PG8_SCHED; PG8_LDA(At, 0, 0); PG8_STAGE(PG8_SA(1, 1), a1 + hstepA, voffA);
            PG8_WAIT_L(8); PG8_BAR; PG8_WAIT_L(0); PG8_MMA(0, 0, At, B0); PG8_BAR; PG8_SCHED;
            PG8_LDB(B1, 0, 1); PG8_STAGE(PG8_SB(0, 0), b2, voffB);
            PG8_BAR; PG8_WAIT_L(0); PG8_MMA(0, 1, At, B1); PG8_BAR;
            PG8_LDA(At, 0, 1); PG8_STAGE(PG8_SA(0, 0), a2, voffA);
            PG8_BAR; PG8_WAIT_L(0); PG8_MMA(1, 0, At, B0); PG8_BAR; PG8_SCHED;
            PG8_STAGE(PG8_SB(0, 1), b2 + hstep, voffB);
            PG8_WAIT_V(6); PG8_BAR; PG8_MMA(1, 1, At, B1); PG8_BAR;
            PG8_LDB(B0, 1, 0); PG8_SCHED; PG8_LDA(At, 1, 0); PG8_STAGE(PG8_SA(0, 1), a2 + hstepA, voffA);
            PG8_WAIT_L(8); PG8_BAR; PG8_WAIT_L(0); PG8_MMA(0, 0, At, B0); PG8_BAR; PG8_SCHED;
            PG8_LDB(B1, 1, 1); PG8_STAGE(PG8_SB(1, 0), b3, voffB);
            PG8_BAR; PG8_WAIT_L(0); PG8_MMA(0, 1, At, B1); PG8_BAR;
            PG8_LDA(At, 1, 1); PG8_STAGE(PG8_SA(1, 0), a3, voffA);
            PG8_BAR; PG8_WAIT_L(0); PG8_MMA(1, 0, At, B0); PG8_BAR; PG8_SCHED;
            PG8_STAGE(PG8_SB(1, 1), b3 + hstep, voffB);
            PG8_WAIT_V(6); PG8_BAR; PG8_MMA(1, 1, At, B1); PG8_BAR;
        }
        PG8_STAMP();
        if constexpr (!Epi::AFTER_DRAIN) { E(acc, cur, wr, wc, fr, fq); S.done(cur); }
        PG8_STAMP();
        if (!has_next) break;
#pragma unroll
        for (int a = 0; a < 2; ++a)
#pragma unroll
            for (int b = 0; b < 2; ++b)
#pragma unroll
                for (int m = 0; m < 4; ++m)
#pragma unroll
                    for (int n = 0; n < 2; ++n) acc[a][b][m][n] = (f32x4){0.f, 0.f, 0.f, 0.f};
        cur = nxt; cA = nA; cB = nB; ++ui;
    }
    PG8_WAIT_V(0);
    if (wr == 0) PG8_BAR;
    PG8_BAR;
    if constexpr (Epi::AFTER_DRAIN) { E.fused(acc, cur, wr, wc, fr, fq, lds, wid, lane); S.done(cur); }
    PG8_STAMP();
    if (STAMP && wid == 0) { stamps[lane] = lane < nts ? (((unsigned long long)(unsigned)ts_hi << 32) | (unsigned)ts_lo) : 0ull;
        if (lane == 62) stamps[62] = rt_entry; if (lane == 63) stamps[63] = (unsigned long long)wall_clock64(); }
#undef PG8_STAMP
#undef PG8_SA
#undef PG8_SB
#undef PG8_STAGE
#undef PG8_LDA
#undef PG8_LDB
#undef PG8_MMA
#undef PG8_WAIT_V
#undef PG8_WAIT_L
#undef PG8_BAR
#undef PG8_SCHED
}
}
#define XB_TMO      128
#define XB_XCNT(j)  (256  + 64 * (j))
#define XB_XSUB(j)  (1280 + 64 * (j))
#define XB_XGEN(j)  (2304 + 64 * (j))
#define XB_TOP      3328
#define XB_TOPGEN   3392
#define XCD_BAR_WORDS 3456
#define XB_SPIN_CAP (1u << 22)

__device__ __forceinline__ unsigned xb_ld(unsigned* p)              { return __hip_atomic_load(p, __ATOMIC_RELAXED, __HIP_MEMORY_SCOPE_AGENT); }
__device__ __forceinline__ unsigned xb_add(unsigned* p, unsigned v) { return __hip_atomic_fetch_add(p, v, __ATOMIC_RELAXED, __HIP_MEMORY_SCOPE_AGENT); }
__device__ __forceinline__ unsigned xb_xcc_id() { return (unsigned)__builtin_amdgcn_s_getreg((3 << 11) | 20) & 0xFu; }
#define XB_SPIN(cond, bar) do { unsigned _sp = 0; while (cond) { __builtin_amdgcn_s_sleep(1); \
    if ((++_sp & 255u) == 0u) { if (xb_ld(&(bar)[XB_TMO])) break; if (_sp > XB_SPIN_CAP) { atomicAdd(&(bar)[XB_TMO], 1u); break; } } } } while (0)

struct XcdBarrier {
    unsigned* bar; unsigned x;
    volatile LAS unsigned* st;
};

__device__ __forceinline__ XcdBarrier xcd_barrier_post(unsigned* bar, volatile LAS unsigned* st) {
    XcdBarrier b; b.bar = bar; b.x = xb_xcc_id(); b.st = st;
    if (threadIdx.x == 0) (void)xb_add(&bar[XB_XCNT(b.x)], 1u);
    return b;
}
__device__ __forceinline__ void xcd_barrier_complete(unsigned* bar, unsigned x, unsigned& nloc, unsigned& nx) {
    const unsigned G = gridDim.x * gridDim.y * gridDim.z;
    unsigned sum, cnt, mine, sp = 0u;
    for (;;) {
        sum = 0u; cnt = 0u; mine = 0u;
#pragma unroll
        for (unsigned j = 0; j < 16; ++j) { const unsigned c = xb_ld(&bar[XB_XCNT(j)]); sum += c; cnt += (c > 0u) ? 1u : 0u; mine = (j == x) ? c : mine; }
        if (sum == G) break;
        __builtin_amdgcn_s_sleep(1);
        if ((++sp & 255u) == 0u) { if (xb_ld(&bar[XB_TMO])) break; if (sp > XB_SPIN_CAP) { atomicAdd(&bar[XB_TMO], 1u); break; } }
    }
    nloc = mine > 0u ? mine : 1u; nx = cnt > 0u ? cnt : 1u;
}

__device__ __forceinline__ void xcd_barrier(const XcdBarrier& b) {
    asm volatile("s_waitcnt vmcnt(0)" ::: "memory");
    __syncthreads();
    if (threadIdx.x == 0) {
        unsigned* bar = b.bar;
        __builtin_amdgcn_s_waitcnt(0);
        unsigned nloc = b.st[0], nx = b.st[1];
        if (nloc == 0u) { xcd_barrier_complete(bar, b.x, nloc, nx); b.st[0] = nloc; b.st[1] = nx; }
        const unsigned old = xb_add(&bar[XB_XSUB(b.x)], 1u);
        const unsigned gen = old / nloc;
        if (old + 1u == (gen + 1u) * nloc) {
            __builtin_amdgcn_fence(__ATOMIC_RELEASE, "agent");
            asm volatile("s_waitcnt vmcnt(0)" ::: "memory");
            const unsigned og = xb_add(&bar[XB_TOP], 1u);
            const unsigned tg = og / nx;
            if (og + 1u == (tg + 1u) * nx) xb_add(&bar[XB_TOPGEN], 1u);
            else XB_SPIN(xb_ld(&bar[XB_TOPGEN]) == tg, bar);
            __builtin_amdgcn_fence(__ATOMIC_ACQUIRE, "agent");
            xb_add(&bar[XB_XGEN(b.x)], 1u);
            asm volatile("s_waitcnt vmcnt(0)" ::: "memory");
        } else {
            XB_SPIN(xb_ld(&bar[XB_XGEN(b.x)]) == gen, bar);
            __builtin_amdgcn_fence(__ATOMIC_ACQUIRE, "agent");
            asm volatile("s_waitcnt vmcnt(0)" ::: "memory");
        }
    }
    __syncthreads();
}


struct Args { const float* in[31]; float* out; unsigned char* ws; int ph_lo, ph_hi; };
struct PArgs { const float* const* in; float* out; unsigned char* ws; };

struct Ctx {
    LAS unsigned char* lds;
    int tid, lane, wave, nblk, blk;
};

DI void transpose_item(const float* W, int ldw, int src_n0, int k0, bf16* dst, int ldd, bool zero, LAS float* scr, int lane) {
    if (!zero) {
#pragma unroll 8
        for (int i = 0; i < 32; ++i) { const int kk = 2 * i + (lane >> 5); scr[kk * 33 + (lane & 31)] = W[(size_t)(k0 + kk) * ldw + src_n0 + (lane & 31)]; }
    }
    LDS_WAIT(); asm volatile("" ::: "memory");
    const int c = lane & 7;
#pragma unroll
    for (int j = 0; j < 4; ++j) { const int n = (lane >> 3) + 8 * j; const LAS float* s = scr + (8 * c) * 33 + n;
        u32x4 o;
        if (zero) { o = (u32x4){0u, 0u, 0u, 0u}; }
        else { o.x = cvt_pk(s[0 * 33], s[1 * 33]); o.y = cvt_pk(s[2 * 33], s[3 * 33]); o.z = cvt_pk(s[4 * 33], s[5 * 33]); o.w = cvt_pk(s[6 * 33], s[7 * 33]); }
        *(u32x4*)(dst + (size_t)n * ldd + k0 + 8 * c) = o; }
    LDS_WAIT(); asm volatile("" ::: "memory");
}

DI void phase_prologue(const Ctx& X, const PArgs& a) {
    unsigned char* ws = a.ws;
    LAS float* scr = (LAS float*)(X.lds + X.wave * 16384);
    const int gw = X.blk * 8 + X.wave, NGW = X.nblk * 8;
    constexpr int I_IN = 16 * (NWIN / 32), I_PA = 8 * 32, I_PB = 8 * 32, I_OUT = 16 * 32;
    constexpr int NITEMS = I_IN + I_PA + I_PB + I_OUT;
    for (int it = gw; it < NITEMS; it += NGW) {
        int r = it;
        if (r < I_IN) { const int kb = r / (NWIN / 32), nb = r % (NWIN / 32); const int n0 = nb * 32;
            const bool zero = (n0 >= 3744 && n0 < 3840); const int src = n0 < 3744 ? n0 : n0 - 96;
            transpose_item(a.in[5], 5792, zero ? 0 : src, kb * 64, (bf16*)(ws + WS_WIN) + (size_t)n0 * 1024, 1024, zero, scr, X.lane); continue; }
        r -= I_IN;
        if (r < I_PA) { const int kb = r / 32, nb = r % 32; transpose_item(a.in[19], 1024, nb * 32, kb * 64, (bf16*)(ws + WS_WPA) + (size_t)(nb * 32) * 512, 512, false, scr, X.lane); continue; }
        r -= I_PA;
        if (r < I_PB) { const int kb = r / 32, nb = r % 32; transpose_item(a.in[20], 1024, nb * 32, kb * 64, (bf16*)(ws + WS_WPB) + (size_t)(nb * 32) * 512, 512, false, scr, X.lane); continue; }
        r -= I_PB;
        { const int kb = r / 32, nb = r % 32; transpose_item(a.in[21], 1024, nb * 32, kb * 64, (bf16*)(ws + WS_WOUT) + (size_t)(nb * 32) * 1024, 1024, false, scr, X.lane); }
    }
    __syncthreads();
    {
        LAS float* cs = (LAS float*)X.lds;
        LAS float* part = (LAS float*)(X.lds + 8192);
        for (int i = X.tid; i < 2048; i += 512) cs[i] = siluf_(a.in[1][i]);
        __syncthreads();
        const float* aw = a.in[2]; const float* ab = a.in[3]; float* mod = (float*)(ws + WS_MOD);
        for (int cb = X.blk; cb < 256; cb += X.nblk) {
            const int c = X.tid % 24, kg = X.tid / 24;
            float s0 = 0.f, s1 = 0.f;
            if (kg < 21) for (int k = kg; k < 1024; k += 21) { const float w = aw[(size_t)k * 6144 + cb * 24 + c]; s0 += cs[k] * w; s1 += cs[1024 + k] * w; }
            if (kg < 21) { part[(kg * 24 + c) * 2] = s0; part[(kg * 24 + c) * 2 + 1] = s1; }
            __syncthreads();
            if (X.tid < 48) { const int cc = X.tid >> 1, b = X.tid & 1; float s = 0.f;
                for (int q = 0; q < 21; ++q) s += part[(q * 24 + cc) * 2 + b];
                mod[b * 6144 + cb * 24 + cc] = s + ab[cb * 24 + cc]; }
            __syncthreads();
        }
    }
}

DI void phase_norm1(const Ctx& X, const PArgs& a) {
    const float* x = a.in[0]; const float* g1 = a.in[4]; const float* mod = (const float*)(a.ws + WS_MOD);
    bf16* h = (bf16*)a.out;
    const int gw = X.blk * 8 + X.wave, NGW = X.nblk * 8;
    for (int m = gw; m < NTOK; m += NGW) {
        const int b = m >> 13;
        const f32x4* xr = (const f32x4*)(x + (size_t)m * DM) + X.lane;
        f32x4 v[4]; float s = 0.f;
#pragma unroll
        for (int j = 0; j < 4; ++j) { v[j] = xr[64 * j]; s += (v[j].x * v[j].x + v[j].y * v[j].y) + (v[j].z * v[j].z + v[j].w * v[j].w); }
        const float rs = 1.0f / sqrtf(wave_sum(s) * (1.f / DM) + 1e-6f);
        u32x2* o = (u32x2*)(h + (size_t)m * DM) + X.lane;
#pragma unroll
        for (int j = 0; j < 4; ++j) { const int col = 4 * X.lane + 256 * j;
            const f32x4 g = *(const f32x4*)(g1 + col), sh = *(const f32x4*)(mod + b * 6144 + col), sc = *(const f32x4*)(mod + b * 6144 + 1024 + col);
            const f32x4 y = v[j] * rs * g * (1.0f + sc) + sh;
            u32x2 w; w.x = cvt_pk(y.x, y.y); w.y = cvt_pk(y.z, y.w); o[64 * j] = w; }
    }
    {
        const float* g2 = a.in[22]; const float* wgr = a.in[23]; const float* bgr = a.in[24]; const float* wer = a.in[25]; const float* ber = a.in[26];
        bf16* WRH = (bf16*)(a.ws + WS_WRH); bf16* WRL = (bf16*)(a.ws + WS_WRL); float* CB = (float*)(a.ws + WS_CB);
        for (int idx = X.blk * 512 + X.tid; idx < 2 * 48 * 1024; idx += X.nblk * 512) {
            const int k = idx & 1023, o = (idx >> 10) % 48, b = idx / (48 * 1024);
            float wv = 0.f;
            if (o < 4) wv = wgr[k * 4 + o]; else if (o < 36) wv = wer[k * 32 + (o - 4)];
            wv *= g2[k] * (1.0f + mod[b * 6144 + 4096 + k]);
            const bf16 hi = f2bf(wv); const bf16 lo = f2bf(wv - bf2f(hi));
            WRH[idx] = hi; WRL[idx] = lo;
        }
        if (gw < 96) { const int b = gw / 48, o = gw % 48; float s = 0.f;
            if (o < 36) for (int k = X.lane; k < 1024; k += 64) s += mod[b * 6144 + 3072 + k] * (o < 4 ? wgr[k * 4 + o] : wer[k * 32 + (o - 4)]);
            s = wave_sum(s);
            if (X.lane == 0) CB[b * 48 + o] = o < 4 ? s + bgr[o] : (o < 36 ? s + ber[o - 4] : 0.f); }
    }
}

constexpr int HG_CUMLD = 132;
DI float hg_lb_of(const float* hg_lb, int idx) { return 1.0f / (1.0f + __expf(hg_lb[512 + idx] - hg_lb[idx])); }

DI void hg_load_f(const Ctx& X, const bf16* proj, const float* hg_lb, int row0, int hh, LAS float* CUM, float (&f)[16]) {
    const int t = X.tid >> 3, cg = (X.tid & 7) * 16;
    const u32x4* src = (const u32x4*)(proj + (size_t)(row0 + t) * LDP + C_HF + hh * 128 + cg);
    const u32x4 r0 = src[0], r1 = src[1];
    const unsigned w[8] = {r0.x, r0.y, r0.z, r0.w, r1.x, r1.y, r1.z, r1.w};
#pragma unroll
    for (int e = 0; e < 8; ++e) {
        const float lb0 = hg_lb_of(hg_lb, hh * 128 + cg + 2 * e), lb1 = hg_lb_of(hg_lb, hh * 128 + cg + 2 * e + 1);
        f[2 * e] = lb0 + (1.0f - lb0) * sigmoidf_(bflo(w[e])); f[2 * e + 1] = lb1 + (1.0f - lb1) * sigmoidf_(bfhi(w[e]));
    }
#pragma unroll
    for (int e = 0; e < 16; e += 4) *(LAS f32x4*)(CUM + t * HG_CUMLD + cg + e) = (f32x4){__logf(f[e]), __logf(f[e + 1]), __logf(f[e + 2]), __logf(f[e + 3])};
}
DI void hg_scan(const Ctx& X, LAS float* CUM, LAS float* TOT) {
    const int k = X.tid & 127, seg = X.tid >> 7;
    float v[16]; float run = 0.f;
#pragma unroll
    for (int i = 0; i < 16; ++i) { run += CUM[(seg * 16 + i) * HG_CUMLD + k]; v[i] = run; }
    TOT[seg * 128 + k] = run;
    __syncthreads();
    float off = 0.f;
#pragma unroll
    for (int s = 0; s < 3; ++s) off += (s < seg) ? TOT[s * 128 + k] : 0.f;
#pragma unroll
    for (int i = 0; i < 16; ++i) CUM[(seg * 16 + i) * HG_CUMLD + k] = v[i] + off;
    __syncthreads();
}

DI void hg1_unit(const Ctx& X, const PArgs& a, int u) {
    const bf16* proj = (const bf16*)(a.ws + WS_PROJ);
    const int pair = u >> 7, c = u & 127, b = pair >> 2, hh = pair & 3, row0 = b * SEQ + c * 64;
    LAS float* CUM = (LAS float*)X.lds; LAS float* TOT = (LAS float*)(X.lds + 33792);
    LAS bf16* KDT = (LAS bf16*)(X.lds + 36864); LAS bf16* VT = (LAS bf16*)(X.lds + 55296);
    float f[16];
    const int t = X.tid >> 3, cg = (X.tid & 7) * 16;
    const u32x4* srci = (const u32x4*)(proj + (size_t)(row0 + t) * LDP + C_HI + hh * 128 + cg);
    const u32x4 r0 = srci[0], r1 = srci[1];
    hg_load_f(X, proj, a.in[6], row0, hh, CUM, f);
    __syncthreads();
    hg_scan(X, CUM, TOT);
    if (X.tid < 128) ((float*)(a.ws + WS_HGC))[(size_t)u * 128 + X.tid] = __expf(CUM[63 * HG_CUMLD + X.tid]);
    {
        const unsigned w[8] = {r0.x, r0.y, r0.z, r0.w, r1.x, r1.y, r1.z, r1.w};
#pragma unroll
        for (int e = 0; e < 16; ++e) {
            const int k = cg + e;
            const float kd = (1.0f - f[e]) * __expf(CUM[63 * HG_CUMLD + k] - CUM[t * HG_CUMLD + k]);
            KDT[k * 72 + t] = f2bf(kd);
            VT[k * 72 + t] = (bf16)((e & 1) ? (w[e >> 1] >> 16) : (w[e >> 1] & 0xffffu));
        }
    }
    __syncthreads();
    {
        const int w = X.wave, v0 = 32 * (w >> 1), k0 = 64 * (w & 1), r = X.lane & 15, g = X.lane >> 4;
        f32x4 acc[4][2]; zero_acc(acc);
        mm_ll<4, 2, 2>(KDT + k0 * 72, 72, VT + v0 * 72, 72, acc, X.lane);
        bf16* dst = (bf16*)(a.ws + WS_HS) + (size_t)u * 16384;
#pragma unroll
        for (int tp = 0; tp < 4; ++tp)
#pragma unroll
            for (int tq = 0; tq < 2; ++tq) { u32x2 o; o.x = cvt_pk(acc[tp][tq][0], acc[tp][tq][1]); o.y = cvt_pk(acc[tp][tq][2], acc[tp][tq][3]);
                *(u32x2*)(dst + (v0 + 16 * tq + r) * 128 + k0 + 16 * tp + 4 * g) = o; }
    }
    __syncthreads();
}

DI void hg2_scan(const Ctx& X, const PArgs& a, bool dry = false) {
    const float* gc = (const float*)(a.ws + WS_HGC);
    for (int it = X.blk * 512 + X.tid; it < 65536; it += X.nblk * 512) {
        const int pair = it >> 13, rem = it & 8191;
        const int kp = rem & 63;
        unsigned* base = (unsigned*)(a.ws + WS_HS) + (size_t)pair * 128 * 8192 + rem;
        const float* gb = gc + (size_t)pair * 128 * 128 + kp * 2;
        float s0 = 0.f, s1 = 0.f;
        for (int cb = 0; cb < 128; cb += 8) {
            unsigned uu[8]; f32x2 gg[8];
#pragma unroll
            for (int i = 0; i < 8; ++i) { uu[i] = base[(size_t)(cb + i) * 8192]; gg[i] = *(const f32x2*)(gb + (cb + i) * 128); }
#pragma unroll
            for (int i = 0; i < 8; ++i) { if (!dry || s0 == 1.2345e33f) base[(size_t)(cb + i) * 8192] = cvt_pk(s0, s1); s0 = gg[i].x * s0 + bflo(uu[i]); s1 = gg[i].y * s1 + bfhi(uu[i]); }
        }
    }
}

DI void hg3_unit(const Ctx& X, const PArgs& a, int u, bool dry = false) {
    bf16* proj = (bf16*)(a.ws + WS_PROJ);
    const int pair = u >> 7, c = u & 127, b = pair >> 2, hh = pair & 3, row0 = b * SEQ + c * 64;
    LAS float* CUM = (LAS float*)X.lds; LAS float* TOT = (LAS float*)(X.lds + 33792);
    LAS float* RED = (LAS float*)(X.lds + 36352);
    LAS bf16* QD = (LAS bf16*)(X.lds + 36864); LAS bf16* QT = (LAS bf16*)(X.lds + 54272); LAS bf16* KT = (LAS bf16*)(X.lds + 71680);
    LAS bf16* VT = (LAS bf16*)(X.lds + 89088); LAS bf16* PM = (LAS bf16*)(X.lds + 107520);
    float f[16];
    const int w = X.wave, r = X.lane & 15, g = X.lane >> 4, tq0 = 16 * (w >> 1);
    const u32x4* sq = (const u32x4*)(proj + (size_t)(row0 + (X.tid >> 3)) * LDP + C_HQ + hh * 128 + (X.tid & 7) * 16);
    const u32x4* sv = (const u32x4*)(proj + (size_t)(row0 + (X.tid >> 3)) * LDP + C_HI + hh * 128 + (X.tid & 7) * 16);
    const u32x4 q0 = sq[0], q1 = sq[1], i0 = sv[0], i1 = sv[1];
    u32x2 ggw[4];
#pragma unroll
    for (int tp = 0; tp < 4; ++tp) ggw[tp] = *(const u32x2*)(proj + (size_t)(row0 + tq0 + r) * LDP + C_HG + hh * 128 + 64 * (w & 1) + 16 * tp + 4 * g);
    hg_load_f(X, proj, a.in[6], row0, hh, CUM, f);
    __syncthreads();
    hg_scan(X, CUM, TOT);
    {
        const int t = X.tid >> 3, cg = (X.tid & 7) * 16;
        const unsigned qw[8] = {q0.x, q0.y, q0.z, q0.w, q1.x, q1.y, q1.z, q1.w};
        const unsigned iw[8] = {i0.x, i0.y, i0.z, i0.w, i1.x, i1.y, i1.z, i1.w};
        unsigned oqd[8], oqt[8], okt[8];
#pragma unroll
        for (int e = 0; e < 8; ++e) {
            float qd[2], qt[2], kt[2];
#pragma unroll
            for (int hb = 0; hb < 2; ++hb) {
                const int k = cg + 2 * e + hb;
                const float cum = CUM[t * HG_CUMLD + k], ref = CUM[31 * HG_CUMLD + k];
                const float qs = siluf_(hb ? bfhi(qw[e]) : bflo(qw[e]));
                qd[hb] = qs * __expf(cum); qt[hb] = qs * __expf(cum - ref); kt[hb] = (1.0f - f[2 * e + hb]) * __expf(ref - cum);
                VT[k * 72 + t] = (bf16)(hb ? (iw[e] >> 16) : (iw[e] & 0xffffu));
            }
            oqd[e] = cvt_pk(qd[0], qd[1]); oqt[e] = cvt_pk(qt[0], qt[1]); okt[e] = cvt_pk(kt[0], kt[1]);
        }
        *(LAS u32x4*)(QD + t * 136 + cg) = (u32x4){oqd[0], oqd[1], oqd[2], oqd[3]}; *(LAS u32x4*)(QD + t * 136 + cg + 8) = (u32x4){oqd[4], oqd[5], oqd[6], oqd[7]};
        *(LAS u32x4*)(QT + t * 136 + cg) = (u32x4){oqt[0], oqt[1], oqt[2], oqt[3]}; *(LAS u32x4*)(QT + t * 136 + cg + 8) = (u32x4){oqt[4], oqt[5], oqt[6], oqt[7]};
        *(LAS u32x4*)(KT + t * 136 + cg) = (u32x4){okt[0], okt[1], okt[2], okt[3]}; *(LAS u32x4*)(KT + t * 136 + cg + 8) = (u32x4){okt[4], okt[5], okt[6], okt[7]};
    }
    __syncthreads();
    {
        f32x4 acc[2][1]; zero_acc(acc);
        const int s0 = 32 * (w & 1);
        mm_ll<2, 1, 4>(KT + s0 * 136, 136, QT + tq0 * 136, 136, acc, X.lane);
        const int t = tq0 + r;
#pragma unroll
        for (int tp = 0; tp < 2; ++tp) { const int sb = s0 + 16 * tp + 4 * g; float v[4];
#pragma unroll
            for (int e = 0; e < 4; ++e) v[e] = (sb + e <= t) ? acc[tp][0][e] : 0.f;
            u32x2 o; o.x = cvt_pk(v[0], v[1]); o.y = cvt_pk(v[2], v[3]); *(LAS u32x2*)(PM + t * 72 + sb) = o; }
    }
    __syncthreads();
    {
        const int v0 = 64 * (w & 1), t = tq0 + r;
        f32x4 acc[4][1]; zero_acc(acc);
        mm_gl<4, 1, 4>((const bf16*)(a.ws + WS_HS) + (size_t)u * 16384 + (size_t)v0 * 128, 128, QD + tq0 * 136, 136, acc, X.lane);
        mm_ll<4, 1, 2>(VT + v0 * 72, 72, PM + tq0 * 72, 72, acc, X.lane);
        float ss = 0.f;
#pragma unroll
        for (int tp = 0; tp < 4; ++tp)
#pragma unroll
            for (int e = 0; e < 4; ++e) ss += acc[tp][0][e] * acc[tp][0][e];
        ss += __shfl_xor(ss, 16); ss += __shfl_xor(ss, 32);
        if (g == 0) RED[t * 2 + (w & 1)] = ss;
        __syncthreads();
        const float rs = 1.0f / sqrtf((RED[t * 2] + RED[t * 2 + 1]) * (1.0f / 128.0f) + 1e-6f);
        const float* ng = a.in[7];
#pragma unroll
        for (int tp = 0; tp < 4; ++tp) { const int v = v0 + 16 * tp + 4 * g;
            const u32x2 gw = ggw[tp];
            const f32x4 n4 = *(const f32x4*)(ng + hh * 128 + v);
            const float o0 = acc[tp][0][0] * rs * n4.x * siluf_(bflo(gw.x)), o1 = acc[tp][0][1] * rs * n4.y * siluf_(bfhi(gw.x));
            const float o2 = acc[tp][0][2] * rs * n4.z * siluf_(bflo(gw.y)), o3 = acc[tp][0][3] * rs * n4.w * siluf_(bfhi(gw.y));
            u32x2 o; o.x = cvt_pk(o0, o1); o.y = cvt_pk(o2, o3);
            if (dry) *(u32x2*)((bf16*)a.out + (size_t)16 * 1024 * 1024 + (size_t)(row0 + t) * 512 + hh * 128 + v) = o;
            else *(u32x2*)(proj + (size_t)(row0 + t) * LDP + C_HQ + hh * 128 + v) = o; }
    }
    __syncthreads();
}

constexpr int R_AT = 0, R_RT = 9216, R_BH = 18432, R_KH = 27648, R_BHT = 36864, R_KHT = 46080, R_VT = 55296, R_AAK = 64512, R_ARB = 73728, R_ARK = 82944,
              R_WT = 92160, R_U0T = 101376, R_XB = 110592, R_CUM = 144384, R_GC = 161792;
constexpr int R_LW = 64512, R_LA = 69632, R_W2T = 74752, R_A2T = 79872;
constexpr int R_TOT = 92160, R_RED = 94208;
constexpr int XBLD = 132, CUMLD = 68;

DI float tanh_fast(float x) { return 1.0f - 2.0f / (1.0f + __expf(2.0f * x)); }
DI f32x4 rw_shift4(const bf16* proj, const float* mu, int row, int col, bool first) {
    const u32x2 cw = *(const u32x2*)(proj + (size_t)row * LDP + col);
    u32x2 pw = (u32x2){0u, 0u};
    if (!first) pw = *(const u32x2*)(proj + (size_t)(row - 1) * LDP + col);
    const f32x4 m = *(const f32x4*)(mu + (col - C_RR));
    const f32x4 c = (f32x4){bflo(cw.x), bfhi(cw.x), bflo(cw.y), bfhi(cw.y)}, p = (f32x4){bflo(pw.x), bfhi(pw.x), bflo(pw.y), bfhi(pw.y)};
    return c + m * (p - c);
}

#if defined(MK_TPROBE)
#define TPROBE(k) do { if (X.blk == 0 && X.tid == 0) { const unsigned long long now_ = __builtin_amdgcn_s_memtime(); float* T_ = (float*)(a.ws + WS_CTL) + 32768; T_[k] += (float)(now_ - tp_last); tp_last = now_; } } while (0)
#else
#define TPROBE(k) do { } while (0)
#endif
DI void rw1_unit(const Ctx& X, const PArgs& a, int u) {
#if defined(MK_TPROBE)
    unsigned long long tp_last = __builtin_amdgcn_s_memtime();
#endif
    const bf16* proj = (const bf16*)(a.ws + WS_PROJ);
    const float* mu = a.in[8];
    const int pair = u >> 7, c = u & 127, b = pair >> 3, h = pair & 7, row0 = b * SEQ + c * 64;
    LAS unsigned char* L = X.lds;
    LAS bf16 *AT = (LAS bf16*)(L + R_AT), *RT = (LAS bf16*)(L + R_RT), *BH = (LAS bf16*)(L + R_BH), *KH = (LAS bf16*)(L + R_KH), *BHT = (LAS bf16*)(L + R_BHT), *KHT = (LAS bf16*)(L + R_KHT),
             *VT = (LAS bf16*)(L + R_VT), *AAK = (LAS bf16*)(L + R_AAK), *ARB = (LAS bf16*)(L + R_ARB), *ARK = (LAS bf16*)(L + R_ARK), *WT = (LAS bf16*)(L + R_WT), *U0T = (LAS bf16*)(L + R_U0T),
             *LW = (LAS bf16*)(L + R_LW), *LA = (LAS bf16*)(L + R_LA), *W2T = (LAS bf16*)(L + R_W2T), *A2T = (LAS bf16*)(L + R_A2T);
    LAS float *XB = (LAS float*)(L + R_XB), *CUM = (LAS float*)(L + R_CUM), *GC = (LAS float*)(L + R_GC), *TOT = (LAS float*)(L + R_TOT), *RED = (LAS float*)(L + R_RED);
    const int w = X.wave, r = X.lane & 15, g = X.lane >> 4;
    const int t = 16 * (w >> 1) + r, jb = 32 * (w & 1) + 4 * g;
    f32x4 rr_[2], kk_[2], vv_[2], w0_[2], a0_[2], kk_c[2], ka_c[2], rk_c[2];
#pragma unroll
    for (int i = 0; i < 2; ++i) { const int col = h * 64 + jb + 16 * i; const bool first = (c == 0 && t == 0);
        rr_[i] = rw_shift4(proj, mu, row0 + t, C_RR + col, first); kk_[i] = rw_shift4(proj, mu, row0 + t, C_RK + col, first); vv_[i] = rw_shift4(proj, mu, row0 + t, C_RV + col, first);
        w0_[i] = *(const f32x4*)(a.in[9] + col); a0_[i] = *(const f32x4*)(a.in[11] + col); kk_c[i] = *(const f32x4*)(a.in[14] + col); ka_c[i] = *(const f32x4*)(a.in[15] + col); rk_c[i] = *(const f32x4*)(a.in[16] + col); }
    {
        const int t = X.tid >> 3, c8 = (X.tid & 7) * 8; const bool first = (c == 0 && t == 0);
        const f32x4 v0 = rw_shift4(proj, mu, row0 + t, C_WD + c8, first), v1 = rw_shift4(proj, mu, row0 + t, C_WD + c8 + 4, first);
        if (c8 < 32) { u32x4 o; o.x = cvt_pk(tanh_fast(v0.x), tanh_fast(v0.y)); o.y = cvt_pk(tanh_fast(v0.z), tanh_fast(v0.w)); o.z = cvt_pk(tanh_fast(v1.x), tanh_fast(v1.y)); o.w = cvt_pk(tanh_fast(v1.z), tanh_fast(v1.w));
            *(LAS u32x4*)(LW + t * 40 + c8) = o; }
        else { u32x4 o; o.x = cvt_pk(v0.x, v0.y); o.y = cvt_pk(v0.z, v0.w); o.z = cvt_pk(v1.x, v1.y); o.w = cvt_pk(v1.z, v1.w);
            *(LAS u32x4*)(LA + t * 40 + (c8 - 32)) = o; }
        const int m = X.tid >> 4, j4 = (X.tid & 15) * 4;
        const f32x4 w2 = *(const f32x4*)(a.in[10] + m * 512 + h * 64 + j4), a2 = *(const f32x4*)(a.in[12] + m * 512 + h * 64 + j4);
#pragma unroll
        for (int e = 0; e < 4; ++e) { W2T[(j4 + e) * 40 + m] = f2bf(w2[e]); A2T[(j4 + e) * 40 + m] = f2bf(a2[e]); }
    }
    __syncthreads(); TPROBE(0);
    float rs_[8], kf_[8], vs_[8], kkv_[8], aa_[8], lw_[8];
    {
        f32x4 accw[2][1], acca[2][1]; zero_acc(accw); zero_acc(acca);
        mm_ll<2, 1, 1>(W2T + 32 * (w & 1) * 40, 40, LW + 16 * (w >> 1) * 40, 40, accw, X.lane);
        mm_ll<2, 1, 1>(A2T + 32 * (w & 1) * 40, 40, LA + 16 * (w >> 1) * 40, 40, acca, X.lane);
        float ss = 0.f, bon = 0.f;
#pragma unroll
        for (int i = 0; i < 2; ++i) {
            const int j = jb + 16 * i, col = h * 64 + j;
            const f32x4 rr = rr_[i], kk = kk_[i], vv = vv_[i], w0 = w0_[i], a0 = a0_[i], k_k = kk_c[i], k_a = ka_c[i], r_k = rk_c[i];
            f32x4 lw4;
#pragma unroll
            for (int e = 0; e < 4; ++e) {
                const float y = -(w0[e] + accw[i][0][e]);
                const float sp = fmaxf(y, 0.f) + __logf(1.0f + __expf(-fabsf(y)));
                const float wlog = -sp - 0.5f;
                const float lw = -__expf(wlog);
                const float aa = sigmoidf_(a0[e] + acca[i][0][e]);
                const float kkv = kk[e] * k_k[e];
                const float kf = kk[e] * (1.0f + (aa - 1.0f) * k_a[e]);
                ss += kkv * kkv; bon += rr[e] * kf * r_k[e];
                rs_[4 * i + e] = rr[e]; kf_[4 * i + e] = kf; vs_[4 * i + e] = vv[e]; kkv_[4 * i + e] = kkv; aa_[4 * i + e] = aa; lw_[4 * i + e] = lw; lw4[e] = lw;
            }
            *(LAS f32x4*)(CUM + t * CUMLD + j) = lw4;
        }
        ss += __shfl_xor(ss, 16); ss += __shfl_xor(ss, 32); bon += __shfl_xor(bon, 16); bon += __shfl_xor(bon, 32);
        if (g == 0) { RED[(t * 2 + (w & 1)) * 2] = ss; RED[(t * 2 + (w & 1)) * 2 + 1] = bon; }
    }
    __syncthreads(); TPROBE(1);
    {
        const int j = X.tid & 63, seg = X.tid >> 6; float v[8]; float run = 0.f;
#pragma unroll
        for (int i = 0; i < 8; ++i) { run += CUM[(seg * 8 + i) * CUMLD + j]; v[i] = run; }
        TOT[seg * 64 + j] = run;
        __syncthreads();
        float off = 0.f;
#pragma unroll
        for (int s = 0; s < 7; ++s) off += (s < seg) ? TOT[s * 64 + j] : 0.f;
#pragma unroll
        for (int i = 0; i < 8; ++i) CUM[(seg * 8 + i) * CUMLD + j] = v[i] + off;
        if (seg == 7) { const float gc = __expf(v[7] + off); GC[j] = gc; ((float*)(a.ws + WS_RGC))[(size_t)u * 64 + j] = gc; }
    }
    __syncthreads(); TPROBE(2);
    {
        const float ssT = RED[(t * 2) * 2] + RED[(t * 2 + 1) * 2];
        const float inv = 1.0f / sqrtf(fmaxf(ssT, 1e-24f));
        if (g == 0 && (w & 1) == 0) ((float*)(a.ws + WS_BONUS))[(size_t)(row0 + t) * 8 + h] = RED[(t * 2) * 2 + 1] + RED[(t * 2 + 1) * 2 + 1];
#pragma unroll
        for (int i = 0; i < 2; ++i) {
            const int j = jb + 16 * i;
            const f32x4 cum = *(const LAS f32x4*)(CUM + t * CUMLD + j);
            float at[4], rt[4], bh[4], kh[4];
#pragma unroll
            for (int e = 0; e < 4; ++e) {
                const float kkn = kkv_[4 * i + e] * inv;
                const float eneg = __expf(-cum[e]);
                at[e] = -kkn * __expf(cum[e] - lw_[4 * i + e]); rt[e] = rs_[4 * i + e] * __expf(cum[e]);
                bh[e] = kkn * aa_[4 * i + e] * eneg; kh[e] = kf_[4 * i + e] * eneg;
                BHT[(j + e) * 72 + t] = f2bf(bh[e]); KHT[(j + e) * 72 + t] = f2bf(kh[e]); VT[(j + e) * 72 + t] = f2bf(vs_[4 * i + e]);
            }
            *(LAS u32x2*)(AT + t * 72 + j) = (u32x2){cvt_pk(at[0], at[1]), cvt_pk(at[2], at[3])};
            *(LAS u32x2*)(RT + t * 72 + j) = (u32x2){cvt_pk(rt[0], rt[1]), cvt_pk(rt[2], rt[3])};
            *(LAS u32x2*)(BH + t * 72 + j) = (u32x2){cvt_pk(bh[0], bh[1]), cvt_pk(bh[2], bh[3])};
            *(LAS u32x2*)(KH + t * 72 + j) = (u32x2){cvt_pk(kh[0], kh[1]), cvt_pk(kh[2], kh[3])};
            *(LAS f32x4*)(XB + t * XBLD + j) = (f32x4){at[0], at[1], at[2], at[3]};
        }
    }
    __syncthreads(); TPROBE(3);
    {
        LAS float* AAB = CUM;
        const int tq0 = 16 * (w >> 1), s0 = 32 * (w & 1);
        f32x4 ab[2][1], ak[2][1], rb[2][1], rk[2][1]; zero_acc(ab); zero_acc(ak); zero_acc(rb); zero_acc(rk);
        mm_ll<2, 1, 2>(BH + s0 * 72, 72, AT + tq0 * 72, 72, ab, X.lane);
        mm_ll<2, 1, 2>(KH + s0 * 72, 72, AT + tq0 * 72, 72, ak, X.lane);
        mm_ll<2, 1, 2>(BH + s0 * 72, 72, RT + tq0 * 72, 72, rb, X.lane);
        mm_ll<2, 1, 2>(KH + s0 * 72, 72, RT + tq0 * 72, 72, rk, X.lane);
#pragma unroll
        for (int tp = 0; tp < 2; ++tp) { const int sb = s0 + 16 * tp + 4 * g; f32x4 vab; float vak[4], vrb[4], vrk[4];
#pragma unroll
            for (int e = 0; e < 4; ++e) { const bool lo = (sb + e < t), le = (sb + e <= t);
                vab[e] = lo ? ab[tp][0][e] : 0.f; vak[e] = lo ? ak[tp][0][e] : 0.f; vrb[e] = le ? rb[tp][0][e] : 0.f; vrk[e] = le ? rk[tp][0][e] : 0.f; }
            *(LAS f32x4*)(AAB + t * CUMLD + sb) = vab;
            *(LAS u32x2*)(AAK + t * 72 + sb) = (u32x2){cvt_pk(vak[0], vak[1]), cvt_pk(vak[2], vak[3])};
            *(LAS u32x2*)(ARB + t * 72 + sb) = (u32x2){cvt_pk(vrb[0], vrb[1]), cvt_pk(vrb[2], vrb[3])};
            *(LAS u32x2*)(ARK + t * 72 + sb) = (u32x2){cvt_pk(vrk[0], vrk[1]), cvt_pk(vrk[2], vrk[3])}; }
    }
    __syncthreads(); TPROBE(4);
    LAS bf16* AABH = (LAS bf16*)(L + R_BH);
    LAS bf16* TINV = (LAS bf16*)(L + R_AT);
    LAS bf16* YT = (LAS bf16*)(L + R_KH);
    {
        const int tq0 = 16 * (w >> 1), i0 = 32 * (w & 1);
        f32x4 acc[2][1]; zero_acc(acc);
        mm_ll<2, 1, 2>(VT + i0 * 72, 72, AAK + tq0 * 72, 72, acc, X.lane);
#pragma unroll
        for (int tp = 0; tp < 2; ++tp) *(LAS f32x4*)(XB + t * XBLD + 64 + i0 + 16 * tp + 4 * g) = acc[tp][0];
        { const int tt = X.tid >> 3, s8 = (X.tid & 7) * 8; const f32x4 a0 = *(const LAS f32x4*)(CUM + tt * CUMLD + s8), a1 = *(const LAS f32x4*)(CUM + tt * CUMLD + s8 + 4);
          *(LAS u32x4*)(AABH + tt * 72 + s8) = (u32x4){cvt_pk(a0[0], a0[1]), cvt_pk(a0[2], a0[3]), cvt_pk(a1[0], a1[1]), cvt_pk(a1[2], a1[3])}; }
#pragma unroll
        for (int q = 0; q < 9; ++q) ((LAS unsigned*)WT)[X.tid * 9 + q] = 0u;
        if (w < 4) {
            const int l = X.lane & 15;
            float ar[16];
#pragma unroll
            for (int q = 0; q < 4; ++q) { const f32x4 v = *(const LAS f32x4*)(CUM + (16 * w + l) * CUMLD + 16 * w + 4 * q); ar[4 * q] = v[0]; ar[4 * q + 1] = v[1]; ar[4 * q + 2] = v[2]; ar[4 * q + 3] = v[3]; }
            float x[16];
#pragma unroll
            for (int i = 0; i < 16; ++i) { float xi = (i == l) ? 1.0f : 0.0f;
#pragma unroll
                for (int ip = 0; ip < i; ++ip) xi += __int_as_float(__builtin_amdgcn_readlane(__float_as_int(ar[ip]), i)) * x[ip];
                x[i] = xi; }
            if (X.lane < 16) {
#pragma unroll
                for (int i = 0; i < 16; ++i) TINV[(w * 16 + i) * 24 + l] = f2bf(x[i]); }
        }
    }
    __syncthreads(); TPROBE(5);
    {
        LAS bf16* Xt = (w < 4 ? WT + 16 * w * 72 : U0T + 16 * (w - 4) * 72);
        LAS bf16* Yw = YT + 16 * w * 24;
        const bf16x8 zf = (bf16x8){0, 0, 0, 0, 0, 0, 0, 0};
#pragma unroll
        for (int bk = 0; bk < 4; ++bk) {
            f32x4 acc = (f32x4){0.f, 0.f, 0.f, 0.f};
#pragma unroll
            for (int ks = 0; ks < (bk + 1) / 2; ++ks) {
                const bf16x8 pf = *(const LAS bf16x8*)(AABH + (16 * bk + r) * 72 + 32 * ks + 8 * g), qf = *(const LAS bf16x8*)(Xt + r * 72 + 32 * ks + 8 * g);
                acc = mfma16(pf, qf, acc); }
#pragma unroll
            for (int e = 0; e < 4; ++e) acc[e] += XB[(16 * bk + 4 * g + e) * XBLD + 16 * w + r];
            *(LAS u32x2*)(Yw + r * 24 + 4 * g) = (u32x2){cvt_pk(acc[0], acc[1]), cvt_pk(acc[2], acc[3])};
            asm volatile("s_waitcnt lgkmcnt(0)" ::: "memory");
            bf16x8 pf = zf, qf = zf;
            if (g < 2) { pf = *(const LAS bf16x8*)(TINV + (bk * 16 + r) * 24 + 8 * g); qf = *(const LAS bf16x8*)(Yw + r * 24 + 8 * g); }
            const f32x4 xs = mfma16(pf, qf, (f32x4){0.f, 0.f, 0.f, 0.f});
            *(LAS u32x2*)(Xt + r * 72 + 16 * bk + 4 * g) = (u32x2){cvt_pk(xs[0], xs[1]), cvt_pk(xs[2], xs[3])};
            asm volatile("s_waitcnt lgkmcnt(0)" ::: "memory");
        }
    }
    __syncthreads(); TPROBE(6);
    {
        bf16* out = (bf16*)(a.ws + WS_RM) + (size_t)u * 16384;
        const int q0 = 16 * (w >> 1), p0 = 32 * (w & 1), qq = q0 + r;
        f32x4 accG[2][1], accY[2][1], accM[2][1], accN[2][1]; zero_acc(accG); zero_acc(accY); zero_acc(accM); zero_acc(accN);
        mm_ll<2, 1, 2>(WT + p0 * 72, 72, ARB + q0 * 72, 72, accG, X.lane);
        mm_ll<2, 1, 2>(U0T + p0 * 72, 72, ARB + q0 * 72, 72, accY, X.lane);
        mm_ll<2, 1, 2>(VT + p0 * 72, 72, ARK + q0 * 72, 72, accY, X.lane);
        mm_ll<2, 1, 2>(WT + p0 * 72, 72, BHT + q0 * 72, 72, accM, X.lane);
        mm_ll<2, 1, 2>(BHT + p0 * 72, 72, U0T + q0 * 72, 72, accN, X.lane);
        mm_ll<2, 1, 2>(KHT + p0 * 72, 72, VT + q0 * 72, 72, accN, X.lane);
        const float gq = GC[qq];
        unsigned mw[4], nw_[4];
#pragma unroll
        for (int tp = 0; tp < 2; ++tp) { const int pp = p0 + 16 * tp + 4 * g;
            const u32x2 rtw = *(const LAS u32x2*)(RT + qq * 72 + pp);
            const f32x4 gp = *(const LAS f32x4*)(GC + pp);
            const f32x4 G4 = accG[tp][0] + (f32x4){bflo(rtw.x), bfhi(rtw.x), bflo(rtw.y), bfhi(rtw.y)};
            const f32x4 M4 = accM[tp][0] * gq, N4 = accN[tp][0] * gp;
            mw[2 * tp] = cvt_pk(M4[0], M4[1]); mw[2 * tp + 1] = cvt_pk(M4[2], M4[3]);
            nw_[2 * tp] = cvt_pk(N4[0], N4[1]); nw_[2 * tp + 1] = cvt_pk(N4[2], N4[3]);
            *(u32x2*)(out + 2 * 4096 + qq * 64 + pp) = (u32x2){cvt_pk(G4[0], G4[1]), cvt_pk(G4[2], G4[3])};
            *(u32x2*)(out + 3 * 4096 + qq * 64 + pp) = (u32x2){cvt_pk(accY[tp][0][0], accY[tp][0][1]), cvt_pk(accY[tp][0][2], accY[tp][0][3])}; }
        *(u32x4*)(out + 0 * 4096 + X.tid * 8) = (u32x4){mw[0], mw[1], mw[2], mw[3]};
        *(u32x4*)(out + 1 * 4096 + ((w >> 1) * 64 + X.lane) * 16 + (w & 1) * 8) = (u32x4){nw_[0], nw_[1], nw_[2], nw_[3]};
    }
    __syncthreads(); TPROBE(7);
}

constexpr int R2D = 4;
DI void rw2_chain(const Ctx& X, const PArgs& a, int ch) {
    const int pair = ch >> 2, it = ch & 3, r = X.lane & 15, g = X.lane >> 4, i = 16 * it + r;
    const bf16* RM = (const bf16*)(a.ws + WS_RM); bf16* RS = (bf16*)(a.ws + WS_RS);
    LAS float* GCL = (LAS float*)X.lds;
    { const f32x4* src = (const f32x4*)((const float*)(a.ws + WS_RGC) + (size_t)pair * 128 * 64);
      for (int q = X.lane; q < 2048; q += 64) *(LAS f32x4*)(GCL + 4 * q) = src[q]; }
    f32x4 acc[4];
#pragma unroll
    for (int pt = 0; pt < 4; ++pt) acc[pt] = (f32x4){0.f, 0.f, 0.f, 0.f};
    u32x4 mreg[R2D][8], nreg[R2D][2];
#define R2_LOAD(s, c) do { const bf16* M_ = RM + ((size_t)pair * 128 + (c)) * 16384; \
        _Pragma("unroll") for (int q = 0; q < 8; ++q) mreg[s][q] = *(const u32x4*)(M_ + (q * 64 + X.lane) * 8); \
        _Pragma("unroll") for (int q = 0; q < 2; ++q) nreg[s][q] = *(const u32x4*)(M_ + 4096 + (it * 64 + X.lane) * 16 + q * 8); } while (0)
#pragma unroll
    for (int s = 0; s < R2D; ++s) R2_LOAD(s, s);
    LDS_WAIT();
    for (int c0 = 0; c0 < 128; c0 += R2D) {
#pragma unroll
        for (int s = 0; s < R2D; ++s) {
            const int c = c0 + s; const size_t u = (size_t)pair * 128 + c;
            f32x4 nw[4];
#pragma unroll
            for (int pt = 0; pt < 4; ++pt) { const unsigned lo = nreg[s][pt >> 1][(pt & 1) * 2], hi = nreg[s][pt >> 1][(pt & 1) * 2 + 1];
                const f32x4 gcv = *(const LAS f32x4*)(GCL + c * 64 + 16 * pt + 4 * g);
                nw[pt] = (f32x4){bflo(lo), bfhi(lo), bflo(hi), bfhi(hi)} + gcv * acc[pt]; }
            unsigned pk[4][2];
#pragma unroll
            for (int pt = 0; pt < 4; ++pt) { pk[pt][0] = cvt_pk(acc[pt][0], acc[pt][1]); pk[pt][1] = cvt_pk(acc[pt][2], acc[pt][3]);
                *(u32x2*)(RS + u * 4096 + i * 64 + 16 * pt + 4 * g) = (u32x2){pk[pt][0], pk[pt][1]}; }
            const bf16x8 sf0 = __builtin_bit_cast(bf16x8, (u32x4){pk[0][0], pk[0][1], pk[1][0], pk[1][1]});
            const bf16x8 sf1 = __builtin_bit_cast(bf16x8, (u32x4){pk[2][0], pk[2][1], pk[3][0], pk[3][1]});
#pragma unroll
            for (int pt = 0; pt < 4; ++pt) { nw[pt] = mfma16(__builtin_bit_cast(bf16x8, mreg[s][2 * pt]), sf0, nw[pt]); nw[pt] = mfma16(__builtin_bit_cast(bf16x8, mreg[s][2 * pt + 1]), sf1, nw[pt]); acc[pt] = nw[pt]; }
            if (c + R2D < 128) R2_LOAD(s, c + R2D);
        }
    }
#undef R2_LOAD
}

DI void rw3_unit(const Ctx& X, const PArgs& a, int u) {
    bf16* proj = (bf16*)(a.ws + WS_PROJ);
    const float* mu = a.in[8];
    const int pair = u >> 7, c = u & 127, b = pair >> 3, h = pair & 7, row0 = b * SEQ + c * 64;
    LAS bf16* SG = (LAS bf16*)X.lds;
    LAS bf16* G2T = (LAS bf16*)(X.lds + 13312);
    LAS float* RED = (LAS float*)(X.lds + 26624);
    const int w = X.wave, r = X.lane & 15, g = X.lane >> 4;
    const int t = 16 * (w >> 1) + r, i0 = 32 * (w & 1);
    const bf16* RMu = (const bf16*)(a.ws + WS_RM) + (size_t)u * 16384;
    f32x4 vvh[2], gwh[2], gbh[2]; u32x2 y0h[2];
#pragma unroll
    for (int tp = 0; tp < 2; ++tp) { const int col = h * 64 + i0 + 16 * tp + 4 * g;
        vvh[tp] = rw_shift4(proj, mu, row0 + t, C_RV + col, (c == 0 && t == 0)); gwh[tp] = *(const f32x4*)(a.in[17] + col); gbh[tp] = *(const f32x4*)(a.in[18] + col);
        y0h[tp] = *(const u32x2*)(RMu + 3 * 4096 + t * 64 + i0 + 16 * tp + 4 * g); }
    const float bonus = ((const float*)(a.ws + WS_BONUS))[(size_t)(row0 + t) * 8 + h];
    for (int idx = X.tid; idx < 64 * 24; idx += 512) {
        const int t = idx / 24, c4 = (idx % 24) * 4; const bool first = (c == 0 && t == 0);
        const f32x4 v = rw_shift4(proj, mu, row0 + t, C_GD + c4, first);
        *(LAS u32x2*)(SG + t * 104 + c4) = (u32x2){cvt_pk(sigmoidf_(v.x), sigmoidf_(v.y)), cvt_pk(sigmoidf_(v.z), sigmoidf_(v.w))};
    }
    for (int idx = X.tid; idx < 96 * 16; idx += 512) {
        const int m = idx >> 4, j4 = (idx & 15) * 4;
        const f32x4 g2 = *(const f32x4*)(a.in[13] + m * 512 + h * 64 + j4);
#pragma unroll
        for (int e = 0; e < 4; ++e) G2T[(j4 + e) * 104 + m] = f2bf(g2[e]);
    }
    __syncthreads();
    f32x4 acc[2][1], gg[2][1]; zero_acc(acc); zero_acc(gg);
    mm_gg<2, 1, 2>((const bf16*)(a.ws + WS_RS) + (size_t)u * 4096 + (size_t)i0 * 64, 64, RMu + 2 * 4096 + 16 * (w >> 1) * 64, 64, acc, X.lane);
    mm_ll<2, 1, 3>(G2T + i0 * 104, 104, SG + 16 * (w >> 1) * 104, 104, gg, X.lane);
    float s = 0.f;
#pragma unroll
    for (int tp = 0; tp < 2; ++tp) { const u32x2 y0 = y0h[tp];
        acc[tp][0] += (f32x4){bflo(y0.x), bfhi(y0.x), bflo(y0.y), bfhi(y0.y)};
        s += (acc[tp][0][0] + acc[tp][0][1]) + (acc[tp][0][2] + acc[tp][0][3]); }
    s += __shfl_xor(s, 16); s += __shfl_xor(s, 32);
    if (g == 0) RED[(t * 2 + (w & 1)) * 2] = s;
    __syncthreads();
    const float mean = (RED[(t * 2) * 2] + RED[(t * 2 + 1) * 2]) * (1.0f / 64.0f);
    float q = 0.f;
#pragma unroll
    for (int tp = 0; tp < 2; ++tp)
#pragma unroll
        for (int e = 0; e < 4; ++e) { const float d = acc[tp][0][e] - mean; q += d * d; }
    q += __shfl_xor(q, 16); q += __shfl_xor(q, 32);
    if (g == 0) RED[(t * 2 + (w & 1)) * 2 + 1] = q;
    __syncthreads();
    const float rstd = 1.0f / sqrtf((RED[(t * 2) * 2 + 1] + RED[(t * 2 + 1) * 2 + 1]) * (1.0f / 64.0f) + 64e-5f);
#pragma unroll
    for (int tp = 0; tp < 2; ++tp) { const int i = i0 + 16 * tp + 4 * g, col = h * 64 + i;
        const f32x4 vv = vvh[tp], gw = gwh[tp], gb = gbh[tp];
        f32x4 o;
#pragma unroll
        for (int e = 0; e < 4; ++e) o[e] = ((acc[tp][0][e] - mean) * rstd * gw[e] + gb[e] + bonus * vv[e]) * gg[tp][0][e];
        *(u32x2*)(proj + (size_t)(row0 + t) * LDP + C_RR + col) = (u32x2){cvt_pk(o[0], o[1]), cvt_pk(o[2], o[3])}; }
    __syncthreads();
}

namespace epi {
using pg8::Unit; using pg8::BM; using pg8::HALF;
struct InProj {
    static constexpr bool PERM = true, AFTER_DRAIN = false;
    bf16* proj; bf16* ga; bf16* gb;
    DI void operator()(const f32x4 (&acc)[2][2][4][2], const Unit& u, int wr, int wc, int fr, int fq) const {
        const int row0 = u.pm * BM + wr * 64 + fr;
        const bool gate = u.pn >= 15;
        bf16* base = !gate ? proj + u.pn * BM : (u.pn < 19 ? ga + (u.pn - 15) * BM : gb + (u.pn - 19) * BM);
        const int ldc = gate ? 1024 : LDP, col0 = wc * 32 + 8 * fq;
#pragma unroll
        for (int ai = 0; ai < 2; ++ai)
#pragma unroll
            for (int m = 0; m < 4; ++m) { bf16* rowp = base + (size_t)(row0 + ai * HALF + m * 16) * ldc + col0;
#pragma unroll
                for (int bj = 0; bj < 2; ++bj) { f32x4 v0 = acc[ai][bj][m][0], v1 = acc[ai][bj][m][1];
                    if (gate) {
#pragma unroll
                        for (int e = 0; e < 4; ++e) { v0[e] = sigmoidf_(v0[e]); v1[e] = sigmoidf_(v1[e]); } }
                    *(u32x4*)(rowp + bj * HALF) = (u32x4){cvt_pk(v0[0], v0[1]), cvt_pk(v0[2], v0[3]), cvt_pk(v1[0], v1[1]), cvt_pk(v1[2], v1[3])}; } }
    }
};
template <bool ADD> struct GateMix {
    static constexpr bool PERM = true, AFTER_DRAIN = false;
    bf16* O; int ldc; const bf16* gate; int ldg;
    DI void operator()(const f32x4 (&acc)[2][2][4][2], const Unit& u, int wr, int wc, int fr, int fq) const {
        const int row0 = u.pm * BM + wr * 64 + fr, col0 = u.pn * BM + wc * 32 + 8 * fq;
#pragma unroll
        for (int ai = 0; ai < 2; ++ai)
#pragma unroll
            for (int m = 0; m < 4; ++m) { const size_t row = (size_t)(row0 + ai * HALF + m * 16);
#pragma unroll
                for (int bj = 0; bj < 2; ++bj) { const f32x4 v0 = acc[ai][bj][m][0], v1 = acc[ai][bj][m][1];
                    const u32x4 gw = *(const u32x4*)(gate + row * ldg + col0 + bj * HALF);
                    float o[8] = {v0[0] * bflo(gw.x), v0[1] * bfhi(gw.x), v0[2] * bflo(gw.y), v0[3] * bfhi(gw.y), v1[0] * bflo(gw.z), v1[1] * bfhi(gw.z), v1[2] * bflo(gw.w), v1[3] * bfhi(gw.w)};
                    bf16* op = O + row * ldc + col0 + bj * HALF;
                    if (ADD) { const u32x4 pw = *(const u32x4*)op;
                        o[0] += bflo(pw.x); o[1] += bfhi(pw.x); o[2] += bflo(pw.y); o[3] += bfhi(pw.y); o[4] += bflo(pw.z); o[5] += bfhi(pw.z); o[6] += bflo(pw.w); o[7] += bfhi(pw.w); }
                    *(u32x4*)op = (u32x4){cvt_pk(o[0], o[1]), cvt_pk(o[2], o[3]), cvt_pk(o[4], o[5]), cvt_pk(o[6], o[7])}; } }
    }
};
struct Resid {
    static constexpr bool PERM = false, AFTER_DRAIN = false;
    const float* base; float* C; const float* gt;
    DI void operator()(const f32x4 (&acc)[2][2][4][2], const Unit& u, int wr, int wc, int fr, int fq) const {
        const int row0 = u.pm * BM + wr * 64 + fr, col0 = u.pn * BM + wc * 32 + 4 * fq;
        const int b = (u.pm * BM) >> 13;
        f32x4 gv[2][2];
#pragma unroll
        for (int bj = 0; bj < 2; ++bj)
#pragma unroll
            for (int n = 0; n < 2; ++n) gv[bj][n] = *(const f32x4*)(gt + b * 6144 + col0 + bj * HALF + n * 16);
#pragma unroll
        for (int ai = 0; ai < 2; ++ai)
#pragma unroll
            for (int m = 0; m < 4; ++m) { const size_t off = (size_t)(row0 + ai * HALF + m * 16) * DM + col0;
#pragma unroll
                for (int bj = 0; bj < 2; ++bj)
#pragma unroll
                    for (int n = 0; n < 2; ++n) { const f32x4 bs = *(const f32x4*)(base + off + bj * HALF + n * 16);
                        *(f32x4*)(C + off + bj * HALF + n * 16) = bs + gv[bj][n] * acc[ai][bj][m][n]; } }
    }
};
struct SwiGlu {
    static constexpr bool PERM = true, AFTER_DRAIN = false;
    bf16* O;
    DI void operator()(const f32x4 (&acc)[2][2][4][2], const Unit& u, int wr, int wc, int fr, int fq) const {
        const int row0 = u.pm * BM + wr * 64 + fr, col0 = (u.pn & 3) * 128 + wc * 32 + 8 * fq;
#pragma unroll
        for (int ai = 0; ai < 2; ++ai)
#pragma unroll
            for (int m = 0; m < 4; ++m) { const f32x4 g0 = acc[ai][0][m][0], g1 = acc[ai][0][m][1], u0 = acc[ai][1][m][0], u1 = acc[ai][1][m][1];
                u32x4 w; w.x = cvt_pk(siluf_(g0[0]) * u0[0], siluf_(g0[1]) * u0[1]); w.y = cvt_pk(siluf_(g0[2]) * u0[2], siluf_(g0[3]) * u0[3]);
                w.z = cvt_pk(siluf_(g1[0]) * u1[0], siluf_(g1[1]) * u1[1]); w.w = cvt_pk(siluf_(g1[2]) * u1[2], siluf_(g1[3]) * u1[3]);
                *(u32x4*)(O + (size_t)(row0 + ai * HALF + m * 16) * 512 + col0) = w; }
    }
};
struct MoeOut {
    static constexpr bool PERM = true, AFTER_DRAIN = false;
    bf16* O;
    DI void operator()(const f32x4 (&acc)[2][2][4][2], const Unit& u, int wr, int wc, int fr, int fq) const {
        const int row0 = u.pm * BM + wr * 64 + fr, col0 = (u.pn & 3) * BM + wc * 32 + 8 * fq;
#pragma unroll
        for (int ai = 0; ai < 2; ++ai)
#pragma unroll
            for (int m = 0; m < 4; ++m) { bf16* rowp = O + (size_t)(row0 + ai * HALF + m * 16) * DM + col0;
#pragma unroll
                for (int bj = 0; bj < 2; ++bj) { const f32x4 v0 = acc[ai][bj][m][0], v1 = acc[ai][bj][m][1];
                    *(u32x4*)(rowp + bj * HALF) = (u32x4){cvt_pk(v0[0], v0[1]), cvt_pk(v0[2], v0[3]), cvt_pk(v1[0], v1[1]), cvt_pk(v1[2], v1[3])}; } }
    }
};
struct MoeOrder {
    const LAS int* tile_e; int ntiles, G, c;
    DI bool next(int i, Unit& u) const { const int L = i * G + c; if (L >= ntiles * 4) return false; const int pm = L >> 2; u.pm = pm; u.pn = tile_e[pm] * 4 + (L & 3); return true; }
    DI void a_ready(const Unit&) const {}
    DI void done(const Unit&) const {}
};
}

constexpr int L_TILE_E = 131072, L_PADSTART = 131072 + 1024, L_NTILES = 131072 + 1024 + 256;
DI void moe_tables(const Ctx& X, const PArgs& a) {
    LAS int* tile_e = (LAS int*)(X.lds + L_TILE_E); LAS int* pad_start = (LAS int*)(X.lds + L_PADSTART); LAS int* ntl = (LAS int*)(X.lds + L_NTILES);
    if (X.tid == 0) {
        const unsigned* cnt = (const unsigned*)(a.ws + WS_CTL) + CW_ECNT; int tiles = 0;
        for (int e = 0; e < 32; ++e) { const int n = (int)__hip_atomic_load(cnt + e, __ATOMIC_RELAXED, __HIP_MEMORY_SCOPE_AGENT); const int nt = (n + 255) >> 8;
            pad_start[e] = tiles * 256; for (int q = 0; q < nt; ++q) tile_e[tiles + q] = e; tiles += nt; }
        pad_start[32] = tiles * 256; ntl[0] = tiles;
    }
    __syncthreads();
}

DI void phase_expert_weights(const Ctx& X, const PArgs& a) {
    LAS float* scr = (LAS float*)(X.lds + X.wave * 16384);
    const int gw = X.blk * 8 + X.wave, NGW = X.nblk * 8;
    bf16* WGU = (bf16*)(a.ws + WS_EWGU); bf16* WD = (bf16*)(a.ws + WS_EWD);
    for (int it = gw; it < 3 * 8192; it += NGW) {
        const int which = it >> 13, r = it & 8191, e = r >> 8, q = r & 255;
        if (which < 2) { const int kb = q >> 4, nb = q & 15;
            transpose_item(a.in[27 + which] + (size_t)e * 1024 * 512, 512, nb * 32, kb * 64, WGU + ((size_t)e * 1024 + (nb >> 2) * 256 + which * 128 + (nb & 3) * 32) * 1024, 1024, false, scr, X.lane); }
        else { const int kb = q >> 5, nb = q & 31;
            transpose_item(a.in[29] + (size_t)e * 512 * 1024, 1024, nb * 32, kb * 64, WD + ((size_t)e * 1024 + nb * 32) * 512, 512, false, scr, X.lane); }
    }
}

DI void phase_router(const Ctx& X, const PArgs& a, bool dry = false) {
    const float* x1 = a.out;
    const bf16* WRH = (const bf16*)(a.ws + WS_WRH); const bf16* WRL = (const bf16*)(a.ws + WS_WRL); const float* CB = (const float*)(a.ws + WS_CB);
    LAS float* PLG = (LAS float*)X.lds;
    LAS float* PSS = (LAS float*)(X.lds + 24576);
    LAS int* EL = (LAS int*)(X.lds + 25088);
    LAS int* PL = (LAS int*)(X.lds + 25600);
    unsigned* cnt = (unsigned*)(a.ws + WS_CTL) + CW_ECNT;
    const int w = X.wave, r = X.lane & 15, g = X.lane >> 4, tg = w & 3, kh = w >> 2;
    for (int tb = X.blk; tb < 256; tb += X.nblk) {
        const int m = tb * 64 + 16 * tg + r, b = (tb * 64) >> 13;
        const float* xp = x1 + (size_t)m * DM + 512 * kh + 8 * g;
        const bf16* wh = WRH + ((size_t)b * 48 + r) * 1024 + 512 * kh + 8 * g; const bf16* wl = WRL + ((size_t)b * 48 + r) * 1024 + 512 * kh + 8 * g;
        f32x4 acc[3]; float ssq = 0.f;
#pragma unroll
        for (int ot = 0; ot < 3; ++ot) acc[ot] = (f32x4){0.f, 0.f, 0.f, 0.f};
#pragma unroll 4
        for (int ks = 0; ks < 16; ++ks) {
            const f32x4 xa = *(const f32x4*)(xp + 32 * ks), xb = *(const f32x4*)(xp + 32 * ks + 4);
            ssq += (xa[0] * xa[0] + xa[1] * xa[1]) + (xa[2] * xa[2] + xa[3] * xa[3]) + (xb[0] * xb[0] + xb[1] * xb[1]) + (xb[2] * xb[2] + xb[3] * xb[3]);
            const unsigned h0 = cvt_pk(xa[0], xa[1]), h1 = cvt_pk(xa[2], xa[3]), h2 = cvt_pk(xb[0], xb[1]), h3 = cvt_pk(xb[2], xb[3]);
            const unsigned l0 = cvt_pk(xa[0] - bflo(h0), xa[1] - bfhi(h0)), l1 = cvt_pk(xa[2] - bflo(h1), xa[3] - bfhi(h1)), l2 = cvt_pk(xb[0] - bflo(h2), xb[1] - bfhi(h2)), l3 = cvt_pk(xb[2] - bflo(h3), xb[3] - bfhi(h3));
            const bf16x8 ahi = __builtin_bit_cast(bf16x8, (u32x4){h0, h1, h2, h3}), alo = __builtin_bit_cast(bf16x8, (u32x4){l0, l1, l2, l3});
#pragma unroll
            for (int ot = 0; ot < 3; ++ot) {
                const bf16x8 bh = *(const bf16x8*)(wh + (size_t)ot * 16 * 1024 + 32 * ks), bl = *(const bf16x8*)(wl + (size_t)ot * 16 * 1024 + 32 * ks);
                acc[ot] = mfma16(bh, ahi, acc[ot]); acc[ot] = mfma16(bl, ahi, acc[ot]); acc[ot] = mfma16(bh, alo, acc[ot]); }
        }
        ssq += __shfl_xor(ssq, 16); ssq += __shfl_xor(ssq, 32);
        const int tl = 16 * tg + r;
#pragma unroll
        for (int ot = 0; ot < 3; ++ot) *(LAS f32x4*)(PLG + (kh * 64 + tl) * 48 + 16 * ot + 4 * g) = acc[ot];
        if (g == 0) PSS[kh * 64 + tl] = ssq;
        __syncthreads();
        if (X.tid < 64) {
            const int t = X.tid, mm = tb * 64 + t;
            const float rs = 1.0f / sqrtf((PSS[t] + PSS[64 + t]) * (1.f / DM) + 1e-6f);
            ((float*)(a.ws + WS_RSV))[mm] = rs;
            const LAS float* p0 = PLG + t * 48; const LAS float* p1 = PLG + (64 + t) * 48; const float* cb = CB + b * 48;
            float lg[4];
#pragma unroll
            for (int o = 0; o < 4; ++o) lg[o] = rs * (p0[o] + p1[o]) + cb[o];
            int gi = 0; float gm = lg[0];
#pragma unroll
            for (int o = 1; o < 4; ++o) if (lg[o] > gm) { gm = lg[o]; gi = o; }
            float gs = 0.f;
#pragma unroll
            for (int o = 0; o < 4; ++o) gs += __expf(lg[o] - gm);
            const float pgrp = 1.0f / gs;
            float sel[8];
#pragma unroll
            for (int o = 0; o < 8; ++o) sel[o] = rs * (p0[4 + gi * 8 + o] + p1[4 + gi * 8 + o]) + cb[4 + gi * 8 + o];
            int i0 = 0; float m0 = sel[0];
#pragma unroll
            for (int o = 1; o < 8; ++o) if (sel[o] > m0) { m0 = sel[o]; i0 = o; }
            int i1 = -1; float m1 = -3.0e38f;
#pragma unroll
            for (int o = 0; o < 8; ++o) if (o != i0 && sel[o] > m1) { m1 = sel[o]; i1 = o; }
            const float e1 = __expf(m1 - m0), den = 1.0f + e1;
            EL[t * 2] = gi * 8 + i0; EL[t * 2 + 1] = gi * 8 + i1;
            float* wt = (float*)(a.ws + WS_WTS) + (size_t)mm * 2; wt[0] = pgrp / den; wt[1] = pgrp * e1 / den;
        }
        __syncthreads();
        if (!dry && X.tid < 32) { int n = 0;
            for (int q = 0; q < 128; ++q) n += (EL[q] == X.tid) ? 1 : 0;
            int base = 0; if (n) base = (int)__hip_atomic_fetch_add(cnt + X.tid, (unsigned)n, __ATOMIC_RELAXED, __HIP_MEMORY_SCOPE_AGENT);
            for (int q = 0; q < 128; ++q) if (EL[q] == X.tid) PL[q] = base++; }
        __syncthreads();
        if (!dry && X.tid < 128) { ((int*)(a.ws + WS_EID))[(size_t)tb * 128 + X.tid] = EL[X.tid]; ((int*)(a.ws + WS_POS))[(size_t)tb * 128 + X.tid] = PL[X.tid]; }
        __syncthreads();
    }
}

DI void phase_gather(const Ctx& X, const PArgs& a) {
    moe_tables(X, a);
    const LAS int* pad_start = (const LAS int*)(X.lds + L_PADSTART);
    const int* EID = (const int*)(a.ws + WS_EID); const int* POS = (const int*)(a.ws + WS_POS); int* SLOT = (int*)(a.ws + WS_SLOT);
    const float* x1 = a.out; const float* RSV = (const float*)(a.ws + WS_RSV); const float* g2 = a.in[22]; const float* mod = (const float*)(a.ws + WS_MOD);
    bf16* xg = (bf16*)(a.ws + WS_XG);
    const int gw = X.blk * 8 + X.wave, NGW = X.nblk * 8;
    for (int m = gw; m < NTOK; m += NGW) {
        const int b = m >> 13; const float rs = RSV[m];
        const int d0 = pad_start[EID[2 * m]] + POS[2 * m], d1 = pad_start[EID[2 * m + 1]] + POS[2 * m + 1];
        if (X.lane == 0) { SLOT[2 * m] = d0; SLOT[2 * m + 1] = d1; }
        const f32x4* xr = (const f32x4*)(x1 + (size_t)m * DM) + X.lane;
        u32x2* o0 = (u32x2*)(xg + (size_t)d0 * DM) + X.lane; u32x2* o1 = (u32x2*)(xg + (size_t)d1 * DM) + X.lane;
#pragma unroll
        for (int j = 0; j < 4; ++j) { const int col = 4 * X.lane + 256 * j;
            const f32x4 g = *(const f32x4*)(g2 + col), sh = *(const f32x4*)(mod + b * 6144 + 3072 + col), sc = *(const f32x4*)(mod + b * 6144 + 4096 + col);
            const f32x4 y = xr[64 * j] * rs * g * (1.0f + sc) + sh;
            const u32x2 wv = (u32x2){cvt_pk(y.x, y.y), cvt_pk(y.z, y.w)}; o0[64 * j] = wv; o1[64 * j] = wv; }
    }
}

DI void phase_final(const Ctx& X, const PArgs& a, bool with_moe, bool dry = false) {
    float* out = a.out; float* dst = dry ? (float*)(a.ws + WS_HID) : a.out; const float* fg = a.in[30]; const float* mod = (const float*)(a.ws + WS_MOD);
    const int* SLOT = (const int*)(a.ws + WS_SLOT); const float* WTS = (const float*)(a.ws + WS_WTS); const bf16* Y = (const bf16*)(a.ws + WS_XG);
    const int gw = X.blk * 8 + X.wave, NGW = X.nblk * 8;
    for (int m = gw; m < NTOK; m += NGW) {
        const int b = m >> 13;
        f32x4* xr = (f32x4*)(out + (size_t)m * DM) + X.lane;
        f32x4 v[4]; float s = 0.f;
        int s0 = 0, s1 = 0; float w0 = 0.f, w1 = 0.f;
        if (with_moe) { s0 = SLOT[m * 2]; s1 = SLOT[m * 2 + 1]; w0 = WTS[m * 2]; w1 = WTS[m * 2 + 1]; }
#pragma unroll
        for (int j = 0; j < 4; ++j) { const int col = 4 * X.lane + 256 * j; v[j] = xr[64 * j];
            if (with_moe) {
                const u32x2 y0 = *(const u32x2*)(Y + (size_t)s0 * DM + col), y1 = *(const u32x2*)(Y + (size_t)s1 * DM + col);
                const f32x4 gt = *(const f32x4*)(mod + b * 6144 + 5120 + col);
                const f32x4 mo = w0 * (f32x4){bflo(y0.x), bfhi(y0.x), bflo(y0.y), bfhi(y0.y)} + w1 * (f32x4){bflo(y1.x), bfhi(y1.x), bflo(y1.y), bfhi(y1.y)};
                v[j] = v[j] + gt * mo; }
            s += (v[j].x * v[j].x + v[j].y * v[j].y) + (v[j].z * v[j].z + v[j].w * v[j].w); }
        float rs = 1.0f / sqrtf(wave_sum(s) * (1.f / DM) + 1e-6f);
#if defined(MK_TPROBE)
        { const float* T_ = (const float*)(a.ws + WS_CTL) + 32768; float tot_ = 0.f; for (int q = 0; q < 8; ++q) tot_ += T_[q]; rs *= (1.0f + 0.1f * T_[MK_TPROBE] / tot_); }
#endif
#pragma unroll
        for (int j = 0; j < 4; ++j) { const f32x4 g = *(const f32x4*)(fg + 4 * X.lane + 256 * j); ((f32x4*)(dst + (size_t)(dry ? (m & 4095) : m) * DM) + X.lane)[64 * j] = v[j] * rs * g; }
    }
}

#ifndef MK_DUP
#define MK_DUP 0
#endif
constexpr int NPH = 13;
template <class T> DI T* fresh_ptr(T* p) { asm volatile("" : "+s"(p)); return p; }
#define PH_ARGS const PArgs al{a.in, fresh_ptr(a.out), fresh_ptr(a.ws)}; unsigned char* ws = al.ws; (void)ws
__global__ void __launch_bounds__(512, 2) mk_fwd(Args a) {
    extern __shared__ __attribute__((aligned(16))) unsigned char lds_raw[];
    Ctx X; X.lds = (LAS unsigned char*)lds_raw; X.tid = threadIdx.x; X.lane = X.tid & 63; X.wave = __builtin_amdgcn_readfirstlane(X.tid >> 6); X.nblk = gridDim.x; X.blk = blockIdx.x;
    if (X.tid < 8) ((LAS unsigned*)(X.lds + LDS_MISC))[X.tid] = 0u;
    __syncthreads();
    XcdBarrier bar = xcd_barrier_post((unsigned*)(a.ws + WS_CTL) + CW_BAR, (volatile LAS unsigned*)(X.lds + LDS_MISC));
    const int lo = a.ph_lo, hi = a.ph_hi;
#ifndef MK_PHASE_MASK
#define MK_PHASE_MASK 0xffff
#endif
#define IN(k) (((MK_PHASE_MASK >> (k)) & 1) && lo <= (k) && (k) < hi)
#define SEAM(k) do { if (IN(k) && IN((k) + 1)) xcd_barrier(bar); } while (0)
    if (IN(0)) { PH_ARGS; phase_prologue(X, al); } SEAM(0);
    if (IN(1)) { PH_ARGS; phase_norm1(X, al); } SEAM(1);
    if (IN(2)) { PH_ARGS;
        pg8::Gemm g{(bf16*)al.out, (const bf16*)(ws + WS_WIN), NTOK, NWIN, 1024, 1024}; pg8::StaticOrder S; S.init(NTOK, NWIN, X.nblk, X.blk);
        epi::InProj E{(bf16*)(ws + WS_PROJ), (bf16*)al.out + (size_t)16 * 1024 * 1024, (bf16*)(ws + WS_GATEB)};
        pg8::gemm_phase<epi::InProj, pg8::StaticOrder>(X.lds, g, S, E, nullptr);
    } SEAM(2);
    if (IN(3)) { PH_ARGS;
        for (int rep = 0; rep < 1 + (MK_DUP & 1); ++rep) for (int u = X.blk; u < 1024; u += X.nblk) hg1_unit(X, al, u);
        for (int rep = 0; rep < 1 + ((MK_DUP >> 1) & 1); ++rep) for (int u = X.blk; u < 2048; u += X.nblk) rw1_unit(X, al, u);
    } SEAM(3);
    if (IN(4)) { PH_ARGS;
        hg2_scan(X, al);
        for (int rep = 0; rep < 1 + ((MK_DUP >> 2) & 1); ++rep) if (X.wave == 0) for (int ch = 0; ch < 64; ++ch) if ((128 + ch) % X.nblk == X.blk) rw2_chain(X, al, ch);
    } SEAM(4);
    if (IN(5)) { PH_ARGS;
        if ((MK_DUP >> 15) & 1) for (int u = X.blk; u < 1024; u += X.nblk) hg3_unit(X, al, u, true);
        for (int u = X.blk; u < 1024; u += X.nblk) hg3_unit(X, al, u);
        for (int rep = 0; rep < 1 + ((MK_DUP >> 3) & 1); ++rep) for (int u = X.blk; u < 2048; u += X.nblk) rw3_unit(X, al, u);
    } SEAM(5);
    if (IN(6)) { PH_ARGS;
        pg8::StaticOrder S; S.init(NTOK, 1024, X.nblk, X.blk);
        { pg8::Gemm g{(const bf16*)(ws + WS_PROJ) + C_HQ, (const bf16*)(ws + WS_WPA), NTOK, 1024, 512, LDP};
          epi::GateMix<false> E{(bf16*)(ws + WS_MIXED), 1024, (bf16*)al.out + (size_t)16 * 1024 * 1024, 1024};
          pg8::gemm_phase<epi::GateMix<false>, pg8::StaticOrder>(X.lds, g, S, E, nullptr); }
        __syncthreads();
        { pg8::Gemm g{(const bf16*)(ws + WS_PROJ) + C_RR, (const bf16*)(ws + WS_WPB), NTOK, 1024, 512, LDP};
          epi::GateMix<true> E{(bf16*)(ws + WS_MIXED), 1024, (bf16*)(ws + WS_GATEB), 1024};
          pg8::gemm_phase<epi::GateMix<true>, pg8::StaticOrder>(X.lds, g, S, E, nullptr); }
    } SEAM(6);
    if (IN(7)) { PH_ARGS;
        pg8::Gemm g{(const bf16*)(ws + WS_MIXED), (const bf16*)(ws + WS_WOUT), NTOK, 1024, 1024, 1024}; pg8::StaticOrder S; S.init(NTOK, 1024, X.nblk, X.blk);
        epi::Resid E{al.in[0], al.out, (const float*)(ws + WS_MOD) + 2048};
        pg8::gemm_phase<epi::Resid, pg8::StaticOrder>(X.lds, g, S, E, nullptr);
        __syncthreads();
        phase_expert_weights(X, al);
    } SEAM(7);
    if (IN(8)) { PH_ARGS; if ((MK_DUP >> 16) & 1) { phase_router(X, al, true); __syncthreads(); } phase_router(X, al); } SEAM(8);
    if ((MK_DUP >> 20) & 1) {
#pragma unroll 1
        for (int q = 0; q < 10; ++q) xcd_barrier(bar); }
    if (IN(9)) { PH_ARGS; phase_gather(X, al); } SEAM(9);
    if (IN(10)) { PH_ARGS;
        moe_tables(X, al);
        const int ntiles = ((const LAS int*)(X.lds + L_NTILES))[0];
        pg8::Gemm g{(const bf16*)(ws + WS_XG), (const bf16*)(ws + WS_EWGU), ntiles * 256, 32 * 1024, 1024, 1024};
        epi::MoeOrder S{(const LAS int*)(X.lds + L_TILE_E), ntiles, X.nblk, X.blk};
        epi::SwiGlu E{(bf16*)(ws + WS_HID)};
        pg8::gemm_phase<epi::SwiGlu, epi::MoeOrder>(X.lds, g, S, E, nullptr);
    } SEAM(10);
    if (IN(11)) { PH_ARGS;
        moe_tables(X, al);
        const int ntiles = ((const LAS int*)(X.lds + L_NTILES))[0];
        pg8::Gemm g{(const bf16*)(ws + WS_HID), (const bf16*)(ws + WS_EWD), ntiles * 256, 32 * 1024, 512, 512};
        epi::MoeOrder S{(const LAS int*)(X.lds + L_TILE_E), ntiles, X.nblk, X.blk};
        epi::MoeOut E{(bf16*)(ws + WS_XG)};
        pg8::gemm_phase<epi::MoeOut, epi::MoeOrder>(X.lds, g, S, E, nullptr);
    } SEAM(11);
    if (IN(12)) { PH_ARGS; phase_final(X, al, true); }
#undef IN
#undef SEAM
}

extern "C" void kernel_launch(void* const* d_in, const int* in_sizes, int n_in, void* d_out, int out_size, void* d_ws, size_t ws_size, hipStream_t stream) {
    static int grid = 0;
    if (grid == 0) {
        int dev = 0, cus = 0;
        if (n_in != 31 || out_size != NTOK * DM || ws_size < WS_END) { fprintf(stderr, "kernel_launch: unexpected shapes (n_in %d out %d ws %zu)\n", n_in, out_size, ws_size); grid = -1; return; }
        if (hipGetDevice(&dev) != hipSuccess || hipDeviceGetAttribute(&cus, hipDeviceAttributeMultiprocessorCount, dev) != hipSuccess) { grid = -1; return; }
        if (hipFuncSetAttribute((const void*)mk_fwd, hipFuncAttributeMaxDynamicSharedMemorySize, LDS_BYTES) != hipSuccess) { fprintf(stderr, "kernel_launch: hipFuncSetAttribute failed\n"); grid = -1; return; }
        int per_cu = 0;
        if (hipOccupancyMaxActiveBlocksPerMultiprocessor(&per_cu, (const void*)mk_fwd, 512, LDS_BYTES) != hipSuccess || per_cu < 1) fprintf(stderr, "kernel_launch: occupancy query reports %d\n", per_cu);
        (void)hipGetLastError();
        grid = cus;
    }
    if (grid < 0) return;
    (void)hipMemsetAsync((char*)d_ws + WS_CTL, 0, CTL_ZERO_BYTES, stream);
    Args a{};
    for (int i = 0; i < 31; ++i) a.in[i] = (const float*)d_in[i];
    a.out = (float*)d_out; a.ws = (unsigned char*)d_ws;
#if MK_ONE_LAUNCH
    a.ph_lo = 0; a.ph_hi = NPH;
    hipLaunchKernelGGL(mk_fwd, dim3(grid), dim3(512), LDS_BYTES, stream, a);
#else
    for (int ph = 0; ph < NPH; ++ph) {
        a.ph_lo = ph; a.ph_hi = ph + 1;
        hipLaunchKernelGGL(mk_fwd, dim3(grid), dim3(512), LDS_BYTES, stream, a);
    }
#endif
}
```

```cpp
#define MK_ONE_LAUNCH 1
#include <hip/hip_runtime.h>
#include <stdint.h>
#include <stdio.h>

#ifndef MK_ONE_LAUNCH
#define MK_ONE_LAUNCH 0
#endif
#ifndef MK_LAST_PHASE
#define MK_LAST_PHASE 99
#endif

#define DI __device__ __forceinline__
#define LAS __attribute__((address_space(3)))
typedef unsigned short bf16;
typedef short bf16x8 __attribute__((ext_vector_type(8)));
typedef float f32x4 __attribute__((ext_vector_type(4)));
typedef float f32x2 __attribute__((ext_vector_type(2)));
typedef unsigned u32x4 __attribute__((ext_vector_type(4)));
typedef unsigned u32x2 __attribute__((ext_vector_type(2)));

constexpr int NTOK = 16384, DM = 1024, SEQ = 8192;
constexpr int LDP = 3840;
constexpr int NWIN = 5888;
constexpr int C_HQ = 0, C_HF = 512, C_HI = 1024, C_HG = 1536, C_RR = 2048, C_RK = 2560, C_RV = 3072, C_WD = 3584, C_AD = 3616, C_GD = 3648;
DI size_t pj_off(int row, int sec_start, int width, int c) { return (size_t)sec_start * NTOK + (size_t)row * width + c; }
constexpr int MOE_PMAX = 40960;

constexpr size_t MiB = 1u << 20;
constexpr size_t WS_CTL = 0, CTL_ZERO_BYTES = 1 * MiB;
constexpr size_t WS_MOD = 1 * MiB;
constexpr size_t WS_SLOT = 1 * MiB + 64 * 1024;
constexpr size_t WS_WTS = WS_SLOT + 128 * 1024;
constexpr size_t WS_EID = WS_WTS + 128 * 1024;
constexpr size_t WS_POS = WS_EID + 128 * 1024;
constexpr size_t WS_RSV = WS_POS + 128 * 1024;
constexpr size_t WS_BONUS = 2 * MiB;
constexpr size_t WS_HGC = 2 * MiB + 512 * 1024;
constexpr size_t WS_RGC = 3 * MiB;
constexpr size_t WS_WRH = 3 * MiB + 512 * 1024;
constexpr size_t WS_WRL = WS_WRH + 196608;
constexpr size_t WS_CB = WS_WRL + 196608;
constexpr size_t WS_G2T = WS_CB + 1024;
constexpr size_t WS_WIN = 4 * MiB;
constexpr size_t WS_WPA = 16 * MiB, WS_WPB = 17 * MiB, WS_WOUT = 18 * MiB;
constexpr size_t WS_PROJ = 20 * MiB;
constexpr size_t WS_HS = 140 * MiB;
constexpr size_t WS_RM = 172 * MiB;
constexpr size_t WS_RS = 236 * MiB;
constexpr size_t WS_MIXED = 204 * MiB;
constexpr size_t WS_EWGU = 20 * MiB;
constexpr size_t WS_EWD = 84 * MiB;
constexpr size_t WS_XG = 116 * MiB;
constexpr size_t WS_HID = 196 * MiB;
constexpr size_t WS_GATEB = 252 * MiB;
constexpr size_t WS_END = 284 * MiB;
constexpr int CW_BAR = 4096, CW_ECNT = 16384;

constexpr int LDS_BYTES = 163840;
constexpr int LDS_MISC = 163840 - 256;

typedef __bf16 bf16x2_t __attribute__((ext_vector_type(2)));
DI unsigned cvt_pk(float lo, float hi) { bf16x2_t v = {(__bf16)lo, (__bf16)hi}; return __builtin_bit_cast(unsigned, v); }
DI bf16 f2bf(float x) { return (bf16)(cvt_pk(x, 0.f) & 0xffffu); }
DI float bf2f(bf16 b) { return __uint_as_float(((unsigned)b) << 16); }
DI float bflo(unsigned w) { return __uint_as_float(w << 16); }
DI float bfhi(unsigned w) { return __uint_as_float(w & 0xffff0000u); }
DI float frcp(float x) { return __builtin_amdgcn_rcpf(x); }
DI float frsq(float x) { return __builtin_amdgcn_rsqf(x); }
DI float sigmoidf_(float x) { return frcp(1.0f + __expf(-x)); }
DI float siluf_(float x) { return x * frcp(1.0f + __expf(-x)); }
DI float wave_sum(float v) {
#pragma unroll
    for (int o = 1; o < 64; o <<= 1) v += __shfl_xor(v, o);
    return v;
}
DI f32x4 mfma16(bf16x8 a, bf16x8 b, f32x4 c) { return __builtin_amdgcn_mfma_f32_16x16x32_bf16(a, b, c, 0, 0, 0); }
#define LDS_WAIT() asm volatile("s_waitcnt lgkmcnt(0)" ::: "memory")
#define VM_WAIT() asm volatile("s_waitcnt vmcnt(0)" ::: "memory")

template <int TP, int TQ, int KS>
DI void mm_ll(const LAS bf16* P, int ldp, const LAS bf16* Q, int ldq, f32x4 (&acc)[TP][TQ], int lane) {
    const int r = lane & 15, g = lane >> 4;
#pragma unroll
    for (int ks = 0; ks < KS; ++ks) {
        bf16x8 pf[TP], qf[TQ];
#pragma unroll
        for (int tp = 0; tp < TP; ++tp) pf[tp] = *(const LAS bf16x8*)(P + (tp * 16 + r) * ldp + ks * 32 + g * 8);
#pragma unroll
        for (int tq = 0; tq < TQ; ++tq) qf[tq] = *(const LAS bf16x8*)(Q + (tq * 16 + r) * ldq + ks * 32 + g * 8);
#pragma unroll
        for (int tp = 0; tp < TP; ++tp)
#pragma unroll
            for (int tq = 0; tq < TQ; ++tq) acc[tp][tq] = mfma16(pf[tp], qf[tq], acc[tp][tq]);
    }
}
template <int TP, int TQ, int KS>
DI void mm_gl(const bf16* P, int ldp, const LAS bf16* Q, int ldq, f32x4 (&acc)[TP][TQ], int lane) {
    const int r = lane & 15, g = lane >> 4;
#pragma unroll
    for (int ks = 0; ks < KS; ++ks) {
        bf16x8 pf[TP], qf[TQ];
#pragma unroll
        for (int tp = 0; tp < TP; ++tp) pf[tp] = *(const bf16x8*)(P + (size_t)(tp * 16 + r) * ldp + ks * 32 + g * 8);
#pragma unroll
        for (int tq = 0; tq < TQ; ++tq) qf[tq] = *(const LAS bf16x8*)(Q + (tq * 16 + r) * ldq + ks * 32 + g * 8);
#pragma unroll
        for (int tp = 0; tp < TP; ++tp)
#pragma unroll
            for (int tq = 0; tq < TQ; ++tq) acc[tp][tq] = mfma16(pf[tp], qf[tq], acc[tp][tq]);
    }
}
template <int TP, int TQ, int KS>
DI void mm_gg(const bf16* P, int ldp, const bf16* Q, int ldq, f32x4 (&acc)[TP][TQ], int lane) {
    const int r = lane & 15, g = lane >> 4;
#pragma unroll
    for (int ks = 0; ks < KS; ++ks) {
        bf16x8 pf[TP], qf[TQ];
#pragma unroll
        for (int tp = 0; tp < TP; ++tp) pf[tp] = *(const bf16x8*)(P + (size_t)(tp * 16 + r) * ldp + ks * 32 + g * 8);
#pragma unroll
        for (int tq = 0; tq < TQ; ++tq) qf[tq] = *(const bf16x8*)(Q + (size_t)(tq * 16 + r) * ldq + ks * 32 + g * 8);
#pragma unroll
        for (int tp = 0; tp < TP; ++tp)
#pragma unroll
            for (int tq = 0; tq < TQ; ++tq) acc[tp][tq] = mfma16(pf[tp], qf[tq], acc[tp][tq]);
    }
}
template <int A, int B> DI void zero_acc(f32x4 (&acc)[A][B]) {
#pragma unroll
    for (int a = 0; a < A; ++a)
#pragma unroll
        for (int b = 0; b < B; ++b) acc[a][b] = (f32x4){0.f, 0.f, 0.f, 0.f};
}
namespace pg8 {
#define PG8_LAS __attribute__((address_space(3)))
typedef unsigned short bf16_t;
typedef short bf16x8 __attribute__((ext_vector_type(8)));
typedef float f32x4 __attribute__((ext_vector_type(4)));
typedef unsigned u32x4 __attribute__((ext_vector_type(4)));
constexpr int BM = 256, BK = 64, HALF = 128, HTB = HALF * BK * 2  , STAGE_BYTES = 8 * HTB, NXCD = 8, WGM = 8;

__host__ __device__ __forceinline__ int lds_byte(int r, int c) { const int st = (r >> 4) * 2 + (c >> 5), rr = r & 15, cc = c & 31, ob = rr * 64 + cc * 2; return st * 1024 + (ob ^ (((ob >> 9) & 1) << 5)); }
__host__ __device__ __forceinline__ void stage_rc(int b, int& R, int& C) { const int st = b / 1024, sb = b % 1024, swz = sb ^ (((sb >> 9) & 1) << 5); R = (st >> 1) * 16 + swz / 64; C = (st & 1) * 32 + (swz % 64) / 2; }
__host__ __device__ __forceinline__ int perm32(int rho) { const int n = rho >> 4, i = rho & 15; return 8 * (i >> 2) + 4 * n + (i & 3); }

struct Unit { int pm, pn; };
struct Gemm { const bf16_t* A; const bf16_t* Bt; int M, N, K, lda; };

struct StaticOrder {
    int nM, nN, nwg, G, c;
    __host__ __device__ void init(int M, int N, int G_, int c_) { nM = M / BM; nN = N / BM; nwg = nM * nN; G = G_; c = c_; }
    __host__ __device__ bool next(int i, Unit& u) const {
        const long L = (long)i * G + c; if (L >= nwg) return false;
        int wgid = (int)L; { const int q = nwg / NXCD, r = nwg % NXCD, xcd = wgid % NXCD, off = wgid / NXCD; wgid = (xcd < r ? xcd * (q + 1) : r * (q + 1) + (xcd - r) * q) + off; }
        const int nig = WGM * nN, gid = wgid / nig, fm = gid * WGM, gsz = (nM - fm) < WGM ? (nM - fm) : WGM;
        u.pm = fm + ((wgid % nig) % gsz); u.pn = (wgid % nig) / gsz; return true;
    }
    __device__ __forceinline__ void a_ready(const Unit&) const {}
    __device__ __forceinline__ void done(const Unit&) const {}
};
struct CountedOrder : StaticOrder {
    const unsigned* ready; unsigned need; unsigned* tmo;
    __device__ __forceinline__ void a_ready(const Unit& u) const {
        if (threadIdx.x < 64) {
            const unsigned long long t0 = __builtin_amdgcn_s_memrealtime(); unsigned polls = 0;
            while ((unsigned)__builtin_amdgcn_readfirstlane(__hip_atomic_load(ready + 64 * u.pm, __ATOMIC_RELAXED, __HIP_MEMORY_SCOPE_AGENT)) < need) {
                if ((++polls & 255u) == 0u && __builtin_amdgcn_readfirstlane(__hip_atomic_load(tmo, __ATOMIC_RELAXED, __HIP_MEMORY_SCOPE_AGENT)) != 0u) break;
                if (__builtin_amdgcn_s_memrealtime() - t0 > 2000000ull) {
                    if (threadIdx.x == 0) { unsigned expect = 0u; __hip_atomic_compare_exchange_strong(tmo + 1, &expect, 0x600u | (unsigned)(u.pm & 0xff), __ATOMIC_RELAXED, __ATOMIC_RELAXED, __HIP_MEMORY_SCOPE_AGENT); __hip_atomic_store(tmo, 1u, __ATOMIC_RELAXED, __HIP_MEMORY_SCOPE_AGENT); }
                    break; }
                __builtin_amdgcn_s_sleep(2); }
            __builtin_amdgcn_fence(__ATOMIC_ACQUIRE, "agent");
            asm volatile("s_waitcnt vmcnt(0)" ::: "memory");
        }
#if !defined(BROKEN_HOOK_NO_BARRIER)
        asm volatile("" ::: "memory"); __builtin_amdgcn_s_barrier(); asm volatile("" ::: "memory");
#endif
    }
};

__device__ __forceinline__ unsigned cvt_pk_bf16(float lo, float hi) { return ::cvt_pk(lo, hi); }
typedef float f32x2 __attribute__((ext_vector_type(2)));
__device__ __forceinline__ f32x2 gelu_pk(f32x2 v) {
    const f32x2 av = __builtin_elementwise_abs(v), d = av * 0.2316418882f + 1.0f;
    f32x2 t; t.x = __builtin_amdgcn_rcpf(d.x); t.y = __builtin_amdgcn_rcpf(d.y);
    f32x2 q = t * 0.5307027145f + (-0.7265760135f); q = q * t + 0.7107068705f; q = q * t + (-0.142248368f); q = q * t + 0.127414796f; q = q * t;
    const f32x2 s = (v * v) * (-0.72134752044f);
    f32x2 e; e.x = __builtin_amdgcn_exp2f(s.x); e.y = __builtin_amdgcn_exp2f(s.y);
    const f32x2 m = v * (q * e), r = v - m;
    f32x2 o; o.x = v.x < 0.f ? m.x : r.x; o.y = v.y < 0.f ? m.y : r.y; return o;
}

struct EpiF32 {
    static constexpr bool PERM = false, AFTER_DRAIN = false;
    float* C; int ldc; const float* bias;
    __device__ __forceinline__ void operator()(const f32x4 (&acc)[2][2][4][2], const Unit& u, int wr, int wc, int fr, int fq) const {
        const int row0 = u.pm * BM + wr * 64 + fr, col0 = u.pn * BM + wc * 32 + 4 * fq;
        f32x4 bv[2][2];
#pragma unroll
        for (int bj = 0; bj < 2; ++bj)
#pragma unroll
            for (int n = 0; n < 2; ++n) bv[bj][n] = bias ? *(const f32x4*)(bias + col0 + bj * HALF + n * 16) : (f32x4){0.f, 0.f, 0.f, 0.f};
#pragma unroll
        for (int ai = 0; ai < 2; ++ai)
#pragma unroll
            for (int m = 0; m < 4; ++m) { float* rowp = C + (size_t)(row0 + ai * HALF + m * 16) * ldc + col0;
#pragma unroll
                for (int bj = 0; bj < 2; ++bj)
#pragma unroll
                    for (int n = 0; n < 2; ++n) *(f32x4*)(rowp + bj * HALF + n * 16) = acc[ai][bj][m][n] + bv[bj][n]; }
    }
};
template <int ACT  > struct EpiBf16 {
    static constexpr bool PERM = true, AFTER_DRAIN = false;
    bf16_t* O; int ldc; const float* bias; int split_cols; size_t split_stride;
    __device__ __forceinline__ void operator()(const f32x4 (&acc)[2][2][4][2], const Unit& u, int wr, int wc, int fr, int fq) const {
        const int row0 = u.pm * BM + wr * 64 + fr; int colt = u.pn * BM; bf16_t* base = O;
        if (split_cols) { const int t = colt / split_cols; base += (size_t)t * split_stride; colt -= t * split_cols; }
        const int col0 = colt + wc * 32 + 8 * fq, bcol0 = u.pn * BM + wc * 32 + 8 * fq;
        f32x4 bv[2][2];
#pragma unroll
        for (int bj = 0; bj < 2; ++bj)
#pragma unroll
            for (int n = 0; n < 2; ++n) bv[bj][n] = bias ? *(const f32x4*)(bias + bcol0 + bj * HALF + 4 * n) : (f32x4){0.f, 0.f, 0.f, 0.f};
#pragma unroll
        for (int ai = 0; ai < 2; ++ai)
#pragma unroll
            for (int m = 0; m < 4; ++m) { bf16_t* rowp = base + (size_t)(row0 + ai * HALF + m * 16) * ldc + col0;
#pragma unroll
                for (int bj = 0; bj < 2; ++bj) { f32x4 v0 = acc[ai][bj][m][0] + bv[bj][0], v1 = acc[ai][bj][m][1] + bv[bj][1];
                    if (ACT == 1) { f32x2 a = gelu_pk((f32x2){v0[0], v0[1]}), b = gelu_pk((f32x2){v0[2], v0[3]}), c = gelu_pk((f32x2){v1[0], v1[1]}), d = gelu_pk((f32x2){v1[2], v1[3]});
                        v0 = (f32x4){a.x, a.y, b.x, b.y}; v1 = (f32x4){c.x, c.y, d.x, d.y}; }
                    if (ACT == 2) {
#pragma unroll
                        for (int j = 0; j < 4; ++j) { v0[j] = 0.5f * v0[j] * (1.0f + erff(v0[j] * 0.70710678f)); v1[j] = 0.5f * v1[j] * (1.0f + erff(v1[j] * 0.70710678f)); } }
                    u32x4 w; w.x = cvt_pk_bf16(v0[0], v0[1]); w.y = cvt_pk_bf16(v0[2], v0[3]); w.z = cvt_pk_bf16(v1[0], v1[1]); w.w = cvt_pk_bf16(v1[2], v1[3]);
                    *(u32x4*)(rowp + bj * HALF) = w; } }
    }
};
template <class Epi, class Sched, bool STAMP = false>
__device__ __forceinline__ void gemm_phase(PG8_LAS unsigned char* lds, const Gemm g, const Sched& S, const Epi& E, unsigned long long* stamps) {
    const int tid = threadIdx.x, wid = __builtin_amdgcn_readfirstlane(tid >> 6), lane = tid & 63, wr = wid >> 2, wc = wid & 3, fr = lane & 15, fq = lane >> 4;
    const int K = g.K, nt = K / BK;
    int ts_lo = 0, ts_hi = 0, nts = 0; const unsigned long long rt_entry = STAMP ? (unsigned long long)wall_clock64() : 0ull;
#define PG8_STAMP() do { if (STAMP && wid == 0 && nts < 64) { const unsigned long long _c = (unsigned long long)clock64(); \
        ts_lo = (lane == nts) ? (int)(unsigned)_c : ts_lo; ts_hi = (lane == nts) ? (int)(unsigned)(_c >> 32) : ts_hi; ++nts; } } while (0)
    PG8_STAMP();
    unsigned voffA[2], voffB[2];
#pragma unroll
    for (int i = 0; i < 2; ++i) { int R, C; stage_rc(tid * 16 + i * 8192, R, C); const int Rb = Epi::PERM ? ((R & ~31) + perm32(R & 31)) : R;
        voffA[i] = (unsigned)(R * g.lda + C) * 2u; voffB[i] = (unsigned)(Rb * K + C) * 2u; }
    const size_t kstep = (size_t)(BK * 2);
    const size_t hstep = (size_t)HALF * K * 2;
    const size_t tstep = 2 * hstep; const size_t hstepA = (size_t)HALF * g.lda * 2, tstepA = 2 * hstepA;
    const unsigned ldsw = (unsigned)wid * 1024u;
    const int aoff = lds_byte(wr * 64 + fr, fq * 8), boff = lds_byte(wc * 32 + fr, fq * 8);
#define PG8_SA(b, h) (((b) * 2 + (h)) * HTB)
#define PG8_SB(b, h) ((4 + (b) * 2 + (h)) * HTB)
#define PG8_STAGE(bufoff, gbase, voff) do { _Pragma("unroll") for (int _i = 0; _i < 2; ++_i) \
        __builtin_amdgcn_global_load_lds((const unsigned*)((const char*)(gbase) + (voff)[_i]), (PG8_LAS unsigned*)(lds + (bufoff) + ldsw + _i * 8192), 16, 0, 0); } while (0)
#define PG8_LDA(dst, b, h) do { _Pragma("unroll") for (int m = 0; m < 4; ++m) _Pragma("unroll") for (int k = 0; k < 2; ++k) dst[m][k] = *(const PG8_LAS bf16x8*)(lds + PG8_SA(b, h) + aoff + m * 2048 + k * 1024); } while (0)
#define PG8_LDB(dst, b, h) do { _Pragma("unroll") for (int n = 0; n < 2; ++n) _Pragma("unroll") for (int k = 0; k < 2; ++k) dst[n][k] = *(const PG8_LAS bf16x8*)(lds + PG8_SB(b, h) + boff + n * 2048 + k * 1024); } while (0)
#define PG8_MMA(ai, bj, At, Bt) do { __builtin_amdgcn_s_setprio(1); _Pragma("unroll") for (int m = 0; m < 4; ++m) _Pragma("unroll") for (int n = 0; n < 2; ++n) _Pragma("unroll") for (int k = 0; k < 2; ++k) \
        acc[ai][bj][m][n] = __builtin_amdgcn_mfma_f32_16x16x32_bf16(Bt[n][k], At[m][k], acc[ai][bj][m][n], 0, 0, 0); __builtin_amdgcn_s_setprio(0); } while (0)
#define PG8_WAIT_V(n) asm volatile("s_waitcnt vmcnt(" #n ")" ::: "memory")
#define PG8_WAIT_L(n) asm volatile("s_waitcnt lgkmcnt(" #n ")" ::: "memory")
#define PG8_BAR __builtin_amdgcn_s_barrier()
#define PG8_SCHED __builtin_amdgcn_sched_barrier(0)
    Unit cur, nxt; int ui = 0;
    if (!S.next(0, cur)) return;
    f32x4 acc[2][2][4][2];
#pragma unroll
    for (int a = 0; a < 2; ++a)
#pragma unroll
        for (int b = 0; b < 2; ++b)
#pragma unroll
            for (int m = 0; m < 4; ++m)
#pragma unroll
                for (int n = 0; n < 2; ++n) acc[a][b][m][n] = (f32x4){0.f, 0.f, 0.f, 0.f};
    bf16x8 At[4][2], B0[2][2], B1[2][2];
    const char* cA = (const char*)g.A + (size_t)cur.pm * tstepA; const char* cB = (const char*)g.Bt + (size_t)cur.pn * tstep;
    S.a_ready(cur);
    PG8_STAGE(PG8_SB(0, 0), cB, voffB); PG8_STAGE(PG8_SA(0, 0), cA, voffA); PG8_STAGE(PG8_SB(0, 1), cB + hstep, voffB); PG8_STAGE(PG8_SA(0, 1), cA + hstepA, voffA);
    if (wr == 1) PG8_BAR;
    PG8_WAIT_V(4); PG8_BAR;
    PG8_STAGE(PG8_SB(1, 0), cB + kstep, voffB); PG8_STAGE(PG8_SA(1, 0), cA + kstep, voffA); PG8_STAGE(PG8_SB(1, 1), cB + hstep + kstep, voffB);
    PG8_WAIT_V(6); PG8_BAR;
    PG8_STAMP();
    for (;;) {
        const bool has_next = S.next(ui + 1, nxt);
        const char* nA = has_next ? (const char*)g.A + (size_t)nxt.pm * tstepA : cA; const char* nB = has_next ? (const char*)g.Bt + (size_t)nxt.pn * tstep : cB;
        for (int t = 0; t < nt; t += 2) {
            const bool last = (t == nt - 2);
            const char* a1 = cA + (size_t)(t + 1) * kstep;
            const char* a2 = last ? nA : cA + (size_t)(t + 2) * kstep; const char* b2 = last ? nB : cB + (size_t)(t + 2) * kstep;
            const char* a3 = a2 + kstep; const char* b3 = b2 + kstep;
            if (last && has_next) S.a_ready(nxt);
            PG8_LDB(B0, 0, 0); PG8_SCHED; PG8_LDA(At, 0, 0); PG8_STAGE(PG8_SA(1, 1), a1 + hstepA, voffA);
            PG8_WAIT_L(8); PG8_BAR; PG8_WAIT_L(0); PG8_MMA(0, 0, At, B0); PG8_BAR; PG8_SCHED;
            PG8_LDB(B1, 0, 1); PG8_STAGE(PG8_SB(0, 0), b2, voffB);
            PG8_BAR; PG8_WAIT_L(0); PG8_MMA(0, 1, At, B1); PG8_BAR;
            PG8_LDA(At, 0, 1); PG8_STAGE(PG8_SA(0, 0), a2, voffA);
            PG8_BAR; PG8_WAIT_L(0); PG8_MMA(1, 0, At, B0); PG8_BAR; PG8_SCHED;
            PG8_STAGE(PG8_SB(0, 1), b2 + hstep, voffB);
            PG8_WAIT_V(6); PG8_BAR; PG8_MMA(1, 1, At, B1); PG8_BAR;
            PG8_LDB(B0, 1, 0); PG8_SCHED; PG8_LDA(At, 1, 0); PG8_STAGE(PG8_SA(0, 1), a2 + hstepA, voffA);
            PG8_WAIT_L(8); PG8_BAR; PG8_WAIT_L(0); PG8_MMA(0, 0, At, B0); PG8_BAR; PG8_SCHED;
            PG8_LDB(B1, 1, 1); PG8_STAGE(PG8_SB(1, 0), b3, voffB);
            PG8_BAR; PG8_WAIT_L(0); PG8_MMA(0, 1, At, B1); PG8_BAR;
            PG8_LDA(At, 1, 1); PG8_STAGE(PG8_SA(1, 0), a3, voffA);
            PG8_BAR; PG8_WAIT_L(0); PG8_MMA(1, 0, At, B0); PG8_BAR; PG8_SCHED;
            PG8_STAGE(PG8_SB(1, 1), b3 + hstep, voffB);
            PG8_WAIT_V(6); PG8_BAR; PG8_MMA(1, 1, At, B1); PG8_BAR;
        }
        PG8_STAMP();
        if constexpr (!Epi::AFTER_DRAIN) { E(acc, cur, wr, wc, fr, fq); S.done(cur); }
        PG8_STAMP();
        if (!has_next) break;
#pragma unroll
        for (int a = 0; a < 2; ++a)
#pragma unroll
            for (int b = 0; b < 2; ++b)
#pragma unroll
                for (int m = 0; m < 4; ++m)
#pragma unroll
                    for (int n = 0; n < 2; ++n) acc[a][b][m][n] = (f32x4){0.f, 0.f, 0.f, 0.f};
        cur = nxt; cA = nA; cB = nB; ++ui;
    }
    PG8_WAIT_V(0);
    if (wr == 0) PG8_BAR;
    PG8_BAR;
    if constexpr (Epi::AFTER_DRAIN) { E.fused(acc, cur, wr, wc, fr, fq, lds, wid, lane); S.done(cur); }
    PG8_STAMP();
    if (STAMP && wid == 0) { stamps[lane] = lane < nts ? (((unsigned long long)(unsigned)ts_hi << 32) | (unsigned)ts_lo) : 0ull;
        if (lane == 62) stamps[62] = rt_entry; if (lane == 63) stamps[63] = (unsigned long long)wall_clock64(); }
#undef PG8_STAMP
#undef PG8_SA
#undef PG8_SB
#undef PG8_STAGE
#undef PG8_LDA
#undef PG8_LDB
#undef PG8_MMA
#undef PG8_WAIT_V
#undef PG8_WAIT_L
#undef PG8_BAR
#undef PG8_SCHED
}
}
#define XB_TMO      128
#define XB_XCNT(j)  (256  + 64 * (j))
#define XB_XSUB(j)  (1280 + 64 * (j))
#define XB_XGEN(j)  (2304 + 64 * (j))
#define XB_TOP      3328
#define XB_TOPGEN   3392
#define XCD_BAR_WORDS 3456
#define XB_SPIN_CAP (1u << 22)

__device__ __forceinline__ unsigned xb_ld(unsigned* p)              { return __hip_atomic_load(p, __ATOMIC_RELAXED, __HIP_MEMORY_SCOPE_AGENT); }
__device__ __forceinline__ unsigned xb_add(unsigned* p, unsigned v) { return __hip_atomic_fetch_add(p, v, __ATOMIC_RELAXED, __HIP_MEMORY_SCOPE_AGENT); }
__device__ __forceinline__ unsigned xb_xcc_id() { return (unsigned)__builtin_amdgcn_s_getreg((3 << 11) | 20) & 0xFu; }
#define XB_SPIN(cond, bar) do { unsigned _sp = 0; while (cond) { __builtin_amdgcn_s_sleep(1); \
    if ((++_sp & 255u) == 0u) { if (xb_ld(&(bar)[XB_TMO])) break; if (_sp > XB_SPIN_CAP) { atomicAdd(&(bar)[XB_TMO], 1u); break; } } } } while (0)

struct XcdBarrier {
    unsigned* bar; unsigned x;
    volatile LAS unsigned* st;
};

__device__ __forceinline__ XcdBarrier xcd_barrier_post(unsigned* bar, volatile LAS unsigned* st) {
    XcdBarrier b; b.bar = bar; b.x = xb_xcc_id(); b.st = st;
    if (threadIdx.x == 0) (void)xb_add(&bar[XB_XCNT(b.x)], 1u);
    return b;
}
__device__ __forceinline__ void xcd_barrier_complete(unsigned* bar, unsigned x, unsigned& nloc, unsigned& nx) {
    const unsigned G = gridDim.x * gridDim.y * gridDim.z;
    unsigned sum, cnt, mine, sp = 0u;
    for (;;) {
        sum = 0u; cnt = 0u; mine = 0u;
#pragma unroll
        for (unsigned j = 0; j < 16; ++j) { const unsigned c = xb_ld(&bar[XB_XCNT(j)]); sum += c; cnt += (c > 0u) ? 1u : 0u; mine = (j == x) ? c : mine; }
        if (sum == G) break;
        __builtin_amdgcn_s_sleep(1);
        if ((++sp & 255u) == 0u) { if (xb_ld(&bar[XB_TMO])) break; if (sp > XB_SPIN_CAP) { atomicAdd(&bar[XB_TMO], 1u); break; } }
    }
    nloc = mine > 0u ? mine : 1u; nx = cnt > 0u ? cnt : 1u;
}

__device__ __forceinline__ void xcd_barrier(const XcdBarrier& b) {
    asm volatile("s_waitcnt vmcnt(0)" ::: "memory");
    __syncthreads();
    if (threadIdx.x == 0) {
        unsigned* bar = b.bar;
        __builtin_amdgcn_s_waitcnt(0);
        unsigned nloc = b.st[0], nx = b.st[1];
        if (nloc == 0u) { xcd_barrier_complete(bar, b.x, nloc, nx); b.st[0] = nloc; b.st[1] = nx; }
        const unsigned old = xb_add(&bar[XB_XSUB(b.x)], 1u);
        const unsigned gen = old / nloc;
        if (old + 1u == (gen + 1u) * nloc) {
            __builtin_amdgcn_fence(__ATOMIC_RELEASE, "agent");
            asm volatile("s_waitcnt vmcnt(0)" ::: "memory");
            const unsigned og = xb_add(&bar[XB_TOP], 1u);
            const unsigned tg = og / nx;
            if (og + 1u == (tg + 1u) * nx) xb_add(&bar[XB_TOPGEN], 1u);
            else XB_SPIN(xb_ld(&bar[XB_TOPGEN]) == tg, bar);
            __builtin_amdgcn_fence(__ATOMIC_ACQUIRE, "agent");
            xb_add(&bar[XB_XGEN(b.x)], 1u);
            asm volatile("s_waitcnt vmcnt(0)" ::: "memory");
        } else {
            XB_SPIN(xb_ld(&bar[XB_XGEN(b.x)]) == gen, bar);
            __builtin_amdgcn_fence(__ATOMIC_ACQUIRE, "agent");
            asm volatile("s_waitcnt vmcnt(0)" ::: "memory");
        }
    }
    __syncthreads();
}


struct Args { const float* in[31]; float* out; unsigned char* ws; int ph_lo, ph_hi; };
struct PArgs { const float* const* in; float* out; unsigned char* ws; };

struct Ctx {
    LAS unsigned char* lds;
    int tid, lane, wave, nblk, blk;
};

DI void transpose_item(const float* W, int ldw, int src_n0, int k0, bf16* dst, int ldd, bool zero, LAS float* scr, int lane) {
    if (!zero) {
#pragma unroll 8
        for (int i = 0; i < 32; ++i) { const int kk = 2 * i + (lane >> 5); scr[kk * 33 + (lane & 31)] = W[(size_t)(k0 + kk) * ldw + src_n0 + (lane & 31)]; }
    }
    LDS_WAIT(); asm volatile("" ::: "memory");
    const int c = lane & 7;
#pragma unroll
    for (int j = 0; j < 4; ++j) { const int n = (lane >> 3) + 8 * j; const LAS float* s = scr + (8 * c) * 33 + n;
        u32x4 o;
        if (zero) { o = (u32x4){0u, 0u, 0u, 0u}; }
        else { o.x = cvt_pk(s[0 * 33], s[1 * 33]); o.y = cvt_pk(s[2 * 33], s[3 * 33]); o.z = cvt_pk(s[4 * 33], s[5 * 33]); o.w = cvt_pk(s[6 * 33], s[7 * 33]); }
        *(u32x4*)(dst + (size_t)n * ldd + k0 + 8 * c) = o; }
    LDS_WAIT(); asm volatile("" ::: "memory");
}

DI void phase_prologue(const Ctx& X, const PArgs& a) {
    unsigned char* ws = a.ws;
    LAS float* scr = (LAS float*)(X.lds + X.wave * 16384);
    const int gw = X.blk * 8 + X.wave, NGW = X.nblk * 8;
    constexpr int I_IN = 16 * (NWIN / 32), I_PA = 8 * 32, I_PB = 8 * 32, I_OUT = 16 * 32;
    constexpr int NITEMS = I_IN + I_PA + I_PB + I_OUT;
    for (int it = gw; it < NITEMS; it += NGW) {
        int r = it;
        if (r < I_IN) { const int kb = r / (NWIN / 32), nb = r % (NWIN / 32); const int n0 = nb * 32;
            const bool zero = (n0 >= 3744 && n0 < 3840); const int src = n0 < 3744 ? n0 : n0 - 96;
            transpose_item(a.in[5], 5792, zero ? 0 : src, kb * 64, (bf16*)(ws + WS_WIN) + (size_t)n0 * 1024, 1024, zero, scr, X.lane); continue; }
        r -= I_IN;
        if (r < I_PA) { const int kb = r / 32, nb = r % 32; transpose_item(a.in[19], 1024, nb * 32, kb * 64, (bf16*)(ws + WS_WPA) + (size_t)(nb * 32) * 512, 512, false, scr, X.lane); continue; }
        r -= I_PA;
        if (r < I_PB) { const int kb = r / 32, nb = r % 32; transpose_item(a.in[20], 1024, nb * 32, kb * 64, (bf16*)(ws + WS_WPB) + (size_t)(nb * 32) * 512, 512, false, scr, X.lane); continue; }
        r -= I_PB;
        { const int kb = r / 32, nb = r % 32; transpose_item(a.in[21], 1024, nb * 32, kb * 64, (bf16*)(ws + WS_WOUT) + (size_t)(nb * 32) * 1024, 1024, false, scr, X.lane); }
    }
    {
        bf16* G2TB = (bf16*)(ws + WS_G2T); const float* g2 = a.in[13];
        for (int idx = X.blk * 512 + X.tid; idx < 8 * 64 * 96; idx += X.nblk * 512) { const int m = idx % 96, i = (idx / 96) & 63, hh = idx / (96 * 64);
            G2TB[idx] = f2bf(g2[m * 512 + hh * 64 + i]); }
    }
    __syncthreads();
    {
        LAS float* cs = (LAS float*)X.lds;
        LAS float* part = (LAS float*)(X.lds + 8192);
        for (int i = X.tid; i < 2048; i += 512) cs[i] = siluf_(a.in[1][i]);
        __syncthreads();
        const float* aw = a.in[2]; const float* ab = a.in[3]; float* mod = (float*)(ws + WS_MOD);
        for (int cb = X.blk; cb < 256; cb += X.nblk) {
            const int c = X.tid % 24, kg = X.tid / 24;
            float s0 = 0.f, s1 = 0.f;
            if (kg < 21) for (int k = kg; k < 1024; k += 21) { const float w = aw[(size_t)k * 6144 + cb * 24 + c]; s0 += cs[k] * w; s1 += cs[1024 + k] * w; }
            if (kg < 21) { part[(kg * 24 + c) * 2] = s0; part[(kg * 24 + c) * 2 + 1] = s1; }
            __syncthreads();
            if (X.tid < 48) { const int cc = X.tid >> 1, b = X.tid & 1; float s = 0.f;
                for (int q = 0; q < 21; ++q) s += part[(q * 24 + cc) * 2 + b];
                mod[b * 6144 + cb * 24 + cc] = s + ab[cb * 24 + cc]; }
            __syncthreads();
        }
    }
}

DI void phase_norm1(const Ctx& X, const PArgs& a) {
    const float* x = a.in[0]; const float* g1 = a.in[4]; const float* mod = (const float*)(a.ws + WS_MOD);
    bf16* h = (bf16*)a.out;
    const int gw = X.blk * 8 + X.wave, NGW = X.nblk * 8;
    for (int m = gw; m < NTOK; m += NGW) {
        const int b = m >> 13;
        const f32x4* xr = (const f32x4*)(x + (size_t)m * DM) + X.lane;
        f32x4 v[4]; float s = 0.f;
#pragma unroll
        for (int j = 0; j < 4; ++j) { v[j] = xr[64 * j]; s += (v[j].x * v[j].x + v[j].y * v[j].y) + (v[j].z * v[j].z + v[j].w * v[j].w); }
        const float rs = frsq(wave_sum(s) * (1.f / DM) + 1e-6f);
        u32x2* o = (u32x2*)(h + (size_t)m * DM) + X.lane;
#pragma unroll
        for (int j = 0; j < 4; ++j) { const int col = 4 * X.lane + 256 * j;
            const f32x4 g = *(const f32x4*)(g1 + col), sh = *(const f32x4*)(mod + b * 6144 + col), sc = *(const f32x4*)(mod + b * 6144 + 1024 + col);
            const f32x4 y = v[j] * rs * g * (1.0f + sc) + sh;
            u32x2 w; w.x = cvt_pk(y.x, y.y); w.y = cvt_pk(y.z, y.w); o[64 * j] = w; }
    }
    {
        const float* g2 = a.in[22]; const float* wgr = a.in[23]; const float* bgr = a.in[24]; const float* wer = a.in[25]; const float* ber = a.in[26];
        bf16* WRH = (bf16*)(a.ws + WS_WRH); bf16* WRL = (bf16*)(a.ws + WS_WRL); float* CB = (float*)(a.ws + WS_CB);
        for (int idx = X.blk * 512 + X.tid; idx < 2 * 48 * 1024; idx += X.nblk * 512) {
            const int k = idx & 1023, o = (idx >> 10) % 48, b = idx / (48 * 1024);
            float wv = 0.f;
            if (o < 4) wv = wgr[k * 4 + o]; else if (o < 36) wv = wer[k * 32 + (o - 4)];
            wv *= g2[k] * (1.0f + mod[b * 6144 + 4096 + k]);
            const bf16 hi = f2bf(wv); const bf16 lo = f2bf(wv - bf2f(hi));
            WRH[idx] = hi; WRL[idx] = lo;
        }
        if (gw < 96) { const int b = gw / 48, o = gw % 48; float s = 0.f;
            if (o < 36) for (int k = X.lane; k < 1024; k += 64) s += mod[b * 6144 + 3072 + k] * (o < 4 ? wgr[k * 4 + o] : wer[k * 32 + (o - 4)]);
            s = wave_sum(s);
            if (X.lane == 0) CB[b * 48 + o] = o < 4 ? s + bgr[o] : (o < 36 ? s + ber[o - 4] : 0.f); }
    }
}

constexpr int HG_CUMLD = 132;
DI float hg_lb_of(const float* hg_lb, int idx) { return frcp(1.0f + __expf(hg_lb[512 + idx] - hg_lb[idx])); }

DI void hg_load_f(const Ctx& X, const bf16* proj, const float* hg_lb, int row0, int hh, LAS float* CUM, float (&f)[16]) {
    const int t = X.tid >> 3, cg = (X.tid & 7) * 16;
    const u32x4* src = (const u32x4*)(proj + pj_off(row0 + t, C_HF + hh * 128, 128, cg));
    const u32x4 r0 = src[0], r1 = src[1];
    const unsigned w[8] = {r0.x, r0.y, r0.z, r0.w, r1.x, r1.y, r1.z, r1.w};
#pragma unroll
    for (int e = 0; e < 8; ++e) {
        const float lb0 = hg_lb_of(hg_lb, hh * 128 + cg + 2 * e), lb1 = hg_lb_of(hg_lb, hh * 128 + cg + 2 * e + 1);
        f[2 * e] = lb0 + (1.0f - lb0) * sigmoidf_(bflo(w[e])); f[2 * e + 1] = lb1 + (1.0f - lb1) * sigmoidf_(bfhi(w[e]));
    }
#pragma unroll
    for (int e = 0; e < 16; e += 4) *(LAS f32x4*)(CUM + t * HG_CUMLD + cg + e) = (f32x4){__logf(f[e]), __logf(f[e + 1]), __logf(f[e + 2]), __logf(f[e + 3])};
}
DI void hg_scan(const Ctx& X, LAS float* CUM, LAS float* TOT) {
    const int k = X.tid & 127, seg = X.tid >> 7;
    float v[16]; float run = 0.f;
#pragma unroll
    for (int i = 0; i < 16; ++i) { run += CUM[(seg * 16 + i) * HG_CUMLD + k]; v[i] = run; }
    TOT[seg * 128 + k] = run;
    __syncthreads();
    float off = 0.f;
#pragma unroll
    for (int s = 0; s < 3; ++s) off += (s < seg) ? TOT[s * 128 + k] : 0.f;
#pragma unroll
    for (int i = 0; i < 16; ++i) CUM[(seg * 16 + i) * HG_CUMLD + k] = v[i] + off;
    __syncthreads();
}

DI void hg1_unit(const Ctx& X, const PArgs& a, int u) {
    const bf16* proj = (const bf16*)(a.ws + WS_PROJ);
    const int pair = u >> 7, c = u & 127, b = pair >> 2, hh = pair & 3, row0 = b * SEQ + c * 64;
    LAS float* CUM = (LAS float*)X.lds; LAS float* TOT = (LAS float*)(X.lds + 33792);
    LAS bf16* KDT = (LAS bf16*)(X.lds + 36864); LAS bf16* VT = (LAS bf16*)(X.lds + 55296);
    float f[16];
    const int t = X.tid >> 3, cg = (X.tid & 7) * 16;
    const u32x4* srci = (const u32x4*)(proj + pj_off(row0 + t, C_HI + hh * 128, 128, cg));
    const u32x4 r0 = srci[0], r1 = srci[1];
    hg_load_f(X, proj, a.in[6], row0, hh, CUM, f);
    __syncthreads();
    hg_scan(X, CUM, TOT);
    if (X.tid < 128) ((float*)(a.ws + WS_HGC))[(size_t)u * 128 + X.tid] = __expf(CUM[63 * HG_CUMLD + X.tid]);
    {
        const unsigned w[8] = {r0.x, r0.y, r0.z, r0.w, r1.x, r1.y, r1.z, r1.w};
#pragma unroll
        for (int e = 0; e < 16; ++e) {
            const int k = cg + e;
            const float kd = (1.0f - f[e]) * __expf(CUM[63 * HG_CUMLD + k] - CUM[t * HG_CUMLD + k]);
            KDT[k * 72 + t] = f2bf(kd);
            VT[k * 72 + t] = (bf16)((e & 1) ? (w[e >> 1] >> 16) : (w[e >> 1] & 0xffffu));
        }
    }
    __syncthreads();
    {
        const int w = X.wave, v0 = 32 * (w >> 1), k0 = 64 * (w & 1), r = X.lane & 15, g = X.lane >> 4;
        f32x4 acc[4][2]; zero_acc(acc);
        mm_ll<4, 2, 2>(KDT + k0 * 72, 72, VT + v0 * 72, 72, acc, X.lane);
        bf16* dst = (bf16*)(a.ws + WS_HS) + (size_t)u * 16384;
#pragma unroll
        for (int tp = 0; tp < 4; ++tp)
#pragma unroll
            for (int tq = 0; tq < 2; ++tq) { u32x2 o; o.x = cvt_pk(acc[tp][tq][0], acc[tp][tq][1]); o.y = cvt_pk(acc[tp][tq][2], acc[tp][tq][3]);
                *(u32x2*)(dst + (v0 + 16 * tq + r) * 128 + k0 + 16 * tp + 4 * g) = o; }
    }
    __syncthreads();
}

DI void hg2_scan(const Ctx& X, const PArgs& a, bool dry = false) {
    const float* gc = (const float*)(a.ws + WS_HGC);
    for (int it = X.blk * 512 + X.tid; it < 65536; it += X.nblk * 512) {
        const int pair = it >> 13, rem = it & 8191;
        const int kp = rem & 63;
        unsigned* base = (unsigned*)(a.ws + WS_HS) + (size_t)pair * 128 * 8192 + rem;
        const float* gb = gc + (size_t)pair * 128 * 128 + kp * 2;
        float s0 = 0.f, s1 = 0.f;
        for (int cb = 0; cb < 128; cb += 8) {
            unsigned uu[8]; f32x2 gg[8];
#pragma unroll
            for (int i = 0; i < 8; ++i) { uu[i] = base[(size_t)(cb + i) * 8192]; gg[i] = *(const f32x2*)(gb + (cb + i) * 128); }
#pragma unroll
            for (int i = 0; i < 8; ++i) { if (!dry || s0 == 1.2345e33f) base[(size_t)(cb + i) * 8192] = cvt_pk(s0, s1); s0 = gg[i].x * s0 + bflo(uu[i]); s1 = gg[i].y * s1 + bfhi(uu[i]); }
        }
    }
}

DI void hg3_unit(const Ctx& X, const PArgs& a, int u) {
    const bf16* proj = (const bf16*)(a.ws + WS_PROJ);
    const int pair = u >> 7, c = u & 127, b = pair >> 2, hh = pair & 3, row0 = b * SEQ + c * 64;
    LAS float* CUM = (LAS float*)X.lds; LAS float* TOT = (LAS float*)(X.lds + 33792);
    LAS float* RED = (LAS float*)(X.lds + 36352);
    LAS bf16* QD = (LAS bf16*)(X.lds + 36864); LAS bf16* QT = (LAS bf16*)(X.lds + 54272); LAS bf16* KT = (LAS bf16*)(X.lds + 71680);
    LAS bf16* VT = (LAS bf16*)(X.lds + 89088); LAS bf16* PM = (LAS bf16*)(X.lds + 107520);
    float f[16];
    const int w = X.wave, r = X.lane & 15, g = X.lane >> 4, tq0 = 16 * (w >> 1);
    const u32x4* sq = (const u32x4*)(proj + pj_off(row0 + (X.tid >> 3), C_HQ + hh * 128, 128, (X.tid & 7) * 16));
    const u32x4* sv = (const u32x4*)(proj + pj_off(row0 + (X.tid >> 3), C_HI + hh * 128, 128, (X.tid & 7) * 16));
    const u32x4 q0 = sq[0], q1 = sq[1], i0 = sv[0], i1 = sv[1];
    u32x2 ggw[4];
#pragma unroll
    for (int tp = 0; tp < 4; ++tp) ggw[tp] = *(const u32x2*)(proj + pj_off(row0 + tq0 + r, C_HG + hh * 128, 128, 64 * (w & 1) + 16 * tp + 4 * g));
    hg_load_f(X, proj, a.in[6], row0, hh, CUM, f);
    __syncthreads();
    hg_scan(X, CUM, TOT);
    {
        const int t = X.tid >> 3, cg = (X.tid & 7) * 16;
        const unsigned qw[8] = {q0.x, q0.y, q0.z, q0.w, q1.x, q1.y, q1.z, q1.w};
        const unsigned iw[8] = {i0.x, i0.y, i0.z, i0.w, i1.x, i1.y, i1.z, i1.w};
        unsigned oqd[8], oqt[8], okt[8];
#pragma unroll
        for (int e = 0; e < 8; ++e) {
            float qd[2], qt[2], kt[2];
#pragma unroll
            for (int hb = 0; hb < 2; ++hb) {
                const int k = cg + 2 * e + hb;
                const float cum = CUM[t * HG_CUMLD + k], ref = CUM[31 * HG_CUMLD + k];
                const float qs = siluf_(hb ? bfhi(qw[e]) : bflo(qw[e]));
                qd[hb] = qs * __expf(cum); qt[hb] = qs * __expf(cum - ref); kt[hb] = (1.0f - f[2 * e + hb]) * __expf(ref - cum);
                VT[k * 72 + t] = (bf16)(hb ? (iw[e] >> 16) : (iw[e] & 0xffffu));
            }
            oqd[e] = cvt_pk(qd[0], qd[1]); oqt[e] = cvt_pk(qt[0], qt[1]); okt[e] = cvt_pk(kt[0], kt[1]);
        }
        *(LAS u32x4*)(QD + t * 136 + cg) = (u32x4){oqd[0], oqd[1], oqd[2], oqd[3]}; *(LAS u32x4*)(QD + t * 136 + cg + 8) = (u32x4){oqd[4], oqd[5], oqd[6], oqd[7]};
        *(LAS u32x4*)(QT + t * 136 + cg) = (u32x4){oqt[0], oqt[1], oqt[2], oqt[3]}; *(LAS u32x4*)(QT + t * 136 + cg + 8) = (u32x4){oqt[4], oqt[5], oqt[6], oqt[7]};
        *(LAS u32x4*)(KT + t * 136 + cg) = (u32x4){okt[0], okt[1], okt[2], okt[3]}; *(LAS u32x4*)(KT + t * 136 + cg + 8) = (u32x4){okt[4], okt[5], okt[6], okt[7]};
    }
    __syncthreads();
    {
        f32x4 acc[2][1]; zero_acc(acc);
        const int s0 = 32 * (w & 1);
        mm_ll<2, 1, 4>(KT + s0 * 136, 136, QT + tq0 * 136, 136, acc, X.lane);
        const int t = tq0 + r;
#pragma unroll
        for (int tp = 0; tp < 2; ++tp) { const int sb = s0 + 16 * tp + 4 * g; float v[4];
#pragma unroll
            for (int e = 0; e < 4; ++e) v[e] = (sb + e <= t) ? acc[tp][0][e] : 0.f;
            u32x2 o; o.x = cvt_pk(v[0], v[1]); o.y = cvt_pk(v[2], v[3]); *(LAS u32x2*)(PM + t * 72 + sb) = o; }
    }
    __syncthreads();
    {
        const int v0 = 64 * (w & 1), t = tq0 + r;
        f32x4 acc[4][1]; zero_acc(acc);
        mm_gl<4, 1, 4>((const bf16*)(a.ws + WS_HS) + (size_t)u * 16384 + (size_t)v0 * 128, 128, QD + tq0 * 136, 136, acc, X.lane);
        mm_ll<4, 1, 2>(VT + v0 * 72, 72, PM + tq0 * 72, 72, acc, X.lane);
        float ss = 0.f;
#pragma unroll
        for (int tp = 0; tp < 4; ++tp)
#pragma unroll
            for (int e = 0; e < 4; ++e) ss += acc[tp][0][e] * acc[tp][0][e];
        ss += __shfl_xor(ss, 16); ss += __shfl_xor(ss, 32);
        if (g == 0) RED[t * 2 + (w & 1)] = ss;
        __syncthreads();
        const float rs = frsq((RED[t * 2] + RED[t * 2 + 1]) * (1.0f / 128.0f) + 1e-6f);
        const float* ng = a.in[7];
#pragma unroll
        for (int tp = 0; tp < 4; ++tp) { const int v = v0 + 16 * tp + 4 * g;
            const u32x2 gw = ggw[tp];
            const f32x4 n4 = *(const f32x4*)(ng + hh * 128 + v);
            const float o0 = acc[tp][0][0] * rs * n4.x * siluf_(bflo(gw.x)), o1 = acc[tp][0][1] * rs * n4.y * siluf_(bfhi(gw.x));
            const float o2 = acc[tp][0][2] * rs * n4.z * siluf_(bflo(gw.y)), o3 = acc[tp][0][3] * rs * n4.w * siluf_(bfhi(gw.y));
            u32x2 o; o.x = cvt_pk(o0, o1); o.y = cvt_pk(o2, o3);
            *(u32x2*)((bf16*)a.out + (size_t)(row0 + t) * 512 + hh * 128 + v) = o; }
    }
    __syncthreads();
}

constexpr int R_AT = 0, R_RT = 9216, R_BH = 18432, R_KH = 27648, R_BHT = 36864, R_KHT = 46080, R_VT = 55296, R_AAK = 64512, R_ARB = 73728, R_ARK = 82944,
              R_WT = 92160, R_U0T = 101376, R_XB = 110592, R_CUM = 144384, R_GC = 161792;
constexpr int R_LW = 64512, R_LA = 69632, R_W2T = 74752, R_A2T = 79872;
constexpr int R_TOT = 92160, R_RED = 94208;
constexpr int XBLD = 132, CUMLD = 68;

DI float tanh_fast(float x) { return 1.0f - 2.0f * frcp(1.0f + __expf(2.0f * x)); }
DI f32x4 rw_shift4(const bf16* proj, const float* mu, int row, int col, bool first) {
    const int ss = col < C_WD ? (col & ~63) : (col < C_GD ? C_WD : C_GD), wd = col < C_GD ? 64 : 192;
    const bf16* ptr = proj + pj_off(row, ss, wd, col - ss);
    const u32x2 cw = *(const u32x2*)ptr;
    u32x2 pw = (u32x2){0u, 0u};
    if (!first) pw = *(const u32x2*)(ptr - wd);
    const f32x4 m = *(const f32x4*)(mu + (col - C_RR));
    const f32x4 c = (f32x4){bflo(cw.x), bfhi(cw.x), bflo(cw.y), bfhi(cw.y)}, p = (f32x4){bflo(pw.x), bfhi(pw.x), bflo(pw.y), bfhi(pw.y)};
    return c + m * (p - c);
}

#if defined(MK_TPROBE)
#define TPROBE_INIT() unsigned long long tp_last = __builtin_amdgcn_s_memtime()
#define TPROBE(k) do { if (X.blk == 0 && X.tid == 0) { const unsigned long long now_ = __builtin_amdgcn_s_memtime(); float* T_ = (float*)(a.ws + WS_CTL) + 32768; T_[k] += (float)(now_ - tp_last); tp_last = now_; } } while (0)
#else
#define TPROBE_INIT() do { } while (0)
#define TPROBE(k) do { } while (0)
#endif
DI void rw1_unit(const Ctx& X, const PArgs& a, int u) {
    TPROBE_INIT();
    const bf16* proj = (const bf16*)(a.ws + WS_PROJ);
    const float* mu = a.in[8];
    const int pair = u >> 7, c = u & 127, b = pair >> 3, h = pair & 7, row0 = b * SEQ + c * 64;
    LAS unsigned char* L = X.lds;
    LAS bf16 *AT = (LAS bf16*)(L + R_AT), *RT = (LAS bf16*)(L + R_RT), *BH = (LAS bf16*)(L + R_BH), *KH = (LAS bf16*)(L + R_KH), *BHT = (LAS bf16*)(L + R_BHT), *KHT = (LAS bf16*)(L + R_KHT),
             *VT = (LAS bf16*)(L + R_VT), *AAK = (LAS bf16*)(L + R_AAK), *ARB = (LAS bf16*)(L + R_ARB), *ARK = (LAS bf16*)(L + R_ARK), *WT = (LAS bf16*)(L + R_WT), *U0T = (LAS bf16*)(L + R_U0T),
             *LW = (LAS bf16*)(L + R_LW), *LA = (LAS bf16*)(L + R_LA), *W2T = (LAS bf16*)(L + R_W2T), *A2T = (LAS bf16*)(L + R_A2T);
    LAS float *XB = (LAS float*)(L + R_XB), *CUM = (LAS float*)(L + R_CUM), *GC = (LAS float*)(L + R_GC), *TOT = (LAS float*)(L + R_TOT), *RED = (LAS float*)(L + R_RED);
    const int w = X.wave, r = X.lane & 15, g = X.lane >> 4;
    const int t = 16 * (w >> 1) + r, jb = 32 * (w & 1) + 4 * g;
    f32x4 rr_[2], kk_[2], vv_[2], w0_[2], a0_[2], kk_c[2], ka_c[2], rk_c[2];
#pragma unroll
    for (int i = 0; i < 2; ++i) { const int col = h * 64 + jb + 16 * i; const bool first = (c == 0 && t == 0);
        rr_[i] = rw_shift4(proj, mu, row0 + t, C_RR + col, first); kk_[i] = rw_shift4(proj, mu, row0 + t, C_RK + col, first); vv_[i] = rw_shift4(proj, mu, row0 + t, C_RV + col, first);
        w0_[i] = *(const f32x4*)(a.in[9] + col); a0_[i] = *(const f32x4*)(a.in[11] + col); kk_c[i] = *(const f32x4*)(a.in[14] + col); ka_c[i] = *(const f32x4*)(a.in[15] + col); rk_c[i] = *(const f32x4*)(a.in[16] + col); }
    {
        const int t = X.tid >> 3, c8 = (X.tid & 7) * 8; const bool first = (c == 0 && t == 0);
        const f32x4 v0 = rw_shift4(proj, mu, row0 + t, C_WD + c8, first), v1 = rw_shift4(proj, mu, row0 + t, C_WD + c8 + 4, first);
        if (c8 < 32) { u32x4 o; o.x = cvt_pk(tanh_fast(v0.x), tanh_fast(v0.y)); o.y = cvt_pk(tanh_fast(v0.z), tanh_fast(v0.w)); o.z = cvt_pk(tanh_fast(v1.x), tanh_fast(v1.y)); o.w = cvt_pk(tanh_fast(v1.z), tanh_fast(v1.w));
            *(LAS u32x4*)(LW + t * 40 + c8) = o; }
        else { u32x4 o; o.x = cvt_pk(v0.x, v0.y); o.y = cvt_pk(v0.z, v0.w); o.z = cvt_pk(v1.x, v1.y); o.w = cvt_pk(v1.z, v1.w);
            *(LAS u32x4*)(LA + t * 40 + (c8 - 32)) = o; }
        const int m = X.tid >> 4, j4 = (X.tid & 15) * 4;
        const f32x4 w2 = *(const f32x4*)(a.in[10] + m * 512 + h * 64 + j4), a2 = *(const f32x4*)(a.in[12] + m * 512 + h * 64 + j4);
#pragma unroll
        for (int e = 0; e < 4; ++e) { W2T[(j4 + e) * 40 + m] = f2bf(w2[e]); A2T[(j4 + e) * 40 + m] = f2bf(a2[e]); }
    }
    __syncthreads(); TPROBE(0);
    float rs_[8], kf_[8], vs_[8], kkv_[8], aa_[8], lw_[8];
    {
        f32x4 accw[2][1], acca[2][1]; zero_acc(accw); zero_acc(acca);
        mm_ll<2, 1, 1>(W2T + 32 * (w & 1) * 40, 40, LW + 16 * (w >> 1) * 40, 40, accw, X.lane);
        mm_ll<2, 1, 1>(A2T + 32 * (w & 1) * 40, 40, LA + 16 * (w >> 1) * 40, 40, acca, X.lane);
        float ss = 0.f, bon = 0.f;
#pragma unroll
        for (int i = 0; i < 2; ++i) {
            const int j = jb + 16 * i, col = h * 64 + j;
            const f32x4 rr = rr_[i], kk = kk_[i], vv = vv_[i], w0 = w0_[i], a0 = a0_[i], k_k = kk_c[i], k_a = ka_c[i], r_k = rk_c[i];
            f32x4 lw4;
#pragma unroll
            for (int e = 0; e < 4; ++e) {
                const float y = -(w0[e] + accw[i][0][e]);
                const float sp = fmaxf(y, 0.f) + __logf(1.0f + __expf(-fabsf(y)));
                const float wlog = -sp - 0.5f;
                const float lw = -__expf(wlog);
                const float aa = sigmoidf_(a0[e] + acca[i][0][e]);
                const float kkv = kk[e] * k_k[e];
                const float kf = kk[e] * (1.0f + (aa - 1.0f) * k_a[e]);
                ss += kkv * kkv; bon += rr[e] * kf * r_k[e];
                rs_[4 * i + e] = rr[e]; kf_[4 * i + e] = kf; vs_[4 * i + e] = vv[e]; kkv_[4 * i + e] = kkv; aa_[4 * i + e] = aa; lw_[4 * i + e] = lw; lw4[e] = lw;
            }
            *(LAS f32x4*)(CUM + t * CUMLD + j) = lw4;
        }
        ss += __shfl_xor(ss, 16); ss += __shfl_xor(ss, 32); bon += __shfl_xor(bon, 16); bon += __shfl_xor(bon, 32);
        if (g == 0) { RED[(t * 2 + (w & 1)) * 2] = ss; RED[(t * 2 + (w & 1)) * 2 + 1] = bon; }
    }
    __syncthreads(); TPROBE(1);
    {
        const int j = X.tid & 63, seg = X.tid >> 6; float v[8]; float run = 0.f;
#pragma unroll
        for (int i = 0; i < 8; ++i) { run += CUM[(seg * 8 + i) * CUMLD + j]; v[i] = run; }
        TOT[seg * 64 + j] = run;
        __syncthreads();
        float off = 0.f;
#pragma unroll
        for (int s = 0; s < 7; ++s) off += (s < seg) ? TOT[s * 64 + j] : 0.f;
#pragma unroll
        for (int i = 0; i < 8; ++i) CUM[(seg * 8 + i) * CUMLD + j] = v[i] + off;
        if (seg == 7) { const float gc = __expf(v[7] + off); GC[j] = gc; ((float*)(a.ws + WS_RGC))[(size_t)u * 64 + j] = gc; }
    }
    __syncthreads(); TPROBE(2);
    {
        const float ssT = RED[(t * 2) * 2] + RED[(t * 2 + 1) * 2];
        const float inv = frsq(fmaxf(ssT, 1e-24f));
        if (g == 0 && (w & 1) == 0) ((float*)(a.ws + WS_BONUS))[(size_t)(row0 + t) * 8 + h] = RED[(t * 2) * 2 + 1] + RED[(t * 2 + 1) * 2 + 1];
#pragma unroll
        for (int i = 0; i < 2; ++i) {
            const int j = jb + 16 * i;
            const f32x4 cum = *(const LAS f32x4*)(CUM + t * CUMLD + j);
            float at[4], rt[4], bh[4], kh[4];
#pragma unroll
            for (int e = 0; e < 4; ++e) {
                const float kkn = kkv_[4 * i + e] * inv;
                const float eneg = __expf(-cum[e]);
                at[e] = -kkn * __expf(cum[e] - lw_[4 * i + e]); rt[e] = rs_[4 * i + e] * __expf(cum[e]);
                bh[e] = kkn * aa_[4 * i + e] * eneg; kh[e] = kf_[4 * i + e] * eneg;
                BHT[(j + e) * 72 + t] = f2bf(bh[e]); KHT[(j + e) * 72 + t] = f2bf(kh[e]); VT[(j + e) * 72 + t] = f2bf(vs_[4 * i + e]);
            }
            *(LAS u32x2*)(AT + t * 72 + j) = (u32x2){cvt_pk(at[0], at[1]), cvt_pk(at[2], at[3])};
            *(LAS u32x2*)(RT + t * 72 + j) = (u32x2){cvt_pk(rt[0], rt[1]), cvt_pk(rt[2], rt[3])};
            *(LAS u32x2*)(BH + t * 72 + j) = (u32x2){cvt_pk(bh[0], bh[1]), cvt_pk(bh[2], bh[3])};
            *(LAS u32x2*)(KH + t * 72 + j) = (u32x2){cvt_pk(kh[0], kh[1]), cvt_pk(kh[2], kh[3])};
            *(LAS f32x4*)(XB + t * XBLD + j) = (f32x4){at[0], at[1], at[2], at[3]};
        }
    }
    __syncthreads(); TPROBE(3);
    {
        LAS float* AAB = CUM;
        const int tq0 = 16 * (w >> 1), s0 = 32 * (w & 1);
        f32x4 ab[2][1], ak[2][1], rb[2][1], rk[2][1]; zero_acc(ab); zero_acc(ak); zero_acc(rb); zero_acc(rk);
        mm_ll<2, 1, 2>(BH + s0 * 72, 72, AT + tq0 * 72, 72, ab, X.lane);
        mm_ll<2, 1, 2>(KH + s0 * 72, 72, AT + tq0 * 72, 72, ak, X.lane);
        mm_ll<2, 1, 2>(BH + s0 * 72, 72, RT + tq0 * 72, 72, rb, X.lane);
        mm_ll<2, 1, 2>(KH + s0 * 72, 72, RT + tq0 * 72, 72, rk, X.lane);
#pragma unroll
        for (int tp = 0; tp < 2; ++tp) { const int sb = s0 + 16 * tp + 4 * g; f32x4 vab; float vak[4], vrb[4], vrk[4];
#pragma unroll
            for (int e = 0; e < 4; ++e) { const bool lo = (sb + e < t), le = (sb + e <= t);
                vab[e] = lo ? ab[tp][0][e] : 0.f; vak[e] = lo ? ak[tp][0][e] : 0.f; vrb[e] = le ? rb[tp][0][e] : 0.f; vrk[e] = le ? rk[tp][0][e] : 0.f; }
            *(LAS f32x4*)(AAB + t * CUMLD + sb) = vab;
            *(LAS u32x2*)(AAK + t * 72 + sb) = (u32x2){cvt_pk(vak[0], vak[1]), cvt_pk(vak[2], vak[3])};
            *(LAS u32x2*)(ARB + t * 72 + sb) = (u32x2){cvt_pk(vrb[0], vrb[1]), cvt_pk(vrb[2], vrb[3])};
            *(LAS u32x2*)(ARK + t * 72 + sb) = (u32x2){cvt_pk(vrk[0], vrk[1]), cvt_pk(vrk[2], vrk[3])}; }
    }
    __syncthreads(); TPROBE(4);
    LAS bf16* AABH = (LAS bf16*)(L + R_BH);
    LAS bf16* TINV = (LAS bf16*)(L + R_AT);
    LAS bf16* YT = (LAS bf16*)(L + R_KH);
    {
        const int tq0 = 16 * (w >> 1), i0 = 32 * (w & 1);
        f32x4 acc[2][1]; zero_acc(acc);
        mm_ll<2, 1, 2>(VT + i0 * 72, 72, AAK + tq0 * 72, 72, acc, X.lane);
#pragma unroll
        for (int tp = 0; tp < 2; ++tp) *(LAS f32x4*)(XB + t * XBLD + 64 + i0 + 16 * tp + 4 * g) = acc[tp][0];
        { const int tt = X.tid >> 3, s8 = (X.tid & 7) * 8; const f32x4 a0 = *(const LAS f32x4*)(CUM + tt * CUMLD + s8), a1 = *(const LAS f32x4*)(CUM + tt * CUMLD + s8 + 4);
          *(LAS u32x4*)(AABH + tt * 72 + s8) = (u32x4){cvt_pk(a0[0], a0[1]), cvt_pk(a0[2], a0[3]), cvt_pk(a1[0], a1[1]), cvt_pk(a1[2], a1[3])}; }
#pragma unroll
        for (int q = 0; q < 9; ++q) ((LAS unsigned*)WT)[X.tid * 9 + q] = 0u;
        if (w < 4) {
            const int l = X.lane & 15;
            float ar[16];
#pragma unroll
            for (int q = 0; q < 4; ++q) { const f32x4 v = *(const LAS f32x4*)(CUM + (16 * w + l) * CUMLD + 16 * w + 4 * q); ar[4 * q] = v[0]; ar[4 * q + 1] = v[1]; ar[4 * q + 2] = v[2]; ar[4 * q + 3] = v[3]; }
            float x[16];
#pragma unroll
            for (int i = 0; i < 16; ++i) { float xi = (i == l) ? 1.0f : 0.0f;
#pragma unroll
                for (int ip = 0; ip < i; ++ip) xi += __int_as_float(__builtin_amdgcn_readlane(__float_as_int(ar[ip]), i)) * x[ip];
                x[i] = xi; }
            if (X.lane < 16) {
#pragma unroll
                for (int i = 0; i < 16; ++i) TINV[(w * 16 + i) * 24 + l] = f2bf(x[i]); }
        }
    }
    __syncthreads(); TPROBE(5);
    {
        LAS bf16* Xt = (w < 4 ? WT + 16 * w * 72 : U0T + 16 * (w - 4) * 72);
        LAS bf16* Yw = YT + 16 * w * 24;
        const bf16x8 zf = (bf16x8){0, 0, 0, 0, 0, 0, 0, 0};
#pragma unroll
        for (int bk = 0; bk < 4; ++bk) {
            f32x4 acc = (f32x4){0.f, 0.f, 0.f, 0.f};
#pragma unroll
            for (int ks = 0; ks < (bk + 1) / 2; ++ks) {
                const bf16x8 pf = *(const LAS bf16x8*)(AABH + (16 * bk + r) * 72 + 32 * ks + 8 * g), qf = *(const LAS bf16x8*)(Xt + r * 72 + 32 * ks + 8 * g);
                acc = mfma16(pf, qf, acc); }
#pragma unroll
            for (int e = 0; e < 4; ++e) acc[e] += XB[(16 * bk + 4 * g + e) * XBLD + 16 * w + r];
            *(LAS u32x2*)(Yw + r * 24 + 4 * g) = (u32x2){cvt_pk(acc[0], acc[1]), cvt_pk(acc[2], acc[3])};
            asm volatile("s_waitcnt lgkmcnt(0)" ::: "memory");
            bf16x8 pf = zf, qf = zf;
            if (g < 2) { pf = *(const LAS bf16x8*)(TINV + (bk * 16 + r) * 24 + 8 * g); qf = *(const LAS bf16x8*)(Yw + r * 24 + 8 * g); }
            const f32x4 xs = mfma16(pf, qf, (f32x4){0.f, 0.f, 0.f, 0.f});
            *(LAS u32x2*)(Xt + r * 72 + 16 * bk + 4 * g) = (u32x2){cvt_pk(xs[0], xs[1]), cvt_pk(xs[2], xs[3])};
            asm volatile("s_waitcnt lgkmcnt(0)" ::: "memory");
        }
    }
    __syncthreads(); TPROBE(6);
    {
        bf16* out = (bf16*)(a.ws + WS_RM) + (size_t)u * 16384;
        const int q0 = 16 * (w >> 1), p0 = 32 * (w & 1), qq = q0 + r;
        f32x4 accG[2][1], accY[2][1], accM[2][1], accN[2][1]; zero_acc(accG); zero_acc(accY); zero_acc(accM); zero_acc(accN);
        mm_ll<2, 1, 2>(WT + p0 * 72, 72, ARB + q0 * 72, 72, accG, X.lane);
        mm_ll<2, 1, 2>(U0T + p0 * 72, 72, ARB + q0 * 72, 72, accY, X.lane);
        mm_ll<2, 1, 2>(VT + p0 * 72, 72, ARK + q0 * 72, 72, accY, X.lane);
        mm_ll<2, 1, 2>(WT + p0 * 72, 72, BHT + q0 * 72, 72, accM, X.lane);
        mm_ll<2, 1, 2>(BHT + p0 * 72, 72, U0T + q0 * 72, 72, accN, X.lane);
        mm_ll<2, 1, 2>(KHT + p0 * 72, 72, VT + q0 * 72, 72, accN, X.lane);
        const float gq = GC[qq];
        unsigned mw[4], nw_[4];
#pragma unroll
        for (int tp = 0; tp < 2; ++tp) { const int pp = p0 + 16 * tp + 4 * g;
            const u32x2 rtw = *(const LAS u32x2*)(RT + qq * 72 + pp);
            const f32x4 gp = *(const LAS f32x4*)(GC + pp);
            const f32x4 G4 = accG[tp][0] + (f32x4){bflo(rtw.x), bfhi(rtw.x), bflo(rtw.y), bfhi(rtw.y)};
            const f32x4 M4 = accM[tp][0] * gq, N4 = accN[tp][0] * gp;
            mw[2 * tp] = cvt_pk(M4[0], M4[1]); mw[2 * tp + 1] = cvt_pk(M4[2], M4[3]);
            nw_[2 * tp] = cvt_pk(N4[0], N4[1]); nw_[2 * tp + 1] = cvt_pk(N4[2], N4[3]);
            *(u32x2*)(out + 2 * 4096 + qq * 64 + pp) = (u32x2){cvt_pk(G4[0], G4[1]), cvt_pk(G4[2], G4[3])};
            *(u32x2*)(out + 3 * 4096 + qq * 64 + pp) = (u32x2){cvt_pk(accY[tp][0][0], accY[tp][0][1]), cvt_pk(accY[tp][0][2], accY[tp][0][3])}; }
        *(u32x4*)(out + 0 * 4096 + X.tid * 8) = (u32x4){mw[0], mw[1], mw[2], mw[3]};
        *(u32x4*)(out + 1 * 4096 + ((w >> 1) * 64 + X.lane) * 16 + (w & 1) * 8) = (u32x4){nw_[0], nw_[1], nw_[2], nw_[3]};
    }
    __syncthreads(); TPROBE(7);
}

constexpr int R2D = 4;
DI void rw2_chain(const Ctx& X, const PArgs& a, int ch) {
    const int pair = ch >> 2, it = ch & 3, r = X.lane & 15, g = X.lane >> 4, i = 16 * it + r;
    const bf16* RM = (const bf16*)(a.ws + WS_RM); bf16* RS = (bf16*)(a.ws + WS_RS);
    LAS float* GCL = (LAS float*)X.lds;
    { const f32x4* src = (const f32x4*)((const float*)(a.ws + WS_RGC) + (size_t)pair * 128 * 64);
      for (int q = X.lane; q < 2048; q += 64) *(LAS f32x4*)(GCL + 4 * q) = src[q]; }
    f32x4 acc[4];
#pragma unroll
    for (int pt = 0; pt < 4; ++pt) acc[pt] = (f32x4){0.f, 0.f, 0.f, 0.f};
    u32x4 mreg[R2D][8], nreg[R2D][2];
#define R2_LOAD(s, c) do { const bf16* M_ = RM + ((size_t)pair * 128 + (c)) * 16384; \
        _Pragma("unroll") for (int q = 0; q < 8; ++q) mreg[s][q] = *(const u32x4*)(M_ + (q * 64 + X.lane) * 8); \
        _Pragma("unroll") for (int q = 0; q < 2; ++q) nreg[s][q] = *(const u32x4*)(M_ + 4096 + (it * 64 + X.lane) * 16 + q * 8); } while (0)
#pragma unroll
    for (int s = 0; s < R2D; ++s) R2_LOAD(s, s);
    LDS_WAIT();
    for (int c0 = 0; c0 < 128; c0 += R2D) {
#pragma unroll
        for (int s = 0; s < R2D; ++s) {
            const int c = c0 + s; const size_t u = (size_t)pair * 128 + c;
            f32x4 nw[4];
#pragma unroll
            for (int pt = 0; pt < 4; ++pt) { const unsigned lo = nreg[s][pt >> 1][(pt & 1) * 2], hi = nreg[s][pt >> 1][(pt & 1) * 2 + 1];
                const f32x4 gcv = *(const LAS f32x4*)(GCL + c * 64 + 16 * pt + 4 * g);
                nw[pt] = (f32x4){bflo(lo), bfhi(lo), bflo(hi), bfhi(hi)} + gcv * acc[pt]; }
            unsigned pk[4][2];
#pragma unroll
            for (int pt = 0; pt < 4; ++pt) { pk[pt][0] = cvt_pk(acc[pt][0], acc[pt][1]); pk[pt][1] = cvt_pk(acc[pt][2], acc[pt][3]);
                *(u32x2*)(RS + u * 4096 + i * 64 + 16 * pt + 4 * g) = (u32x2){pk[pt][0], pk[pt][1]}; }
            const bf16x8 sf0 = __builtin_bit_cast(bf16x8, (u32x4){pk[0][0], pk[0][1], pk[1][0], pk[1][1]});
            const bf16x8 sf1 = __builtin_bit_cast(bf16x8, (u32x4){pk[2][0], pk[2][1], pk[3][0], pk[3][1]});
#pragma unroll
            for (int pt = 0; pt < 4; ++pt) { nw[pt] = mfma16(__builtin_bit_cast(bf16x8, mreg[s][2 * pt]), sf0, nw[pt]); nw[pt] = mfma16(__builtin_bit_cast(bf16x8, mreg[s][2 * pt + 1]), sf1, nw[pt]); acc[pt] = nw[pt]; }
            if (c + R2D < 128) R2_LOAD(s, c + R2D);
        }
    }
#undef R2_LOAD
}

#define BAR_LDS() do { asm volatile("s_waitcnt lgkmcnt(0)" ::: "memory"); __builtin_amdgcn_s_barrier(); asm volatile("" ::: "memory"); } while (0)
DI f32x4 rw_shift_raw(u32x2 cw, u32x2 pw, f32x4 m) {
    const f32x4 c = (f32x4){bflo(cw.x), bfhi(cw.x), bflo(cw.y), bfhi(cw.y)}, p = (f32x4){bflo(pw.x), bfhi(pw.x), bflo(pw.y), bfhi(pw.y)};
    return c + m * (p - c);
}
DI void rw3_wave(const Ctx& X, const PArgs& a, int u) {
    bf16* proj = (bf16*)(a.ws + WS_PROJ);
    const float* mu = a.in[8];
    const int pair = u >> 7, c = u & 127, b = pair >> 3, h = pair & 7, row0 = b * SEQ + c * 64;
    const int r = X.lane & 15, g = X.lane >> 4;
    const bf16* RMu = (const bf16*)(a.ws + WS_RM) + (size_t)u * 16384;
    const bf16* Su = (const bf16*)(a.ws + WS_RS) + (size_t)u * 4096;
    const bf16* G2 = (const bf16*)(a.ws + WS_G2T) + (size_t)h * 64 * 96;
    bf16x8 sfr[4][2], g2fr[4][3]; f32x4 gw[4], gb[4];
#pragma unroll
    for (int tp = 0; tp < 4; ++tp) {
#pragma unroll
        for (int ks = 0; ks < 2; ++ks) sfr[tp][ks] = *(const bf16x8*)(Su + (16 * tp + r) * 64 + 32 * ks + 8 * g);
#pragma unroll
        for (int ks = 0; ks < 3; ++ks) g2fr[tp][ks] = *(const bf16x8*)(G2 + (16 * tp + r) * 96 + 32 * ks + 8 * g);
        gw[tp] = *(const f32x4*)(a.in[17] + h * 64 + 16 * tp + 4 * g); gb[tp] = *(const f32x4*)(a.in[18] + h * 64 + 16 * tp + 4 * g); }
#pragma unroll 1
    for (int rb = 0; rb < 4; ++rb) {
        const int t = 16 * rb + r; const bool first = (c == 0 && t == 0);
        bf16x8 gfr[2], sg[3];
#pragma unroll
        for (int ks = 0; ks < 2; ++ks) gfr[ks] = *(const bf16x8*)(RMu + 2 * 4096 + t * 64 + 32 * ks + 8 * g);
        u32x4 gc[3], gp[3]; u32x2 vc[4], vp[4], y0[4];
#pragma unroll
        for (int ks = 0; ks < 3; ++ks) { const bf16* pg_ = proj + pj_off(row0 + t, C_GD, 192, 32 * ks + 8 * g); gc[ks] = *(const u32x4*)pg_; gp[ks] = (u32x4){0u, 0u, 0u, 0u}; if (!first) gp[ks] = *(const u32x4*)(pg_ - 192); }
#pragma unroll
        for (int tp = 0; tp < 4; ++tp) { const bf16* pv_ = proj + pj_off(row0 + t, C_RV + h * 64, 64, 16 * tp + 4 * g);
            vc[tp] = *(const u32x2*)pv_; vp[tp] = (u32x2){0u, 0u}; if (!first) vp[tp] = *(const u32x2*)(pv_ - 64);
            y0[tp] = *(const u32x2*)(RMu + 3 * 4096 + t * 64 + 16 * tp + 4 * g); }
        const float bonus = ((const float*)(a.ws + WS_BONUS))[(size_t)(row0 + t) * 8 + h];
#pragma unroll
        for (int ks = 0; ks < 3; ++ks) { const float* mp = mu + (C_GD - C_RR) + 32 * ks + 8 * g;
            const f32x4 va = rw_shift_raw((u32x2){gc[ks].x, gc[ks].y}, (u32x2){gp[ks].x, gp[ks].y}, *(const f32x4*)mp), vb = rw_shift_raw((u32x2){gc[ks].z, gc[ks].w}, (u32x2){gp[ks].z, gp[ks].w}, *(const f32x4*)(mp + 4));
            sg[ks] = __builtin_bit_cast(bf16x8, (u32x4){cvt_pk(sigmoidf_(va[0]), sigmoidf_(va[1])), cvt_pk(sigmoidf_(va[2]), sigmoidf_(va[3])), cvt_pk(sigmoidf_(vb[0]), sigmoidf_(vb[1])), cvt_pk(sigmoidf_(vb[2]), sigmoidf_(vb[3]))}); }
        f32x4 acc[4], gg[4]; float s = 0.f;
#pragma unroll
        for (int tp = 0; tp < 4; ++tp) { acc[tp] = (f32x4){bflo(y0[tp].x), bfhi(y0[tp].x), bflo(y0[tp].y), bfhi(y0[tp].y)}; gg[tp] = (f32x4){0.f, 0.f, 0.f, 0.f};
#pragma unroll
            for (int ks = 0; ks < 2; ++ks) acc[tp] = mfma16(sfr[tp][ks], gfr[ks], acc[tp]);
#pragma unroll
            for (int ks = 0; ks < 3; ++ks) gg[tp] = mfma16(g2fr[tp][ks], sg[ks], gg[tp]);
            s += (acc[tp][0] + acc[tp][1]) + (acc[tp][2] + acc[tp][3]); }
        s += __shfl_xor(s, 16); s += __shfl_xor(s, 32);
        const float mean = s * (1.0f / 64.0f); float q = 0.f;
#pragma unroll
        for (int tp = 0; tp < 4; ++tp)
#pragma unroll
            for (int e = 0; e < 4; ++e) { const float d = acc[tp][e] - mean; q += d * d; }
        q += __shfl_xor(q, 16); q += __shfl_xor(q, 32);
        const float rstd = frsq(q * (1.0f / 64.0f) + 64e-5f);
#pragma unroll
        for (int tp = 0; tp < 4; ++tp) { const int col = h * 64 + 16 * tp + 4 * g;
            const f32x4 vv = rw_shift_raw(vc[tp], vp[tp], *(const f32x4*)(mu + (C_RV - C_RR) + col));
            f32x4 o;
#pragma unroll
            for (int e = 0; e < 4; ++e) o[e] = ((acc[tp][e] - mean) * rstd * gw[tp][e] + gb[tp][e] + bonus * vv[e]) * gg[tp][e];
            *(u32x2*)((bf16*)a.out + (size_t)8 * 1024 * 1024 + (size_t)(row0 + t) * 512 + col) = (u32x2){cvt_pk(o[0], o[1]), cvt_pk(o[2], o[3])}; }
    }
}

namespace epi {
using pg8::Unit; using pg8::BM; using pg8::HALF;
struct InProj {
    static constexpr bool PERM = true, AFTER_DRAIN = false;
    bf16* proj; bf16* ga; bf16* gb;
    DI void operator()(const f32x4 (&acc)[2][2][4][2], const Unit& u, int wr, int wc, int fr, int fq) const {
        const int row0 = u.pm * BM + wr * 64 + fr;
        const bool gate = u.pn >= 15;
#pragma unroll
        for (int bj = 0; bj < 2; ++bj) {
            const int colb = u.pn * BM + bj * HALF + wc * 32 + 8 * fq;
            bf16* base; int pitch;
            if (gate) { base = (u.pn < 19 ? ga + (colb - 15 * BM) : gb + (colb - 19 * BM)); pitch = 1024; }
            else { const int ss = colb < C_RR ? (colb & ~127) : (colb < C_GD ? (colb & ~63) : C_GD); pitch = colb < C_RR ? 128 : (colb < C_GD ? 64 : 192);
                   base = proj + (size_t)ss * NTOK + (colb - ss); }
#pragma unroll
            for (int ai = 0; ai < 2; ++ai)
#pragma unroll
                for (int m = 0; m < 4; ++m) { f32x4 v0 = acc[ai][bj][m][0], v1 = acc[ai][bj][m][1];
                    if (gate) {
#pragma unroll
                        for (int e = 0; e < 4; ++e) { v0[e] = sigmoidf_(v0[e]); v1[e] = sigmoidf_(v1[e]); } }
                    *(u32x4*)(base + (size_t)(row0 + ai * HALF + m * 16) * pitch) = (u32x4){cvt_pk(v0[0], v0[1]), cvt_pk(v0[2], v0[3]), cvt_pk(v1[0], v1[1]), cvt_pk(v1[2], v1[3])}; }
        }
    }
};
template <bool ADD> struct GateMix {
    static constexpr bool PERM = true, AFTER_DRAIN = false;
    bf16* O; int ldc; const bf16* gate; int ldg;
    DI void operator()(const f32x4 (&acc)[2][2][4][2], const Unit& u, int wr, int wc, int fr, int fq) const {
        const int row0 = u.pm * BM + wr * 64 + fr, col0 = u.pn * BM + wc * 32 + 8 * fq;
#pragma unroll
        for (int ai = 0; ai < 2; ++ai)
#pragma unroll
            for (int m = 0; m < 4; ++m) { const size_t row = (size_t)(row0 + ai * HALF + m * 16);
#pragma unroll
                for (int bj = 0; bj < 2; ++bj) { const f32x4 v0 = acc[ai][bj][m][0], v1 = acc[ai][bj][m][1];
                    const u32x4 gw = *(const u32x4*)(gate + row * ldg + col0 + bj * HALF);
                    float o[8] = {v0[0] * bflo(gw.x), v0[1] * bfhi(gw.x), v0[2] * bflo(gw.y), v0[3] * bfhi(gw.y), v1[0] * bflo(gw.z), v1[1] * bfhi(gw.z), v1[2] * bflo(gw.w), v1[3] * bfhi(gw.w)};
                    bf16* op = O + row * ldc + col0 + bj * HALF;
                    if (ADD) { const u32x4 pw = *(const u32x4*)op;
                        o[0] += bflo(pw.x); o[1] += bfhi(pw.x); o[2] += bflo(pw.y); o[3] += bfhi(pw.y); o[4] += bflo(pw.z); o[5] += bfhi(pw.z); o[6] += bflo(pw.w); o[7] += bfhi(pw.w); }
                    *(u32x4*)op = (u32x4){cvt_pk(o[0], o[1]), cvt_pk(o[2], o[3]), cvt_pk(o[4], o[5]), cvt_pk(o[6], o[7])}; } }
    }
};
struct Resid {
    static constexpr bool PERM = false, AFTER_DRAIN = false;
    const float* base; float* C; const float* gt;
    DI void operator()(const f32x4 (&acc)[2][2][4][2], const Unit& u, int wr, int wc, int fr, int fq) const {
        const int row0 = u.pm * BM + wr * 64 + fr, col0 = u.pn * BM + wc * 32 + 4 * fq;
        const int b = (u.pm * BM) >> 13;
        f32x4 gv[2][2];
#pragma unroll
        for (int bj = 0; bj < 2; ++bj)
#pragma unroll
            for (int n = 0; n < 2; ++n) gv[bj][n] = *(const f32x4*)(gt + b * 6144 + col0 + bj * HALF + n * 16);
#pragma unroll
        for (int ai = 0; ai < 2; ++ai)
#pragma unroll
            for (int m = 0; m < 4; ++m) { const size_t off = (size_t)(row0 + ai * HALF + m * 16) * DM + col0;
#pragma unroll
                for (int bj = 0; bj < 2; ++bj)
#pragma unroll
                    for (int n = 0; n < 2; ++n) { const f32x4 bs = *(const f32x4*)(base + off + bj * HALF + n * 16);
                        *(f32x4*)(C + off + bj * HALF + n * 16) = bs + gv[bj][n] * acc[ai][bj][m][n]; } }
    }
};
struct SwiGlu {
    static constexpr bool PERM = true, AFTER_DRAIN = false;
    bf16* O;
    DI void operator()(const f32x4 (&acc)[2][2][4][2], const Unit& u, int wr, int wc, int fr, int fq) const {
        const int row0 = u.pm * BM + wr * 64 + fr, col0 = (u.pn & 3) * 128 + wc * 32 + 8 * fq;
#pragma unroll
        for (int ai = 0; ai < 2; ++ai)
#pragma unroll
            for (int m = 0; m < 4; ++m) { const f32x4 g0 = acc[ai][0][m][0], g1 = acc[ai][0][m][1], u0 = acc[ai][1][m][0], u1 = acc[ai][1][m][1];
                u32x4 w; w.x = cvt_pk(siluf_(g0[0]) * u0[0], siluf_(g0[1]) * u0[1]); w.y = cvt_pk(siluf_(g0[2]) * u0[2], siluf_(g0[3]) * u0[3]);
                w.z = cvt_pk(siluf_(g1[0]) * u1[0], siluf_(g1[1]) * u1[1]); w.w = cvt_pk(siluf_(g1[2]) * u1[2], siluf_(g1[3]) * u1[3]);
                *(u32x4*)(O + (size_t)(row0 + ai * HALF + m * 16) * 512 + col0) = w; }
    }
};
struct MoeOut {
    static constexpr bool PERM = true, AFTER_DRAIN = false;
    bf16* O;
    DI void operator()(const f32x4 (&acc)[2][2][4][2], const Unit& u, int wr, int wc, int fr, int fq) const {
        const int row0 = u.pm * BM + wr * 64 + fr, col0 = (u.pn & 3) * BM + wc * 32 + 8 * fq;
#pragma unroll
        for (int ai = 0; ai < 2; ++ai)
#pragma unroll
            for (int m = 0; m < 4; ++m) { bf16* rowp = O + (size_t)(row0 + ai * HALF + m * 16) * DM + col0;
#pragma unroll
                for (int bj = 0; bj < 2; ++bj) { const f32x4 v0 = acc[ai][bj][m][0], v1 = acc[ai][bj][m][1];
                    *(u32x4*)(rowp + bj * HALF) = (u32x4){cvt_pk(v0[0], v0[1]), cvt_pk(v0[2], v0[3]), cvt_pk(v1[0], v1[1]), cvt_pk(v1[2], v1[3])}; } }
    }
};
struct MoeOrder {
    const LAS int* tile_e; int ntiles, G, c;
    DI bool next(int i, Unit& u) const { const int L = i * G + c; if (L >= ntiles * 4) return false; const int pm = L >> 2; u.pm = pm; u.pn = tile_e[pm] * 4 + (L & 3); return true; }
    DI void a_ready(const Unit&) const {}
    DI void done(const Unit&) const {}
};
}

constexpr int L_TILE_E = 131072, L_PADSTART = 131072 + 1024, L_NTILES = 131072 + 1024 + 256;
DI void moe_tables(const Ctx& X, const PArgs& a) {
    LAS int* tile_e = (LAS int*)(X.lds + L_TILE_E); LAS int* pad_start = (LAS int*)(X.lds + L_PADSTART); LAS int* ntl = (LAS int*)(X.lds + L_NTILES);
    if (X.tid == 0) {
        const unsigned* cnt = (const unsigned*)(a.ws + WS_CTL) + CW_ECNT; int tiles = 0;
        for (int e = 0; e < 32; ++e) { const int n = (int)__hip_atomic_load(cnt + e, __ATOMIC_RELAXED, __HIP_MEMORY_SCOPE_AGENT); const int nt = (n + 255) >> 8;
            pad_start[e] = tiles * 256; for (int q = 0; q < nt; ++q) tile_e[tiles + q] = e; tiles += nt; }
        pad_start[32] = tiles * 256; ntl[0] = tiles;
    }
    __syncthreads();
}

DI void phase_expert_weights(const Ctx& X, const PArgs& a) {
    LAS float* scr = (LAS float*)(X.lds + X.wave * 16384);
    const int gw = X.blk * 8 + X.wave, NGW = X.nblk * 8;
    bf16* WGU = (bf16*)(a.ws + WS_EWGU); bf16* WD = (bf16*)(a.ws + WS_EWD);
    for (int it = gw; it < 3 * 8192; it += NGW) {
        const int which = it >> 13, r = it & 8191, e = r >> 8, q = r & 255;
        if (which < 2) { const int kb = q >> 4, nb = q & 15;
            transpose_item(a.in[27 + which] + (size_t)e * 1024 * 512, 512, nb * 32, kb * 64, WGU + ((size_t)e * 1024 + (nb >> 2) * 256 + which * 128 + (nb & 3) * 32) * 1024, 1024, false, scr, X.lane); }
        else { const int kb = q >> 5, nb = q & 31;
            transpose_item(a.in[29] + (size_t)e * 512 * 1024, 1024, nb * 32, kb * 64, WD + ((size_t)e * 1024 + nb * 32) * 512, 512, false, scr, X.lane); }
    }
}

DI void phase_router(const Ctx& X, const PArgs& a, bool dry = false) {
    const float* x1 = a.out;
    const bf16* WRH = (const bf16*)(a.ws + WS_WRH); const bf16* WRL = (const bf16*)(a.ws + WS_WRL); const float* CB = (const float*)(a.ws + WS_CB);
    LAS float* PLG = (LAS float*)X.lds;
    LAS float* PSS = (LAS float*)(X.lds + 24576);
    LAS int* EL = (LAS int*)(X.lds + 25088);
    LAS int* PL = (LAS int*)(X.lds + 25600);
    unsigned* cnt = (unsigned*)(a.ws + WS_CTL) + CW_ECNT;
    const int w = X.wave, r = X.lane & 15, g = X.lane >> 4, tg = w & 3, kh = w >> 2;
    for (int tb = X.blk; tb < 256; tb += X.nblk) {
        const int m = tb * 64 + 16 * tg + r, b = (tb * 64) >> 13;
        const float* xp = x1 + (size_t)m * DM + 512 * kh + 8 * g;
        const bf16* wh = WRH + ((size_t)b * 48 + r) * 1024 + 512 * kh + 8 * g; const bf16* wl = WRL + ((size_t)b * 48 + r) * 1024 + 512 * kh + 8 * g;
        f32x4 acc[3]; float ssq = 0.f;
#pragma unroll
        for (int ot = 0; ot < 3; ++ot) acc[ot] = (f32x4){0.f, 0.f, 0.f, 0.f};
#pragma unroll 4
        for (int ks = 0; ks < 16; ++ks) {
            const f32x4 xa = *(const f32x4*)(xp + 32 * ks), xb = *(const f32x4*)(xp + 32 * ks + 4);
            ssq += (xa[0] * xa[0] + xa[1] * xa[1]) + (xa[2] * xa[2] + xa[3] * xa[3]) + (xb[0] * xb[0] + xb[1] * xb[1]) + (xb[2] * xb[2] + xb[3] * xb[3]);
            const unsigned h0 = cvt_pk(xa[0], xa[1]), h1 = cvt_pk(xa[2], xa[3]), h2 = cvt_pk(xb[0], xb[1]), h3 = cvt_pk(xb[2], xb[3]);
            const unsigned l0 = cvt_pk(xa[0] - bflo(h0), xa[1] - bfhi(h0)), l1 = cvt_pk(xa[2] - bflo(h1), xa[3] - bfhi(h1)), l2 = cvt_pk(xb[0] - bflo(h2), xb[1] - bfhi(h2)), l3 = cvt_pk(xb[2] - bflo(h3), xb[3] - bfhi(h3));
            const bf16x8 ahi = __builtin_bit_cast(bf16x8, (u32x4){h0, h1, h2, h3}), alo = __builtin_bit_cast(bf16x8, (u32x4){l0, l1, l2, l3});
#pragma unroll
            for (int ot = 0; ot < 3; ++ot) {
                const bf16x8 bh = *(const bf16x8*)(wh + (size_t)ot * 16 * 1024 + 32 * ks), bl = *(const bf16x8*)(wl + (size_t)ot * 16 * 1024 + 32 * ks);
                acc[ot] = mfma16(bh, ahi, acc[ot]); acc[ot] = mfma16(bl, ahi, acc[ot]); acc[ot] = mfma16(bh, alo, acc[ot]); }
        }
        ssq += __shfl_xor(ssq, 16); ssq += __shfl_xor(ssq, 32);
        const int tl = 16 * tg + r;
#pragma unroll
        for (int ot = 0; ot < 3; ++ot) *(LAS f32x4*)(PLG + (kh * 64 + tl) * 48 + 16 * ot + 4 * g) = acc[ot];
        if (g == 0) PSS[kh * 64 + tl] = ssq;
        __syncthreads();
        if (X.tid < 64) {
            const int t = X.tid, mm = tb * 64 + t;
            const float rs = frsq((PSS[t] + PSS[64 + t]) * (1.f / DM) + 1e-6f);
            ((float*)(a.ws + WS_RSV))[mm] = rs;
            const LAS float* p0 = PLG + t * 48; const LAS float* p1 = PLG + (64 + t) * 48; const float* cb = CB + b * 48;
            float lg[4];
#pragma unroll
            for (int o = 0; o < 4; ++o) lg[o] = rs * (p0[o] + p1[o]) + cb[o];
            int gi = 0; float gm = lg[0];
#pragma unroll
            for (int o = 1; o < 4; ++o) if (lg[o] > gm) { gm = lg[o]; gi = o; }
            float gs = 0.f;
#pragma unroll
            for (int o = 0; o < 4; ++o) gs += __expf(lg[o] - gm);
            const float pgrp = 1.0f / gs;
            float sel[8];
#pragma unroll
            for (int o = 0; o < 8; ++o) sel[o] = rs * (p0[4 + gi * 8 + o] + p1[4 + gi * 8 + o]) + cb[4 + gi * 8 + o];
            int i0 = 0; float m0 = sel[0];
#pragma unroll
            for (int o = 1; o < 8; ++o) if (sel[o] > m0) { m0 = sel[o]; i0 = o; }
            int i1 = -1; float m1 = -3.0e38f;
#pragma unroll
            for (int o = 0; o < 8; ++o) if (o != i0 && sel[o] > m1) { m1 = sel[o]; i1 = o; }
            const float e1 = __expf(m1 - m0), den = 1.0f + e1;
            EL[t * 2] = gi * 8 + i0; EL[t * 2 + 1] = gi * 8 + i1;
            float* wt = (float*)(a.ws + WS_WTS) + (size_t)mm * 2; wt[0] = pgrp / den; wt[1] = pgrp * e1 / den;
        }
        __syncthreads();
        if (!dry && X.tid < 32) { int n = 0;
            for (int q = 0; q < 128; ++q) n += (EL[q] == X.tid) ? 1 : 0;
            int base = 0; if (n) base = (int)__hip_atomic_fetch_add(cnt + X.tid, (unsigned)n, __ATOMIC_RELAXED, __HIP_MEMORY_SCOPE_AGENT);
            for (int q = 0; q < 128; ++q) if (EL[q] == X.tid) PL[q] = base++; }
        __syncthreads();
        if (!dry && X.tid < 128) { ((int*)(a.ws + WS_EID))[(size_t)tb * 128 + X.tid] = EL[X.tid]; ((int*)(a.ws + WS_POS))[(size_t)tb * 128 + X.tid] = PL[X.tid]; }
        __syncthreads();
    }
}

DI void phase_gather(const Ctx& X, const PArgs& a) {
    moe_tables(X, a);
    const LAS int* pad_start = (const LAS int*)(X.lds + L_PADSTART);
    const int* EID = (const int*)(a.ws + WS_EID); const int* POS = (const int*)(a.ws + WS_POS); int* SLOT = (int*)(a.ws + WS_SLOT);
    const float* x1 = a.out; const float* RSV = (const float*)(a.ws + WS_RSV); const float* g2 = a.in[22]; const float* mod = (const float*)(a.ws + WS_MOD);
    bf16* xg = (bf16*)(a.ws + WS_XG);
    const int gw = X.blk * 8 + X.wave, NGW = X.nblk * 8;
    for (int m = gw; m < NTOK; m += NGW) {
        const int b = m >> 13; const float rs = RSV[m];
        const int d0 = pad_start[EID[2 * m]] + POS[2 * m], d1 = pad_start[EID[2 * m + 1]] + POS[2 * m + 1];
        if (X.lane == 0) { SLOT[2 * m] = d0; SLOT[2 * m + 1] = d1; }
        const f32x4* xr = (const f32x4*)(x1 + (size_t)m * DM) + X.lane;
        u32x2* o0 = (u32x2*)(xg + (size_t)d0 * DM) + X.lane; u32x2* o1 = (u32x2*)(xg + (size_t)d1 * DM) + X.lane;
#pragma unroll
        for (int j = 0; j < 4; ++j) { const int col = 4 * X.lane + 256 * j;
            const f32x4 g = *(const f32x4*)(g2 + col), sh = *(const f32x4*)(mod + b * 6144 + 3072 + col), sc = *(const f32x4*)(mod + b * 6144 + 4096 + col);
            const f32x4 y = xr[64 * j] * rs * g * (1.0f + sc) + sh;
            const u32x2 wv = (u32x2){cvt_pk(y.x, y.y), cvt_pk(y.z, y.w)}; o0[64 * j] = wv; o1[64 * j] = wv; }
    }
}

DI void phase_final(const Ctx& X, const PArgs& a, bool with_moe, bool dry = false) {
    float* out = a.out; float* dst = dry ? (float*)(a.ws + WS_HID) : a.out; const float* fg = a.in[30]; const float* mod = (const float*)(a.ws + WS_MOD);
    const int* SLOT = (const int*)(a.ws + WS_SLOT); const float* WTS = (const float*)(a.ws + WS_WTS); const bf16* Y = (const bf16*)(a.ws + WS_XG);
    const int gw = X.blk * 8 + X.wave, NGW = X.nblk * 8;
    for (int m = gw; m < NTOK; m += NGW) {
        const int b = m >> 13;
        f32x4* xr = (f32x4*)(out + (size_t)m * DM) + X.lane;
        f32x4 v[4]; float s = 0.f;
        int s0 = 0, s1 = 0; float w0 = 0.f, w1 = 0.f;
        if (with_moe) { s0 = SLOT[m * 2]; s1 = SLOT[m * 2 + 1]; w0 = WTS[m * 2]; w1 = WTS[m * 2 + 1]; }
#pragma unroll
        for (int j = 0; j < 4; ++j) { const int col = 4 * X.lane + 256 * j; v[j] = xr[64 * j];
            if (with_moe) {
                const u32x2 y0 = *(const u32x2*)(Y + (size_t)s0 * DM + col), y1 = *(const u32x2*)(Y + (size_t)s1 * DM + col);
                const f32x4 gt = *(const f32x4*)(mod + b * 6144 + 5120 + col);
                const f32x4 mo = w0 * (f32x4){bflo(y0.x), bfhi(y0.x), bflo(y0.y), bfhi(y0.y)} + w1 * (f32x4){bflo(y1.x), bfhi(y1.x), bflo(y1.y), bfhi(y1.y)};
                v[j] = v[j] + gt * mo; }
            s += (v[j].x * v[j].x + v[j].y * v[j].y) + (v[j].z * v[j].z + v[j].w * v[j].w); }
        float rs = frsq(wave_sum(s) * (1.f / DM) + 1e-6f);
#if defined(MK_TPROBE)
        { const float* T_ = (const float*)(a.ws + WS_CTL) + 32768; float tot_ = 0.f; for (int q = MK_TPG_LO; q < MK_TPG_HI; ++q) tot_ += T_[q]; rs *= (1.0f + 0.1f * T_[MK_TPROBE] / tot_); }
#endif
#pragma unroll
        for (int j = 0; j < 4; ++j) { const f32x4 g = *(const f32x4*)(fg + 4 * X.lane + 256 * j); ((f32x4*)(dst + (size_t)(dry ? (m & 4095) : m) * DM) + X.lane)[64 * j] = v[j] * rs * g; }
    }
}

#ifndef MK_DUP
#define MK_DUP 0
#endif
constexpr int NPH = 13;
template <class T> DI T* fresh_ptr(T* p) { asm volatile("" : "+s"(p)); return p; }
#define PH_ARGS const PArgs al{a.in, fresh_ptr(a.out), fresh_ptr(a.ws)}; unsigned char* ws = al.ws; (void)ws
__global__ void __launch_bounds__(512, 2) mk_fwd(Args a) {
    extern __shared__ __attribute__((aligned(16))) unsigned char lds_raw[];
    Ctx X; X.lds = (LAS unsigned char*)lds_raw; X.tid = threadIdx.x; X.lane = X.tid & 63; X.wave = __builtin_amdgcn_readfirstlane(X.tid >> 6); X.nblk = gridDim.x; X.blk = blockIdx.x;
    if (X.tid < 8) ((LAS unsigned*)(X.lds + LDS_MISC))[X.tid] = 0u;
    __syncthreads();
    XcdBarrier bar = xcd_barrier_post((unsigned*)(a.ws + WS_CTL) + CW_BAR, (volatile LAS unsigned*)(X.lds + LDS_MISC));
    const int lo = a.ph_lo, hi = a.ph_hi;
#ifndef MK_PHASE_MASK
#define MK_PHASE_MASK 0xffff
#endif
#define IN(k) (((MK_PHASE_MASK >> (k)) & 1) && lo <= (k) && (k) < hi)
#define SEAM(k) do { if (IN(k) && IN((k) + 1)) xcd_barrier(bar); } while (0)
    if (IN(0)) { PH_ARGS; phase_prologue(X, al); } SEAM(0);
    if (IN(1)) { PH_ARGS; phase_norm1(X, al); } SEAM(1);
    if (IN(2)) { PH_ARGS;
        pg8::Gemm g{(bf16*)al.out, (const bf16*)(ws + WS_WIN), NTOK, NWIN, 1024, 1024}; pg8::StaticOrder S; S.init(NTOK, NWIN, X.nblk, X.blk);
        epi::InProj E{(bf16*)(ws + WS_PROJ), (bf16*)al.out + (size_t)16 * 1024 * 1024, (bf16*)(ws + WS_GATEB)};
        pg8::gemm_phase<epi::InProj, pg8::StaticOrder>(X.lds, g, S, E, nullptr);
    } SEAM(2);
    if (IN(3)) { PH_ARGS;
        for (int rep = 0; rep < 1 + (MK_DUP & 1); ++rep) for (int u = X.blk; u < 1024; u += X.nblk) hg1_unit(X, al, u);
        for (int rep = 0; rep < 1 + ((MK_DUP >> 1) & 1); ++rep) for (int u = X.blk; u < 2048; u += X.nblk) rw1_unit(X, al, u);
    } SEAM(3);
    if (IN(4)) { PH_ARGS;
        hg2_scan(X, al);
        for (int rep = 0; rep < 1 + ((MK_DUP >> 2) & 1); ++rep) if (X.wave == 0) for (int ch = 0; ch < 64; ++ch) if ((128 + ch) % X.nblk == X.blk) rw2_chain(X, al, ch);
    } SEAM(4);
    if (IN(5)) { PH_ARGS;
        for (int u = X.blk; u < 1024; u += X.nblk) hg3_unit(X, al, u);
        for (int u = X.blk * 8 + X.wave; u < 2048; u += X.nblk * 8) rw3_wave(X, al, u);
        if ((MK_DUP >> 3) & 1) for (int u = X.blk * 8 + X.wave; u < 2048; u += X.nblk * 8) rw3_wave(X, al, u);
    } SEAM(5);
    if (IN(6)) { PH_ARGS;
        pg8::StaticOrder S; S.init(NTOK, 1024, X.nblk, X.blk);
        { pg8::Gemm g{(const bf16*)al.out, (const bf16*)(ws + WS_WPA), NTOK, 1024, 512, 512};
          epi::GateMix<false> E{(bf16*)(ws + WS_MIXED), 1024, (bf16*)al.out + (size_t)16 * 1024 * 1024, 1024};
          pg8::gemm_phase<epi::GateMix<false>, pg8::StaticOrder>(X.lds, g, S, E, nullptr); }
        __syncthreads();
        { pg8::Gemm g{(const bf16*)al.out + (size_t)8 * 1024 * 1024, (const bf16*)(ws + WS_WPB), NTOK, 1024, 512, 512};
          epi::GateMix<true> E{(bf16*)(ws + WS_MIXED), 1024, (bf16*)(ws + WS_GATEB), 1024};
          pg8::gemm_phase<epi::GateMix<true>, pg8::StaticOrder>(X.lds, g, S, E, nullptr); }
    } SEAM(6);
    if (IN(7)) { PH_ARGS;
        pg8::Gemm g{(const bf16*)(ws + WS_MIXED), (const bf16*)(ws + WS_WOUT), NTOK, 1024, 1024, 1024}; pg8::StaticOrder S; S.init(NTOK, 1024, X.nblk, X.blk);
        epi::Resid E{al.in[0], al.out, (const float*)(ws + WS_MOD) + 2048};
        pg8::gemm_phase<epi::Resid, pg8::StaticOrder>(X.lds, g, S, E, nullptr);
        __syncthreads();
        phase_expert_weights(X, al);
    } SEAM(7);
    if (IN(8)) { PH_ARGS; if ((MK_DUP >> 16) & 1) { phase_router(X, al, true); __syncthreads(); } phase_router(X, al); } SEAM(8);
    if ((MK_DUP >> 20) & 1) {
#pragma unroll 1
        for (int q = 0; q < 10; ++q) xcd_barrier(bar); }
    if (IN(9)) { PH_ARGS; phase_gather(X, al); } SEAM(9);
    if (IN(10)) { PH_ARGS;
        moe_tables(X, al);
        const int ntiles = ((const LAS int*)(X.lds + L_NTILES))[0];
        pg8::Gemm g{(const bf16*)(ws + WS_XG), (const bf16*)(ws + WS_EWGU), ntiles * 256, 32 * 1024, 1024, 1024};
        epi::MoeOrder S{(const LAS int*)(X.lds + L_TILE_E), ntiles, X.nblk, X.blk};
        epi::SwiGlu E{(bf16*)(ws + WS_HID)};
        pg8::gemm_phase<epi::SwiGlu, epi::MoeOrder>(X.lds, g, S, E, nullptr);
    } SEAM(10);
    if (IN(11)) { PH_ARGS;
        moe_tables(X, al);
        const int ntiles = ((const LAS int*)(X.lds + L_NTILES))[0];
        pg8::Gemm g{(const bf16*)(ws + WS_HID), (const bf16*)(ws + WS_EWD), ntiles * 256, 32 * 1024, 512, 512};
        epi::MoeOrder S{(const LAS int*)(X.lds + L_TILE_E), ntiles, X.nblk, X.blk};
        epi::MoeOut E{(bf16*)(ws + WS_XG)};
        pg8::gemm_phase<epi::MoeOut, epi::MoeOrder>(X.lds, g, S, E, nullptr);
    } SEAM(11);
    if (IN(12)) { PH_ARGS; phase_final(X, al, true); }
#undef IN
#undef SEAM
}

extern "C" void kernel_launch(void* const* d_in, const int* in_sizes, int n_in, void* d_out, int out_size, void* d_ws, size_t ws_size, hipStream_t stream) {
    static int grid = 0;
    if (grid == 0) {
        int dev = 0, cus = 0;
        if (n_in != 31 || out_size != NTOK * DM || ws_size < WS_END) { fprintf(stderr, "kernel_launch: unexpected shapes (n_in %d out %d ws %zu)\n", n_in, out_size, ws_size); grid = -1; return; }
        if (hipGetDevice(&dev) != hipSuccess || hipDeviceGetAttribute(&cus, hipDeviceAttributeMultiprocessorCount, dev) != hipSuccess) { grid = -1; return; }
        if (hipFuncSetAttribute((const void*)mk_fwd, hipFuncAttributeMaxDynamicSharedMemorySize, LDS_BYTES) != hipSuccess) { fprintf(stderr, "kernel_launch: hipFuncSetAttribute failed\n"); grid = -1; return; }
        int per_cu = 0;
        if (hipOccupancyMaxActiveBlocksPerMultiprocessor(&per_cu, (const void*)mk_fwd, 512, LDS_BYTES) != hipSuccess || per_cu < 1) fprintf(stderr, "kernel_launch: occupancy query reports %d\n", per_cu);
        (void)hipGetLastError();
        grid = cus;
    }
    if (grid < 0) return;
    (void)hipMemsetAsync((char*)d_ws + WS_CTL, 0, CTL_ZERO_BYTES, stream);
    Args a{};
    for (int i = 0; i < 31; ++i) a.in[i] = (const float*)d_in[i];
    a.out = (float*)d_out; a.ws = (unsigned char*)d_ws;
#if MK_ONE_LAUNCH
    a.ph_lo = 0; a.ph_hi = NPH;
    hipLaunchKernelGGL(mk_fwd, dim3(grid), dim3(512), LDS_BYTES, stream, a);
#else
    for (int ph = 0; ph < NPH; ++ph) {
        a.ph_lo = ph; a.ph_hi = ph + 1;
        hipLaunchKernelGGL(mk_fwd, dim3(grid), dim3(512), LDS_BYTES, stream, a);
    }
#endif
}
```

```cpp
#define MK_ONE_LAUNCH 1
#include <hip/hip_runtime.h>
#include <stdint.h>
#include <stdio.h>

#ifndef MK_ONE_LAUNCH
#define MK_ONE_LAUNCH 0
#endif
#ifndef MK_LAST_PHASE
#define MK_LAST_PHASE 99
#endif

#define DI __device__ __forceinline__
#define LAS __attribute__((address_space(3)))
typedef unsigned short bf16;
typedef short bf16x8 __attribute__((ext_vector_type(8)));
typedef float f32x4 __attribute__((ext_vector_type(4)));
typedef float f32x2 __attribute__((ext_vector_type(2)));
typedef unsigned u32x4 __attribute__((ext_vector_type(4)));
typedef unsigned u32x2 __attribute__((ext_vector_type(2)));

constexpr int NTOK = 16384, DM = 1024, SEQ = 8192;
constexpr int LDP = 3840;
constexpr int NWIN = 5888;
constexpr int C_HQ = 0, C_HF = 512, C_HI = 1024, C_HG = 1536, C_RR = 2048, C_RK = 2560, C_RV = 3072, C_WD = 3584, C_AD = 3616, C_GD = 3648;
DI size_t pj_off(int row, int sec_start, int width, int c) { return (size_t)sec_start * NTOK + (size_t)row * width + c; }
constexpr int MOE_PMAX = 40960;

constexpr size_t MiB = 1u << 20;
constexpr size_t WS_CTL = 0, CTL_ZERO_BYTES = 1 * MiB;
constexpr size_t WS_MOD = 1 * MiB;
constexpr size_t WS_SLOT = 1 * MiB + 64 * 1024;
constexpr size_t WS_WTS = WS_SLOT + 128 * 1024;
constexpr size_t WS_EID = WS_WTS + 128 * 1024;
constexpr size_t WS_POS = WS_EID + 128 * 1024;
constexpr size_t WS_RSV = WS_POS + 128 * 1024;
constexpr size_t WS_BONUS = 2 * MiB;
constexpr size_t WS_HGC = 2 * MiB + 512 * 1024;
constexpr size_t WS_RGC = 3 * MiB;
constexpr size_t WS_WRH = 3 * MiB + 512 * 1024;
constexpr size_t WS_WRL = WS_WRH + 196608;
constexpr size_t WS_CB = WS_WRL + 196608;
constexpr size_t WS_G2T = WS_CB + 1024;
constexpr size_t WS_WIN = 4 * MiB;
constexpr size_t WS_WPA = 16 * MiB, WS_WPB = 17 * MiB, WS_WOUT = 18 * MiB;
constexpr size_t WS_PROJ = 20 * MiB;
constexpr size_t WS_HS = 140 * MiB;
constexpr size_t WS_RM = 172 * MiB;
constexpr size_t WS_RS = 236 * MiB;
constexpr size_t WS_MIXED = 204 * MiB;
constexpr size_t WS_EWGU = 20 * MiB;
constexpr size_t WS_EWD = 84 * MiB;
constexpr size_t WS_XG = 116 * MiB;
constexpr size_t WS_HID = 196 * MiB;
constexpr size_t WS_GATEB = 252 * MiB;
constexpr size_t WS_H2 = 236 * MiB;
constexpr size_t WS_TOKL = 268 * MiB;
constexpr size_t WS_END = 284 * MiB;
constexpr int CW_BAR = 4096, CW_ECNT = 16384;

constexpr int LDS_BYTES = 163840;
constexpr int LDS_MISC = 163840 - 256;

typedef __bf16 bf16x2_t __attribute__((ext_vector_type(2)));
DI unsigned cvt_pk(float lo, float hi) { bf16x2_t v = {(__bf16)lo, (__bf16)hi}; return __builtin_bit_cast(unsigned, v); }
DI bf16 f2bf(float x) { return (bf16)(cvt_pk(x, 0.f) & 0xffffu); }
DI float bf2f(bf16 b) { return __uint_as_float(((unsigned)b) << 16); }
DI float bflo(unsigned w) { return __uint_as_float(w << 16); }
DI float bfhi(unsigned w) { return __uint_as_float(w & 0xffff0000u); }
DI float frcp(float x) { return __builtin_amdgcn_rcpf(x); }
DI float frsq(float x) { return __builtin_amdgcn_rsqf(x); }
DI float sigmoidf_(float x) { return frcp(1.0f + __expf(-x)); }
DI float siluf_(float x) { return x * frcp(1.0f + __expf(-x)); }
DI float wave_sum(float v) {
#pragma unroll
    for (int o = 1; o < 64; o <<= 1) v += __shfl_xor(v, o);
    return v;
}
DI f32x4 mfma16(bf16x8 a, bf16x8 b, f32x4 c) { return __builtin_amdgcn_mfma_f32_16x16x32_bf16(a, b, c, 0, 0, 0); }
#define LDS_WAIT() asm volatile("s_waitcnt lgkmcnt(0)" ::: "memory")
#define VM_WAIT() asm volatile("s_waitcnt vmcnt(0)" ::: "memory")

template <int TP, int TQ, int KS>
DI void mm_ll(const LAS bf16* P, int ldp, const LAS bf16* Q, int ldq, f32x4 (&acc)[TP][TQ], int lane) {
    const int r = lane & 15, g = lane >> 4;
#pragma unroll
    for (int ks = 0; ks < KS; ++ks) {
        bf16x8 pf[TP], qf[TQ];
#pragma unroll
        for (int tp = 0; tp < TP; ++tp) pf[tp] = *(const LAS bf16x8*)(P + (tp * 16 + r) * ldp + ks * 32 + g * 8);
#pragma unroll
        for (int tq = 0; tq < TQ; ++tq) qf[tq] = *(const LAS bf16x8*)(Q + (tq * 16 + r) * ldq + ks * 32 + g * 8);
#pragma unroll
        for (int tp = 0; tp < TP; ++tp)
#pragma unroll
            for (int tq = 0; tq < TQ; ++tq) acc[tp][tq] = mfma16(pf[tp], qf[tq], acc[tp][tq]);
    }
}
template <int TP, int TQ, int KS>
DI void mm_gl(const bf16* P, int ldp, const LAS bf16* Q, int ldq, f32x4 (&acc)[TP][TQ], int lane) {
    const int r = lane & 15, g = lane >> 4;
#pragma unroll
    for (int ks = 0; ks < KS; ++ks) {
        bf16x8 pf[TP], qf[TQ];
#pragma unroll
        for (int tp = 0; tp < TP; ++tp) pf[tp] = *(const bf16x8*)(P + (size_t)(tp * 16 + r) * ldp + ks * 32 + g * 8);
#pragma unroll
        for (int tq = 0; tq < TQ; ++tq) qf[tq] = *(const LAS bf16x8*)(Q + (tq * 16 + r) * ldq + ks * 32 + g * 8);
#pragma unroll
        for (int tp = 0; tp < TP; ++tp)
#pragma unroll
            for (int tq = 0; tq < TQ; ++tq) acc[tp][tq] = mfma16(pf[tp], qf[tq], acc[tp][tq]);
    }
}
template <int TP, int TQ, int KS>
DI void mm_gg(const bf16* P, int ldp, const bf16* Q, int ldq, f32x4 (&acc)[TP][TQ], int lane) {
    const int r = lane & 15, g = lane >> 4;
#pragma unroll
    for (int ks = 0; ks < KS; ++ks) {
        bf16x8 pf[TP], qf[TQ];
#pragma unroll
        for (int tp = 0; tp < TP; ++tp) pf[tp] = *(const bf16x8*)(P + (size_t)(tp * 16 + r) * ldp + ks * 32 + g * 8);
#pragma unroll
        for (int tq = 0; tq < TQ; ++tq) qf[tq] = *(const bf16x8*)(Q + (size_t)(tq * 16 + r) * ldq + ks * 32 + g * 8);
#pragma unroll
        for (int tp = 0; tp < TP; ++tp)
#pragma unroll
            for (int tq = 0; tq < TQ; ++tq) acc[tp][tq] = mfma16(pf[tp], qf[tq], acc[tp][tq]);
    }
}
template <int A, int B> DI void zero_acc(f32x4 (&acc)[A][B]) {
#pragma unroll
    for (int a = 0; a < A; ++a)
#pragma unroll
        for (int b = 0; b < B; ++b) acc[a][b] = (f32x4){0.f, 0.f, 0.f, 0.f};
}
namespace pg8 {
#define PG8_LAS __attribute__((address_space(3)))
typedef unsigned short bf16_t;
typedef short bf16x8 __attribute__((ext_vector_type(8)));
typedef float f32x4 __attribute__((ext_vector_type(4)));
typedef unsigned u32x4 __attribute__((ext_vector_type(4)));
constexpr int BM = 256, BK = 64, HALF = 128, HTB = HALF * BK * 2  , STAGE_BYTES = 8 * HTB, NXCD = 8, WGM = 8;

__host__ __device__ __forceinline__ int lds_byte(int r, int c) { const int st = (r >> 4) * 2 + (c >> 5), rr = r & 15, cc = c & 31, ob = rr * 64 + cc * 2; return st * 1024 + (ob ^ (((ob >> 9) & 1) << 5)); }
__host__ __device__ __forceinline__ void stage_rc(int b, int& R, int& C) { const int st = b / 1024, sb = b % 1024, swz = sb ^ (((sb >> 9) & 1) << 5); R = (st >> 1) * 16 + swz / 64; C = (st & 1) * 32 + (swz % 64) / 2; }
__host__ __device__ __forceinline__ int perm32(int rho) { const int n = rho >> 4, i = rho & 15; return 8 * (i >> 2) + 4 * n + (i & 3); }

struct Unit { int pm, pn; };
struct Gemm { const bf16_t* A; const bf16_t* Bt; int M, N, K, lda; };

struct StaticOrder {
    int nM, nN, nwg, G, c;
    __host__ __device__ void init(int M, int N, int G_, int c_) { nM = M / BM; nN = N / BM; nwg = nM * nN; G = G_; c = c_; }
    __host__ __device__ bool next(int i, Unit& u) const {
        const long L = (long)i * G + c; if (L >= nwg) return false;
        int wgid = (int)L; { const int q = nwg / NXCD, r = nwg % NXCD, xcd = wgid % NXCD, off = wgid / NXCD; wgid = (xcd < r ? xcd * (q + 1) : r * (q + 1) + (xcd - r) * q) + off; }
        const int nig = WGM * nN, gid = wgid / nig, fm = gid * WGM, gsz = (nM - fm) < WGM ? (nM - fm) : WGM;
        u.pm = fm + ((wgid % nig) % gsz); u.pn = (wgid % nig) / gsz; return true;
    }
    __device__ __forceinline__ void a_ready(const Unit&) const {}
    __device__ __forceinline__ void done(const Unit&) const {}
};
struct CountedOrder : StaticOrder {
    const unsigned* ready; unsigned need; unsigned* tmo;
    __device__ __forceinline__ void a_ready(const Unit& u) const {
        if (threadIdx.x < 64) {
            const unsigned long long t0 = __builtin_amdgcn_s_memrealtime(); unsigned polls = 0;
            while ((unsigned)__builtin_amdgcn_readfirstlane(__hip_atomic_load(ready + 64 * u.pm, __ATOMIC_RELAXED, __HIP_MEMORY_SCOPE_AGENT)) < need) {
                if ((++polls & 255u) == 0u && __builtin_amdgcn_readfirstlane(__hip_atomic_load(tmo, __ATOMIC_RELAXED, __HIP_MEMORY_SCOPE_AGENT)) != 0u) break;
                if (__builtin_amdgcn_s_memrealtime() - t0 > 2000000ull) {
                    if (threadIdx.x == 0) { unsigned expect = 0u; __hip_atomic_compare_exchange_strong(tmo + 1, &expect, 0x600u | (unsigned)(u.pm & 0xff), __ATOMIC_RELAXED, __ATOMIC_RELAXED, __HIP_MEMORY_SCOPE_AGENT); __hip_atomic_store(tmo, 1u, __ATOMIC_RELAXED, __HIP_MEMORY_SCOPE_AGENT); }
                    break; }
                __builtin_amdgcn_s_sleep(2); }
            __builtin_amdgcn_fence(__ATOMIC_ACQUIRE, "agent");
            asm volatile("s_waitcnt vmcnt(0)" ::: "memory");
        }
#if !defined(BROKEN_HOOK_NO_BARRIER)
        asm volatile("" ::: "memory"); __builtin_amdgcn_s_barrier(); asm volatile("" ::: "memory");
#endif
    }
};

__device__ __forceinline__ unsigned cvt_pk_bf16(float lo, float hi) { return ::cvt_pk(lo, hi); }
typedef float f32x2 __attribute__((ext_vector_type(2)));
__device__ __forceinline__ f32x2 gelu_pk(f32x2 v) {
    const f32x2 av = __builtin_elementwise_abs(v), d = av * 0.2316418882f + 1.0f;
    f32x2 t; t.x = __builtin_amdgcn_rcpf(d.x); t.y = __builtin_amdgcn_rcpf(d.y);
    f32x2 q = t * 0.5307027145f + (-0.7265760135f); q = q * t + 0.7107068705f; q = q * t + (-0.142248368f); q = q * t + 0.127414796f; q = q * t;
    const f32x2 s = (v * v) * (-0.72134752044f);
    f32x2 e; e.x = __builtin_amdgcn_exp2f(s.x); e.y = __builtin_amdgcn_exp2f(s.y);
    const f32x2 m = v * (q * e), r = v - m;
    f32x2 o; o.x = v.x < 0.f ? m.x : r.x; o.y = v.y < 0.f ? m.y : r.y; return o;
}

struct EpiF32 {
    static constexpr bool PERM = false, AFTER_DRAIN = false;
    float* C; int ldc; const float* bias;
    __device__ __forceinline__ void operator()(const f32x4 (&acc)[2][2][4][2], const Unit& u, int wr, int wc, int fr, int fq) const {
        const int row0 = u.pm * BM + wr * 64 + fr, col0 = u.pn * BM + wc * 32 + 4 * fq;
        f32x4 bv[2][2];
#pragma unroll
        for (int bj = 0; bj < 2; ++bj)
#pragma unroll
            for (int n = 0; n < 2; ++n) bv[bj][n] = bias ? *(const f32x4*)(bias + col0 + bj * HALF + n * 16) : (f32x4){0.f, 0.f, 0.f, 0.f};
#pragma unroll
        for (int ai = 0; ai < 2; ++ai)
#pragma unroll
            for (int m = 0; m < 4; ++m) { float* rowp = C + (size_t)(row0 + ai * HALF + m * 16) * ldc + col0;
#pragma unroll
                for (int bj = 0; bj < 2; ++bj)
#pragma unroll
                    for (int n = 0; n < 2; ++n) *(f32x4*)(rowp + bj * HALF + n * 16) = acc[ai][bj][m][n] + bv[bj][n]; }
    }
};
template <int ACT  > struct EpiBf16 {
    static constexpr bool PERM = true, AFTER_DRAIN = false;
    bf16_t* O; int ldc; const float* bias; int split_cols; size_t split_stride;
    __device__ __forceinline__ void operator()(const f32x4 (&acc)[2][2][4][2], const Unit& u, int wr, int wc, int fr, int fq) const {
        const int row0 = u.pm * BM + wr * 64 + fr; int colt = u.pn * BM; bf16_t* base = O;
        if (split_cols) { const int t = colt / split_cols; base += (size_t)t * split_stride; colt -= t * split_cols; }
        const int col0 = colt + wc * 32 + 8 * fq, bcol0 = u.pn * BM + wc * 32 + 8 * fq;
        f32x4 bv[2][2];
#pragma unroll
        for (int bj = 0; bj < 2; ++bj)
#pragma unroll
            for (int n = 0; n < 2; ++n) bv[bj][n] = bias ? *(const f32x4*)(bias + bcol0 + bj * HALF + 4 * n) : (f32x4){0.f, 0.f, 0.f, 0.f};
#pragma unroll
        for (int ai = 0; ai < 2; ++ai)
#pragma unroll
            for (int m = 0; m < 4; ++m) { bf16_t* rowp = base + (size_t)(row0 + ai * HALF + m * 16) * ldc + col0;
#pragma unroll
                for (int bj = 0; bj < 2; ++bj) { f32x4 v0 = acc[ai][bj][m][0] + bv[bj][0], v1 = acc[ai][bj][m][1] + bv[bj][1];
                    if (ACT == 1) { f32x2 a = gelu_pk((f32x2){v0[0], v0[1]}), b = gelu_pk((f32x2){v0[2], v0[3]}), c = gelu_pk((f32x2){v1[0], v1[1]}), d = gelu_pk((f32x2){v1[2], v1[3]});
                        v0 = (f32x4){a.x, a.y, b.x, b.y}; v1 = (f32x4){c.x, c.y, d.x, d.y}; }
                    if (ACT == 2) {
#pragma unroll
                        for (int j = 0; j < 4; ++j) { v0[j] = 0.5f * v0[j] * (1.0f + erff(v0[j] * 0.70710678f)); v1[j] = 0.5f * v1[j] * (1.0f + erff(v1[j] * 0.70710678f)); } }
                    u32x4 w; w.x = cvt_pk_bf16(v0[0], v0[1]); w.y = cvt_pk_bf16(v0[2], v0[3]); w.z = cvt_pk_bf16(v1[0], v1[1]); w.w = cvt_pk_bf16(v1[2], v1[3]);
                    *(u32x4*)(rowp + bj * HALF) = w; } }
    }
};
template <class Epi, class Sched, bool STAMP = false>
__device__ __forceinline__ void gemm_phase(PG8_LAS unsigned char* lds, const Gemm g, const Sched& S, const Epi& E, unsigned long long* stamps) {
    const int tid = threadIdx.x, wid = __builtin_amdgcn_readfirstlane(tid >> 6), lane = tid & 63, wr = wid >> 2, wc = wid & 3, fr = lane & 15, fq = lane >> 4;
    const int K = g.K, nt = K / BK;
    int ts_lo = 0, ts_hi = 0, nts = 0; const unsigned long long rt_entry = STAMP ? (unsigned long long)wall_clock64() : 0ull;
#define PG8_STAMP() do { if (STAMP && wid == 0 && nts < 64) { const unsigned long long _c = (unsigned long long)clock64(); \
        ts_lo = (lane == nts) ? (int)(unsigned)_c : ts_lo; ts_hi = (lane == nts) ? (int)(unsigned)(_c >> 32) : ts_hi; ++nts; } } while (0)
    PG8_STAMP();
    unsigned voffA[2], voffB[2];
#pragma unroll
    for (int i = 0; i < 2; ++i) { int R, C; stage_rc(tid * 16 + i * 8192, R, C); const int Rb = Epi::PERM ? ((R & ~31) + perm32(R & 31)) : R;
        voffA[i] = (unsigned)(R * g.lda + C) * 2u; voffB[i] = (unsigned)(Rb * K + C) * 2u; }
    const size_t kstep = (size_t)(BK * 2);
    const size_t hstep = (size_t)HALF * K * 2;
    const size_t tstep = 2 * hstep; const size_t hstepA = (size_t)HALF * g.lda * 2, tstepA = 2 * hstepA;
    const unsigned ldsw = (unsigned)wid * 1024u;
    const int aoff = lds_byte(wr * 64 + fr, fq * 8), boff = lds_byte(wc * 32 + fr, fq * 8);
#define PG8_SA(b, h) (((b) * 2 + (h)) * HTB)
#define PG8_SB(b, h) ((4 + (b) * 2 + (h)) * HTB)
#define PG8_STAGE(bufoff, gbase, voff) do { _Pragma("unroll") for (int _i = 0; _i < 2; ++_i) \
        __builtin_amdgcn_global_load_lds((const unsigned*)((const char*)(gbase) + (voff)[_i]), (PG8_LAS unsigned*)(lds + (bufoff) + ldsw + _i * 8192), 16, 0, 0); } while (0)
#define PG8_LDA(dst, b, h) do { _Pragma("unroll") for (int m = 0; m < 4; ++m) _Pragma("unroll") for (int k = 0; k < 2; ++k) dst[m][k] = *(const PG8_LAS bf16x8*)(lds + PG8_SA(b, h) + aoff + m * 2048 + k * 1024); } while (0)
#define PG8_LDB(dst, b, h) do { _Pragma("unroll") for (int n = 0; n < 2; ++n) _Pragma("unroll") for (int k = 0; k < 2; ++k) dst[n][k] = *(const PG8_LAS bf16x8*)(lds + PG8_SB(b, h) + boff + n * 2048 + k * 1024); } while (0)
#define PG8_MMA(ai, bj, At, Bt) do { __builtin_amdgcn_s_setprio(1); _Pragma("unroll") for (int m = 0; m < 4; ++m) _Pragma("unroll") for (int n = 0; n < 2; ++n) _Pragma("unroll") for (int k = 0; k < 2; ++k) \
        acc[ai][bj][m][n] = __builtin_amdgcn_mfma_f32_16x16x32_bf16(Bt[n][k], At[m][k], acc[ai][bj][m][n], 0, 0, 0); __builtin_amdgcn_s_setprio(0); } while (0)
#define PG8_WAIT_V(n) asm volatile("s_waitcnt vmcnt(" #n ")" ::: "memory")
#define PG8_WAIT_L(n) asm volatile("s_waitcnt lgkmcnt(" #n ")" ::: "memory")
#define PG8_BAR __builtin_amdgcn_s_barrier()
#define PG8_SCHED __builtin_amdgcn_sched_barrier(0)
    Unit cur, nxt; int ui = 0;
    if (!S.next(0, cur)) return;
    f32x4 acc[2][2][4][2];
#pragma unroll
    for (int a = 0; a < 2; ++a)
#pragma unroll
        for (int b = 0; b < 2; ++b)
#pragma unroll
            for (int m = 0; m < 4; ++m)
#pragma unroll
                for (int n = 0; n < 2; ++n) acc[a][b][m][n] = (f32x4){0.f, 0.f, 0.f, 0.f};
    bf16x8 At[4][2], B0[2][2], B1[2][2];
    const char* cA = (const char*)g.A + (size_t)cur.pm * tstepA; const char* cB = (const char*)g.Bt + (size_t)cur.pn * tstep;
    S.a_ready(cur);
    PG8_STAGE(PG8_SB(0, 0), cB, voffB); PG8_STAGE(PG8_SA(0, 0), cA, voffA); PG8_STAGE(PG8_SB(0, 1), cB + hstep, voffB); PG8_STAGE(PG8_SA(0, 1), cA + hstepA, voffA);
    if (wr == 1) PG8_BAR;
    PG8_WAIT_V(4); PG8_BAR;
    PG8_STAGE(PG8_SB(1, 0), cB + kstep, voffB); PG8_STAGE(PG8_SA(1, 0), cA + kstep, voffA); PG8_STAGE(PG8_SB(1, 1), cB + hstep + kstep, voffB);
    PG8_WAIT_V(6); PG8_BAR;
    PG8_STAMP();
    for (;;) {
        const bool has_next = S.next(ui + 1, nxt);
        const char* nA = has_next ? (const char*)g.A + (size_t)nxt.pm * tstepA : cA; const char* nB = has_next ? (const char*)g.Bt + (size_t)nxt.pn * tstep : cB;
        for (int t = 0; t < nt; t += 2) {
            const bool last = (t == nt - 2);
            const char* a1 = cA + (size_t)(t + 1) * kstep;
            const char* a2 = last ? nA : cA + (size_t)(t + 2) * kstep; const char* b2 = last ? nB : cB + (size_t)(t + 2) * kstep;
            const char* a3 = a2 + kstep; const char* b3 = b2 + kstep;
            if (last && has_next) S.a_ready(nxt);
            PG8_LDB(B0, 0, 0); PG8_SCHED; PG8_LDA(At, 0, 0); PG8_STAGE(PG8_SA(1, 1), a1 + hstepA, voffA);
            PG8_WAIT_L(8); PG8_BAR; PG8_WAIT_L(0); PG8_MMA(0, 0, At, B0); PG8_BAR; PG8_SCHED;
            PG8_LDB(B1, 0, 1); PG8_STAGE(PG8_SB(0, 0), b2, voffB);
            PG8_BAR; PG8_WAIT_L(0); PG8_MMA(0, 1, At, B1); PG8_BAR;
            PG8_LDA(At, 0, 1); PG8_STAGE(PG8_SA(0, 0), a2, voffA);
            PG8_BAR; PG8_WAIT_L(0); PG8_MMA(1, 0, At, B0); PG8_BAR; PG8_SCHED;
            PG8_STAGE(PG8_SB(0, 1), b2 + hstep, voffB);
            PG8_WAIT_V(6); PG8_BAR; PG8_MMA(1, 1, At, B1); PG8_BAR;
            PG8_LDB(B0, 1, 0); PG8_SCHED; PG8_LDA(At, 1, 0); PG8_STAGE(PG8_SA(0, 1), a2 + hstepA, voffA);
            PG8_WAIT_L(8); PG8_BAR; PG8_WAIT_L(0); PG8_MMA(0, 0, At, B0); PG8_BAR; PG8_SCHED;
            PG8_LDB(B1, 1, 1); PG8_STAGE(PG8_SB(1, 0), b3, voffB);
            PG8_BAR; PG8_WAIT_L(0); PG8_MMA(0, 1, At, B1); PG8_BAR;
            PG8_LDA(At, 1, 1); PG8_STAGE(PG8_SA(1, 0), a3, voffA);
            PG8_BAR; PG8_WAIT_L(0); PG8_MMA(1, 0, At, B0); PG8_BAR; PG8_SCHED;
            PG8_STAGE(PG8_SB(1, 1), b3 + hstep, voffB);
            PG8_WAIT_V(6); PG8_BAR; PG8_MMA(1, 1, At, B1); PG8_BAR;
        }
        PG8_STAMP();
        if constexpr (!Epi::AFTER_DRAIN) { E(acc, cur, wr, wc, fr, fq); S.done(cur); }
        PG8_STAMP();
        if (!has_next) break;
#pragma unroll
        for (int a = 0; a < 2; ++a)
#pragma unroll
            for (int b = 0; b < 2; ++b)
#pragma unroll
                for (int m = 0; m < 4; ++m)
#pragma unroll
                    for (int n = 0; n < 2; ++n) acc[a][b][m][n] = (f32x4){0.f, 0.f, 0.f, 0.f};
        cur = nxt; cA = nA; cB = nB; ++ui;
    }
    PG8_WAIT_V(0);
    if (wr == 0) PG8_BAR;
    PG8_BAR;
    if constexpr (Epi::AFTER_DRAIN) { E.fused(acc, cur, wr, wc, fr, fq, lds, wid, lane); S.done(cur); }
    PG8_STAMP();
    if (STAMP && wid == 0) { stamps[lane] = lane < nts ? (((unsigned long long)(unsigned)ts_hi << 32) | (unsigned)ts_lo) : 0ull;
        if (lane == 62) stamps[62] = rt_entry; if (lane == 63) stamps[63] = (unsigned long long)wall_clock64(); }
#undef PG8_STAMP
#undef PG8_SA
#undef PG8_SB
#undef PG8_STAGE
#undef PG8_LDA
#undef PG8_LDB
#undef PG8_MMA
#undef PG8_WAIT_V
#undef PG8_WAIT_L
#undef PG8_BAR
#undef PG8_SCHED
}
template <class Epi, class Sched, bool STAMP = false>
__device__ __forceinline__ void gemm_phase_gather(PG8_LAS unsigned char* lds, const Gemm g, const Sched& S, const Epi& E, unsigned long long* stamps) {
    const int tid = threadIdx.x, wid = __builtin_amdgcn_readfirstlane(tid >> 6), lane = tid & 63, wr = wid >> 2, wc = wid & 3, fr = lane & 15, fq = lane >> 4;
    const int K = g.K, nt = K / BK;
    int ts_lo = 0, ts_hi = 0, nts = 0; const unsigned long long rt_entry = STAMP ? (unsigned long long)wall_clock64() : 0ull;
#define PG8_STAMP() do { if (STAMP && wid == 0 && nts < 64) { const unsigned long long _c = (unsigned long long)clock64(); \
        ts_lo = (lane == nts) ? (int)(unsigned)_c : ts_lo; ts_hi = (lane == nts) ? (int)(unsigned)(_c >> 32) : ts_hi; ++nts; } } while (0)
    PG8_STAMP();
    unsigned cvA[2][2], nvA[2][2], voffB[2]; int pieceR[2], pieceC[2];
#pragma unroll
    for (int i = 0; i < 2; ++i) { int R, C; stage_rc(tid * 16 + i * 8192, R, C); const int Rb = Epi::PERM ? ((R & ~31) + perm32(R & 31)) : R;
        pieceR[i] = R; pieceC[i] = C; voffB[i] = (unsigned)(Rb * K + C) * 2u; }
#define PG8_ROWOFF(dst, unit) do { _Pragma("unroll") for (int _h = 0; _h < 2; ++_h) _Pragma("unroll") for (int _i = 0; _i < 2; ++_i) dst[_h][_i] = ((unsigned)S.row_of(unit, _h * HALF + pieceR[_i]) * (unsigned)g.lda + (unsigned)pieceC[_i]) * 2u; } while (0)
    const size_t kstep = (size_t)(BK * 2);
    const size_t hstep = (size_t)HALF * K * 2;
    const size_t tstep = 2 * hstep; const size_t hstepA = (size_t)HALF * g.lda * 2, tstepA = 2 * hstepA;
    const unsigned ldsw = (unsigned)wid * 1024u;
    const int aoff = lds_byte(wr * 64 + fr, fq * 8), boff = lds_byte(wc * 32 + fr, fq * 8);
#define PG8_SA(b, h) (((b) * 2 + (h)) * HTB)
#define PG8_SB(b, h) ((4 + (b) * 2 + (h)) * HTB)
#define PG8_STAGE(bufoff, gbase, voff) do { _Pragma("unroll") for (int _i = 0; _i < 2; ++_i) \
        __builtin_amdgcn_global_load_lds((const unsigned*)((const char*)(gbase) + (voff)[_i]), (PG8_LAS unsigned*)(lds + (bufoff) + ldsw + _i * 8192), 16, 0, 0); } while (0)
#define PG8_LDA(dst, b, h) do { _Pragma("unroll") for (int m = 0; m < 4; ++m) _Pragma("unroll") for (int k = 0; k < 2; ++k) dst[m][k] = *(const PG8_LAS bf16x8*)(lds + PG8_SA(b, h) + aoff + m * 2048 + k * 1024); } while (0)
#define PG8_LDB(dst, b, h) do { _Pragma("unroll") for (int n = 0; n < 2; ++n) _Pragma("unroll") for (int k = 0; k < 2; ++k) dst[n][k] = *(const PG8_LAS bf16x8*)(lds + PG8_SB(b, h) + boff + n * 2048 + k * 1024); } while (0)
#define PG8_MMA(ai, bj, At, Bt) do { __builtin_amdgcn_s_setprio(1); _Pragma("unroll") for (int m = 0; m < 4; ++m) _Pragma("unroll") for (int n = 0; n < 2; ++n) _Pragma("unroll") for (int k = 0; k < 2; ++k) \
        acc[ai][bj][m][n] = __builtin_amdgcn_mfma_f32_16x16x32_bf16(Bt[n][k], At[m][k], acc[ai][bj][m][n], 0, 0, 0); __builtin_amdgcn_s_setprio(0); } while (0)
#define PG8_WAIT_V(n) asm volatile("s_waitcnt vmcnt(" #n ")" ::: "memory")
#define PG8_WAIT_L(n) asm volatile("s_waitcnt lgkmcnt(" #n ")" ::: "memory")
#define PG8_BAR __builtin_amdgcn_s_barrier()
#define PG8_SCHED __builtin_amdgcn_sched_barrier(0)
    Unit cur, nxt; int ui = 0;
    if (!S.next(0, cur)) return;
    f32x4 acc[2][2][4][2];
#pragma unroll
    for (int a = 0; a < 2; ++a)
#pragma unroll
        for (int b = 0; b < 2; ++b)
#pragma unroll
            for (int m = 0; m < 4; ++m)
#pragma unroll
                for (int n = 0; n < 2; ++n) acc[a][b][m][n] = (f32x4){0.f, 0.f, 0.f, 0.f};
    bf16x8 At[4][2], B0[2][2], B1[2][2];
    const char* cA = (const char*)g.A; const char* cB = (const char*)g.Bt + (size_t)cur.pn * tstep;
    PG8_ROWOFF(cvA, cur);
    S.a_ready(cur);
    PG8_STAGE(PG8_SB(0, 0), cB, voffB); PG8_STAGE(PG8_SA(0, 0), cA, cvA[0]); PG8_STAGE(PG8_SB(0, 1), cB + hstep, voffB); PG8_STAGE(PG8_SA(0, 1), cA, cvA[1]);
    if (wr == 1) PG8_BAR;
    PG8_WAIT_V(4); PG8_BAR;
    PG8_STAGE(PG8_SB(1, 0), cB + kstep, voffB); PG8_STAGE(PG8_SA(1, 0), cA + kstep, cvA[0]); PG8_STAGE(PG8_SB(1, 1), cB + hstep + kstep, voffB);
    PG8_WAIT_V(6); PG8_BAR;
    PG8_STAMP();
    for (;;) {
        const bool has_next = S.next(ui + 1, nxt);
        if (has_next) PG8_ROWOFF(nvA, nxt); else { _Pragma("unroll") for (int _h = 0; _h < 2; ++_h) _Pragma("unroll") for (int _i = 0; _i < 2; ++_i) nvA[_h][_i] = cvA[_h][_i]; }
        const char* nA = cA; const char* nB = has_next ? (const char*)g.Bt + (size_t)nxt.pn * tstep : cB;
        for (int t = 0; t < nt; t += 2) {
            const bool last = (t == nt - 2);
            const char* a1 = cA + (size_t)(t + 1) * kstep;
            const char* a2 = last ? nA : cA + (size_t)(t + 2) * kstep; const char* b2 = last ? nB : cB + (size_t)(t + 2) * kstep;
            const char* a3 = a2 + kstep; const char* b3 = b2 + kstep;
            unsigned sv0[2], sv1[2];
            sv0[0] = last ? nvA[0][0] : cvA[0][0]; sv0[1] = last ? nvA[0][1] : cvA[0][1]; sv1[0] = last ? nvA[1][0] : cvA[1][0]; sv1[1] = last ? nvA[1][1] : cvA[1][1];
            if (last && has_next) S.a_ready(nxt);
            PG8_LDB(B0, 0, 0); PG8_SCHED; PG8_LDA(At, 0, 0); PG8_STAGE(PG8_SA(1, 1), a1, cvA[1]);
            PG8_WAIT_L(8); PG8_BAR; PG8_WAIT_L(0); PG8_MMA(0, 0, At, B0); PG8_BAR; PG8_SCHED;
            PG8_LDB(B1, 0, 1); PG8_STAGE(PG8_SB(0, 0), b2, voffB);
            PG8_BAR; PG8_WAIT_L(0); PG8_MMA(0, 1, At, B1); PG8_BAR;
            PG8_LDA(At, 0, 1); PG8_STAGE(PG8_SA(0, 0), a2, sv0);
            PG8_BAR; PG8_WAIT_L(0); PG8_MMA(1, 0, At, B0); PG8_BAR; PG8_SCHED;
            PG8_STAGE(PG8_SB(0, 1), b2 + hstep, voffB);
            PG8_WAIT_V(6); PG8_BAR; PG8_MMA(1, 1, At, B1); PG8_BAR;
            PG8_LDB(B0, 1, 0); PG8_SCHED; PG8_LDA(At, 1, 0); PG8_STAGE(PG8_SA(0, 1), a2, sv1);
            PG8_WAIT_L(8); PG8_BAR; PG8_WAIT_L(0); PG8_MMA(0, 0, At, B0); PG8_BAR; PG8_SCHED;
            PG8_LDB(B1, 1, 1); PG8_STAGE(PG8_SB(1, 0), b3, voffB);
            PG8_BAR; PG8_WAIT_L(0); PG8_MMA(0, 1, At, B1); PG8_BAR;
            PG8_LDA(At, 1, 1); PG8_STAGE(PG8_SA(1, 0), a3, sv0);
            PG8_BAR; PG8_WAIT_L(0); PG8_MMA(1, 0, At, B0); PG8_BAR; PG8_SCHED;
            PG8_STAGE(PG8_SB(1, 1), b3 + hstep, voffB);
            PG8_WAIT_V(6); PG8_BAR; PG8_MMA(1, 1, At, B1); PG8_BAR;
        }
        PG8_STAMP();
        if constexpr (!Epi::AFTER_DRAIN) { E(acc, cur, wr, wc, fr, fq); S.done(cur); }
        PG8_STAMP();
        if (!has_next) break;
#pragma unroll
        for (int a = 0; a < 2; ++a)
#pragma unroll
            for (int b = 0; b < 2; ++b)
#pragma unroll
                for (int m = 0; m < 4; ++m)
#pragma unroll
                    for (int n = 0; n < 2; ++n) acc[a][b][m][n] = (f32x4){0.f, 0.f, 0.f, 0.f};
        cur = nxt; cA = nA; cB = nB; ++ui;
#pragma unroll
        for (int _h = 0; _h < 2; ++_h)
#pragma unroll
            for (int _i = 0; _i < 2; ++_i) cvA[_h][_i] = nvA[_h][_i];
    }
    PG8_WAIT_V(0);
    if (wr == 0) PG8_BAR;
    PG8_BAR;
    if constexpr (Epi::AFTER_DRAIN) { E.fused(acc, cur, wr, wc, fr, fq, lds, wid, lane); S.done(cur); }
    PG8_STAMP();
    if (STAMP && wid == 0) { stamps[lane] = lane < nts ? (((unsigned long long)(unsigned)ts_hi << 32) | (unsigned)ts_lo) : 0ull;
        if (lane == 62) stamps[62] = rt_entry; if (lane == 63) stamps[63] = (unsigned long long)wall_clock64(); }
#undef PG8_STAMP
#undef PG8_ROWOFF
#undef PG8_SA
#undef PG8_SB
#undef PG8_STAGE
#undef PG8_LDA
#undef PG8_LDB
#undef PG8_MMA
#undef PG8_WAIT_V
#undef PG8_WAIT_L
#undef PG8_BAR
#undef PG8_SCHED
}
}
#define XB_TMO      128
#define XB_XCNT(j)  (256  + 64 * (j))
#define XB_XSUB(j)  (1280 + 64 * (j))
#define XB_XGEN(j)  (2304 + 64 * (j))
#define XB_TOP      3328
#define XB_TOPGEN   3392
#define XCD_BAR_WORDS 3456
#define XB_SPIN_CAP (1u << 22)

__device__ __forceinline__ unsigned xb_ld(unsigned* p)              { return __hip_atomic_load(p, __ATOMIC_RELAXED, __HIP_MEMORY_SCOPE_AGENT); }
__device__ __forceinline__ unsigned xb_add(unsigned* p, unsigned v) { return __hip_atomic_fetch_add(p, v, __ATOMIC_RELAXED, __HIP_MEMORY_SCOPE_AGENT); }
__device__ __forceinline__ unsigned xb_xcc_id() { return (unsigned)__builtin_amdgcn_s_getreg((3 << 11) | 20) & 0xFu; }
#define XB_SPIN(cond, bar) do { unsigned _sp = 0; while (cond) { __builtin_amdgcn_s_sleep(1); \
    if ((++_sp & 255u) == 0u) { if (xb_ld(&(bar)[XB_TMO])) break; if (_sp > XB_SPIN_CAP) { atomicAdd(&(bar)[XB_TMO], 1u); break; } } } } while (0)

struct XcdBarrier {
    unsigned* bar; unsigned x;
    volatile LAS unsigned* st;
};

__device__ __forceinline__ XcdBarrier xcd_barrier_post(unsigned* bar, volatile LAS unsigned* st) {
    XcdBarrier b; b.bar = bar; b.x = xb_xcc_id(); b.st = st;
    if (threadIdx.x == 0) (void)xb_add(&bar[XB_XCNT(b.x)], 1u);
    return b;
}
__device__ __forceinline__ void xcd_barrier_complete(unsigned* bar, unsigned x, unsigned& nloc, unsigned& nx) {
    const unsigned G = gridDim.x * gridDim.y * gridDim.z;
    unsigned sum, cnt, mine, sp = 0u;
    for (;;) {
        sum = 0u; cnt = 0u; mine = 0u;
#pragma unroll
        for (unsigned j = 0; j < 16; ++j) { const unsigned c = xb_ld(&bar[XB_XCNT(j)]); sum += c; cnt += (c > 0u) ? 1u : 0u; mine = (j == x) ? c : mine; }
        if (sum == G) break;
        __builtin_amdgcn_s_sleep(1);
        if ((++sp & 255u) == 0u) { if (xb_ld(&bar[XB_TMO])) break; if (sp > XB_SPIN_CAP) { atomicAdd(&bar[XB_TMO], 1u); break; } }
    }
    nloc = mine > 0u ? mine : 1u; nx = cnt > 0u ? cnt : 1u;
}

__device__ __forceinline__ void xcd_barrier(const XcdBarrier& b) {
    asm volatile("s_waitcnt vmcnt(0)" ::: "memory");
    __syncthreads();
    if (threadIdx.x == 0) {
        unsigned* bar = b.bar;
        __builtin_amdgcn_s_waitcnt(0);
        unsigned nloc = b.st[0], nx = b.st[1];
        if (nloc == 0u) { xcd_barrier_complete(bar, b.x, nloc, nx); b.st[0] = nloc; b.st[1] = nx; }
        const unsigned old = xb_add(&bar[XB_XSUB(b.x)], 1u);
        const unsigned gen = old / nloc;
        if (old + 1u == (gen + 1u) * nloc) {
            __builtin_amdgcn_fence(__ATOMIC_RELEASE, "agent");
            asm volatile("s_waitcnt vmcnt(0)" ::: "memory");
            const unsigned og = xb_add(&bar[XB_TOP], 1u);
            const unsigned tg = og / nx;
            if (og + 1u == (tg + 1u) * nx) xb_add(&bar[XB_TOPGEN], 1u);
            else XB_SPIN(xb_ld(&bar[XB_TOPGEN]) == tg, bar);
            __builtin_amdgcn_fence(__ATOMIC_ACQUIRE, "agent");
            xb_add(&bar[XB_XGEN(b.x)], 1u);
            asm volatile("s_waitcnt vmcnt(0)" ::: "memory");
        } else {
            XB_SPIN(xb_ld(&bar[XB_XGEN(b.x)]) == gen, bar);
            __builtin_amdgcn_fence(__ATOMIC_ACQUIRE, "agent");
            asm volatile("s_waitcnt vmcnt(0)" ::: "memory");
        }
    }
    __syncthreads();
}


struct Args { const float* in[31]; float* out; unsigned char* ws; int ph_lo, ph_hi; };
struct PArgs { const float* const* in; float* out; unsigned char* ws; };

struct Ctx {
    LAS unsigned char* lds;
    int tid, lane, wave, nblk, blk;
};

DI void transpose_item(const float* W, int ldw, int src_n0, int k0, bf16* dst, int ldd, bool zero, LAS float* scr, int lane) {
    if (!zero) {
#pragma unroll 8
        for (int i = 0; i < 32; ++i) { const int kk = 2 * i + (lane >> 5); scr[kk * 33 + (lane & 31)] = W[(size_t)(k0 + kk) * ldw + src_n0 + (lane & 31)]; }
    }
    LDS_WAIT(); asm volatile("" ::: "memory");
    const int c = lane & 7;
#pragma unroll
    for (int j = 0; j < 4; ++j) { const int n = (lane >> 3) + 8 * j; const LAS float* s = scr + (8 * c) * 33 + n;
        u32x4 o;
        if (zero) { o = (u32x4){0u, 0u, 0u, 0u}; }
        else { o.x = cvt_pk(s[0 * 33], s[1 * 33]); o.y = cvt_pk(s[2 * 33], s[3 * 33]); o.z = cvt_pk(s[4 * 33], s[5 * 33]); o.w = cvt_pk(s[6 * 33], s[7 * 33]); }
        *(u32x4*)(dst + (size_t)n * ldd + k0 + 8 * c) = o; }
    LDS_WAIT(); asm volatile("" ::: "memory");
}

DI void phase_prologue(const Ctx& X, const PArgs& a) {
    unsigned char* ws = a.ws;
    LAS float* scr = (LAS float*)(X.lds + X.wave * 16384);
    const int gw = X.blk * 8 + X.wave, NGW = X.nblk * 8;
    constexpr int I_IN = 16 * (NWIN / 32), I_PA = 8 * 32, I_PB = 8 * 32, I_OUT = 16 * 32;
    constexpr int NITEMS = I_IN + I_PA + I_PB + I_OUT;
    for (int it = gw; it < NITEMS; it += NGW) {
        int r = it;
        if (r < I_IN) { const int kb = r / (NWIN / 32), nb = r % (NWIN / 32); const int n0 = nb * 32;
            const bool zero = (n0 >= 3744 && n0 < 3840); const int src = n0 < 3744 ? n0 : n0 - 96;
            transpose_item(a.in[5], 5792, zero ? 0 : src, kb * 64, (bf16*)(ws + WS_WIN) + (size_t)n0 * 1024, 1024, zero, scr, X.lane); continue; }
        r -= I_IN;
        if (r < I_PA) { const int kb = r / 32, nb = r % 32; transpose_item(a.in[19], 1024, nb * 32, kb * 64, (bf16*)(ws + WS_WPA) + (size_t)(nb * 32) * 512, 512, false, scr, X.lane); continue; }
        r -= I_PA;
        if (r < I_PB) { const int kb = r / 32, nb = r % 32; transpose_item(a.in[20], 1024, nb * 32, kb * 64, (bf16*)(ws + WS_WPB) + (size_t)(nb * 32) * 512, 512, false, scr, X.lane); continue; }
        r -= I_PB;
        { const int kb = r / 32, nb = r % 32; transpose_item(a.in[21], 1024, nb * 32, kb * 64, (bf16*)(ws + WS_WOUT) + (size_t)(nb * 32) * 1024, 1024, false, scr, X.lane); }
    }
    {
        bf16* G2TB = (bf16*)(ws + WS_G2T); const float* g2 = a.in[13];
        for (int idx = X.blk * 512 + X.tid; idx < 8 * 64 * 96; idx += X.nblk * 512) { const int m = idx % 96, i = (idx / 96) & 63, hh = idx / (96 * 64);
            G2TB[idx] = f2bf(g2[m * 512 + hh * 64 + i]); }
    }
    __syncthreads();
    {
        LAS float* cs = (LAS float*)X.lds;
        LAS float* part = (LAS float*)(X.lds + 8192);
        for (int i = X.tid; i < 2048; i += 512) cs[i] = siluf_(a.in[1][i]);
        __syncthreads();
        const float* aw = a.in[2]; const float* ab = a.in[3]; float* mod = (float*)(ws + WS_MOD);
        for (int cb = X.blk; cb < 256; cb += X.nblk) {
            const int c = X.tid % 24, kg = X.tid / 24;
            float s0 = 0.f, s1 = 0.f;
            if (kg < 21) for (int k = kg; k < 1024; k += 21) { const float w = aw[(size_t)k * 6144 + cb * 24 + c]; s0 += cs[k] * w; s1 += cs[1024 + k] * w; }
            if (kg < 21) { part[(kg * 24 + c) * 2] = s0; part[(kg * 24 + c) * 2 + 1] = s1; }
            __syncthreads();
            if (X.tid < 48) { const int cc = X.tid >> 1, b = X.tid & 1; float s = 0.f;
                for (int q = 0; q < 21; ++q) s += part[(q * 24 + cc) * 2 + b];
                mod[b * 6144 + cb * 24 + cc] = s + ab[cb * 24 + cc]; }
            __syncthreads();
        }
    }
}

DI void phase_norm1(const Ctx& X, const PArgs& a) {
    const float* x = a.in[0]; const float* g1 = a.in[4]; const float* mod = (const float*)(a.ws + WS_MOD);
    bf16* h = (bf16*)a.out;
    const int gw = X.blk * 8 + X.wave, NGW = X.nblk * 8;
    for (int m = gw; m < NTOK; m += NGW) {
        const int b = m >> 13;
        const f32x4* xr = (const f32x4*)(x + (size_t)m * DM) + X.lane;
        f32x4 v[4]; float s = 0.f;
#pragma unroll
        for (int j = 0; j < 4; ++j) { v[j] = xr[64 * j]; s += (v[j].x * v[j].x + v[j].y * v[j].y) + (v[j].z * v[j].z + v[j].w * v[j].w); }
        const float rs = frsq(wave_sum(s) * (1.f / DM) + 1e-6f);
        u32x2* o = (u32x2*)(h + (size_t)m * DM) + X.lane;
#pragma unroll
        for (int j = 0; j < 4; ++j) { const int col = 4 * X.lane + 256 * j;
            const f32x4 g = *(const f32x4*)(g1 + col), sh = *(const f32x4*)(mod + b * 6144 + col), sc = *(const f32x4*)(mod + b * 6144 + 1024 + col);
            const f32x4 y = v[j] * rs * g * (1.0f + sc) + sh;
            u32x2 w; w.x = cvt_pk(y.x, y.y); w.y = cvt_pk(y.z, y.w); o[64 * j] = w; }
    }
    {
        const float* g2 = a.in[22]; const float* wgr = a.in[23]; const float* bgr = a.in[24]; const float* wer = a.in[25]; const float* ber = a.in[26];
        bf16* WRH = (bf16*)(a.ws + WS_WRH); bf16* WRL = (bf16*)(a.ws + WS_WRL); float* CB = (float*)(a.ws + WS_CB);
        for (int idx = X.blk * 512 + X.tid; idx < 2 * 48 * 1024; idx += X.nblk * 512) {
            const int k = idx & 1023, o = (idx >> 10) % 48, b = idx / (48 * 1024);
            float wv = 0.f;
            if (o < 4) wv = wgr[k * 4 + o]; else if (o < 36) wv = wer[k * 32 + (o - 4)];
            wv *= g2[k] * (1.0f + mod[b * 6144 + 4096 + k]);
            const bf16 hi = f2bf(wv); const bf16 lo = f2bf(wv - bf2f(hi));
            WRH[idx] = hi; WRL[idx] = lo;
        }
        if (gw < 96) { const int b = gw / 48, o = gw % 48; float s = 0.f;
            if (o < 36) for (int k = X.lane; k < 1024; k += 64) s += mod[b * 6144 + 3072 + k] * (o < 4 ? wgr[k * 4 + o] : wer[k * 32 + (o - 4)]);
            s = wave_sum(s);
            if (X.lane == 0) CB[b * 48 + o] = o < 4 ? s + bgr[o] : (o < 36 ? s + ber[o - 4] : 0.f); }
    }
}

constexpr int HG_CUMLD = 132;
DI float hg_lb_of(const float* hg_lb, int idx) { return frcp(1.0f + __expf(hg_lb[512 + idx] - hg_lb[idx])); }

DI void hg_load_f(const Ctx& X, const bf16* proj, const float* hg_lb, int row0, int hh, LAS float* CUM, float (&f)[16]) {
    const int t = X.tid >> 3, cg = (X.tid & 7) * 16;
    const u32x4* src = (const u32x4*)(proj + pj_off(row0 + t, C_HF + hh * 128, 128, cg));
    const u32x4 r0 = src[0], r1 = src[1];
    const unsigned w[8] = {r0.x, r0.y, r0.z, r0.w, r1.x, r1.y, r1.z, r1.w};
#pragma unroll
    for (int e = 0; e < 8; ++e) {
        const float lb0 = hg_lb_of(hg_lb, hh * 128 + cg + 2 * e), lb1 = hg_lb_of(hg_lb, hh * 128 + cg + 2 * e + 1);
        f[2 * e] = lb0 + (1.0f - lb0) * sigmoidf_(bflo(w[e])); f[2 * e + 1] = lb1 + (1.0f - lb1) * sigmoidf_(bfhi(w[e]));
    }
#pragma unroll
    for (int e = 0; e < 16; e += 4) *(LAS f32x4*)(CUM + t * HG_CUMLD + cg + e) = (f32x4){__logf(f[e]), __logf(f[e + 1]), __logf(f[e + 2]), __logf(f[e + 3])};
}
DI void hg_scan(const Ctx& X, LAS float* CUM, LAS float* TOT) {
    const int k = X.tid & 127, seg = X.tid >> 7;
    float v[16]; float run = 0.f;
#pragma unroll
    for (int i = 0; i < 16; ++i) { run += CUM[(seg * 16 + i) * HG_CUMLD + k]; v[i] = run; }
    TOT[seg * 128 + k] = run;
    __syncthreads();
    float off = 0.f;
#pragma unroll
    for (int s = 0; s < 3; ++s) off += (s < seg) ? TOT[s * 128 + k] : 0.f;
#pragma unroll
    for (int i = 0; i < 16; ++i) CUM[(seg * 16 + i) * HG_CUMLD + k] = v[i] + off;
    __syncthreads();
}

DI void hg1_unit(const Ctx& X, const PArgs& a, int u) {
    const bf16* proj = (const bf16*)(a.ws + WS_PROJ);
    const int pair = u >> 7, c = u & 127, b = pair >> 2, hh = pair & 3, row0 = b * SEQ + c * 64;
    LAS float* CUM = (LAS float*)X.lds; LAS float* TOT = (LAS float*)(X.lds + 33792);
    LAS bf16* KDT = (LAS bf16*)(X.lds + 36864); LAS bf16* VT = (LAS bf16*)(X.lds + 55296);
    float f[16];
    const int t = X.tid >> 3, cg = (X.tid & 7) * 16;
    const u32x4* srci = (const u32x4*)(proj + pj_off(row0 + t, C_HI + hh * 128, 128, cg));
    const u32x4 r0 = srci[0], r1 = srci[1];
    hg_load_f(X, proj, a.in[6], row0, hh, CUM, f);
    __syncthreads();
    hg_scan(X, CUM, TOT);
    if (X.tid < 128) ((float*)(a.ws + WS_HGC))[(size_t)u * 128 + X.tid] = __expf(CUM[63 * HG_CUMLD + X.tid]);
    {
        const unsigned w[8] = {r0.x, r0.y, r0.z, r0.w, r1.x, r1.y, r1.z, r1.w};
#pragma unroll
        for (int e = 0; e < 16; ++e) {
            const int k = cg + e;
            const float kd = (1.0f - f[e]) * __expf(CUM[63 * HG_CUMLD + k] - CUM[t * HG_CUMLD + k]);
            KDT[k * 72 + t] = f2bf(kd);
            VT[k * 72 + t] = (bf16)((e & 1) ? (w[e >> 1] >> 16) : (w[e >> 1] & 0xffffu));
        }
    }
    __syncthreads();
    {
        const int w = X.wave, v0 = 32 * (w >> 1), k0 = 64 * (w & 1), r = X.lane & 15, g = X.lane >> 4;
        f32x4 acc[4][2]; zero_acc(acc);
        mm_ll<4, 2, 2>(KDT + k0 * 72, 72, VT + v0 * 72, 72, acc, X.lane);
        bf16* dst = (bf16*)(a.ws + WS_HS) + (size_t)u * 16384;
#pragma unroll
        for (int tp = 0; tp < 4; ++tp)
#pragma unroll
            for (int tq = 0; tq < 2; ++tq) { u32x2 o; o.x = cvt_pk(acc[tp][tq][0], acc[tp][tq][1]); o.y = cvt_pk(acc[tp][tq][2], acc[tp][tq][3]);
                *(u32x2*)(dst + (v0 + 16 * tq + r) * 128 + k0 + 16 * tp + 4 * g) = o; }
    }
    __syncthreads();
}

DI void hg2_scan(const Ctx& X, const PArgs& a, bool dry = false) {
    const float* gc = (const float*)(a.ws + WS_HGC);
    for (int it = X.blk * 512 + X.tid; it < 65536; it += X.nblk * 512) {
        const int pair = it >> 13, rem = it & 8191;
        const int kp = rem & 63;
        unsigned* base = (unsigned*)(a.ws + WS_HS) + (size_t)pair * 128 * 8192 + rem;
        const float* gb = gc + (size_t)pair * 128 * 128 + kp * 2;
        float s0 = 0.f, s1 = 0.f;
        for (int cb = 0; cb < 128; cb += 8) {
            unsigned uu[8]; f32x2 gg[8];
#pragma unroll
            for (int i = 0; i < 8; ++i) { uu[i] = base[(size_t)(cb + i) * 8192]; gg[i] = *(const f32x2*)(gb + (cb + i) * 128); }
#pragma unroll
            for (int i = 0; i < 8; ++i) { if (!dry || s0 == 1.2345e33f) base[(size_t)(cb + i) * 8192] = cvt_pk(s0, s1); s0 = gg[i].x * s0 + bflo(uu[i]); s1 = gg[i].y * s1 + bfhi(uu[i]); }
        }
    }
}

DI void hg3_unit(const Ctx& X, const PArgs& a, int u) {
    const bf16* proj = (const bf16*)(a.ws + WS_PROJ);
    const int pair = u >> 7, c = u & 127, b = pair >> 2, hh = pair & 3, row0 = b * SEQ + c * 64;
    LAS float* CUM = (LAS float*)X.lds; LAS float* TOT = (LAS float*)(X.lds + 33792);
    LAS float* RED = (LAS float*)(X.lds + 36352);
    LAS bf16* QD = (LAS bf16*)(X.lds + 36864); LAS bf16* QT = (LAS bf16*)(X.lds + 54272); LAS bf16* KT = (LAS bf16*)(X.lds + 71680);
    LAS bf16* VT = (LAS bf16*)(X.lds + 89088); LAS bf16* PM = (LAS bf16*)(X.lds + 107520);
    float f[16];
    const int w = X.wave, r = X.lane & 15, g = X.lane >> 4, tq0 = 16 * (w >> 1);
    const u32x4* sq = (const u32x4*)(proj + pj_off(row0 + (X.tid >> 3), C_HQ + hh * 128, 128, (X.tid & 7) * 16));
    const u32x4* sv = (const u32x4*)(proj + pj_off(row0 + (X.tid >> 3), C_HI + hh * 128, 128, (X.tid & 7) * 16));
    const u32x4 q0 = sq[0], q1 = sq[1], i0 = sv[0], i1 = sv[1];
    u32x2 ggw[4];
#pragma unroll
    for (int tp = 0; tp < 4; ++tp) ggw[tp] = *(const u32x2*)(proj + pj_off(row0 + tq0 + r, C_HG + hh * 128, 128, 64 * (w & 1) + 16 * tp + 4 * g));
    hg_load_f(X, proj, a.in[6], row0, hh, CUM, f);
    __syncthreads();
    hg_scan(X, CUM, TOT);
    {
        const int t = X.tid >> 3, cg = (X.tid & 7) * 16;
        const unsigned qw[8] = {q0.x, q0.y, q0.z, q0.w, q1.x, q1.y, q1.z, q1.w};
        const unsigned iw[8] = {i0.x, i0.y, i0.z, i0.w, i1.x, i1.y, i1.z, i1.w};
        unsigned oqd[8], oqt[8], okt[8];
#pragma unroll
        for (int e = 0; e < 8; ++e) {
            float qd[2], qt[2], kt[2];
#pragma unroll
            for (int hb = 0; hb < 2; ++hb) {
                const int k = cg + 2 * e + hb;
                const float cum = CUM[t * HG_CUMLD + k], ref = CUM[31 * HG_CUMLD + k];
                const float qs = siluf_(hb ? bfhi(qw[e]) : bflo(qw[e]));
                qd[hb] = qs * __expf(cum); qt[hb] = qs * __expf(cum - ref); kt[hb] = (1.0f - f[2 * e + hb]) * __expf(ref - cum);
                VT[k * 72 + t] = (bf16)(hb ? (iw[e] >> 16) : (iw[e] & 0xffffu));
            }
            oqd[e] = cvt_pk(qd[0], qd[1]); oqt[e] = cvt_pk(qt[0], qt[1]); okt[e] = cvt_pk(kt[0], kt[1]);
        }
        *(LAS u32x4*)(QD + t * 136 + cg) = (u32x4){oqd[0], oqd[1], oqd[2], oqd[3]}; *(LAS u32x4*)(QD + t * 136 + cg + 8) = (u32x4){oqd[4], oqd[5], oqd[6], oqd[7]};
        *(LAS u32x4*)(QT + t * 136 + cg) = (u32x4){oqt[0], oqt[1], oqt[2], oqt[3]}; *(LAS u32x4*)(QT + t * 136 + cg + 8) = (u32x4){oqt[4], oqt[5], oqt[6], oqt[7]};
        *(LAS u32x4*)(KT + t * 136 + cg) = (u32x4){okt[0], okt[1], okt[2], okt[3]}; *(LAS u32x4*)(KT + t * 136 + cg + 8) = (u32x4){okt[4], okt[5], okt[6], okt[7]};
    }
    __syncthreads();
    {
        f32x4 acc[2][1]; zero_acc(acc);
        const int s0 = 32 * (w & 1);
        mm_ll<2, 1, 4>(KT + s0 * 136, 136, QT + tq0 * 136, 136, acc, X.lane);
        const int t = tq0 + r;
#pragma unroll
        for (int tp = 0; tp < 2; ++tp) { const int sb = s0 + 16 * tp + 4 * g; float v[4];
#pragma unroll
            for (int e = 0; e < 4; ++e) v[e] = (sb + e <= t) ? acc[tp][0][e] : 0.f;
            u32x2 o; o.x = cvt_pk(v[0], v[1]); o.y = cvt_pk(v[2], v[3]); *(LAS u32x2*)(PM + t * 72 + sb) = o; }
    }
    __syncthreads();
    {
        const int v0 = 64 * (w & 1), t = tq0 + r;
        f32x4 acc[4][1]; zero_acc(acc);
        mm_gl<4, 1, 4>((const bf16*)(a.ws + WS_HS) + (size_t)u * 16384 + (size_t)v0 * 128, 128, QD + tq0 * 136, 136, acc, X.lane);
        mm_ll<4, 1, 2>(VT + v0 * 72, 72, PM + tq0 * 72, 72, acc, X.lane);
        float ss = 0.f;
#pragma unroll
        for (int tp = 0; tp < 4; ++tp)
#pragma unroll
            for (int e = 0; e < 4; ++e) ss += acc[tp][0][e] * acc[tp][0][e];
        ss += __shfl_xor(ss, 16); ss += __shfl_xor(ss, 32);
        if (g == 0) RED[t * 2 + (w & 1)] = ss;
        __syncthreads();
        const float rs = frsq((RED[t * 2] + RED[t * 2 + 1]) * (1.0f / 128.0f) + 1e-6f);
        const float* ng = a.in[7];
#pragma unroll
        for (int tp = 0; tp < 4; ++tp) { const int v = v0 + 16 * tp + 4 * g;
            const u32x2 gw = ggw[tp];
            const f32x4 n4 = *(const f32x4*)(ng + hh * 128 + v);
            const float o0 = acc[tp][0][0] * rs * n4.x * siluf_(bflo(gw.x)), o1 = acc[tp][0][1] * rs * n4.y * siluf_(bfhi(gw.x));
            const float o2 = acc[tp][0][2] * rs * n4.z * siluf_(bflo(gw.y)), o3 = acc[tp][0][3] * rs * n4.w * siluf_(bfhi(gw.y));
            u32x2 o; o.x = cvt_pk(o0, o1); o.y = cvt_pk(o2, o3);
            *(u32x2*)((bf16*)a.out + (size_t)(row0 + t) * 512 + hh * 128 + v) = o; }
    }
    __syncthreads();
}

constexpr int R_AT = 0, R_RT = 9216, R_BH = 18432, R_KH = 27648, R_BHT = 36864, R_KHT = 46080, R_VT = 55296, R_AAK = 64512, R_ARB = 73728, R_ARK = 82944,
              R_WT = 92160, R_U0T = 101376, R_XB = 110592, R_CUM = 144384, R_GC = 161792;
constexpr int R_LW = 64512, R_LA = 69632, R_W2T = 74752, R_A2T = 79872;
constexpr int R_TOT = 92160, R_RED = 94208;
constexpr int XBLD = 132, CUMLD = 68;

DI float tanh_fast(float x) { return 1.0f - 2.0f * frcp(1.0f + __expf(2.0f * x)); }
DI f32x4 rw_shift4(const bf16* proj, const float* mu, int row, int col, bool first) {
    const int ss = col < C_WD ? (col & ~63) : (col < C_GD ? C_WD : C_GD), wd = col < C_GD ? 64 : 192;
    const bf16* ptr = proj + pj_off(row, ss, wd, col - ss);
    const u32x2 cw = *(const u32x2*)ptr;
    u32x2 pw = (u32x2){0u, 0u};
    if (!first) pw = *(const u32x2*)(ptr - wd);
    const f32x4 m = *(const f32x4*)(mu + (col - C_RR));
    const f32x4 c = (f32x4){bflo(cw.x), bfhi(cw.x), bflo(cw.y), bfhi(cw.y)}, p = (f32x4){bflo(pw.x), bfhi(pw.x), bflo(pw.y), bfhi(pw.y)};
    return c + m * (p - c);
}

#define BAR_LDS() do { asm volatile("s_waitcnt lgkmcnt(0)" ::: "memory"); __builtin_amdgcn_s_barrier(); asm volatile("" ::: "memory"); } while (0)
DI f32x4 rw_shift_raw(u32x2 cw, u32x2 pw, f32x4 m) {
    const f32x4 c = (f32x4){bflo(cw.x), bfhi(cw.x), bflo(cw.y), bfhi(cw.y)}, p = (f32x4){bflo(pw.x), bfhi(pw.x), bflo(pw.y), bfhi(pw.y)};
    return c + m * (p - c);
}
struct R1Raw { u32x2 rc[2], rp[2], kc[2], kp[2], vc[2], vp[2]; u32x4 lc, lp; f32x4 w2v, a2v; };
DI void rw1_load(const Ctx& X, const PArgs& a, int u, R1Raw& R) {
    const bf16* proj = (const bf16*)(a.ws + WS_PROJ);
    const int pair = u >> 7, c = u & 127, b = pair >> 3, h = pair & 7, row0 = b * SEQ + c * 64;
    const int w = X.wave, r = X.lane & 15, g = X.lane >> 4, t = 16 * (w >> 1) + r, jb = 32 * (w & 1) + 4 * g;
    const bool first = (c == 0 && t == 0);
#pragma unroll
    for (int i = 0; i < 2; ++i) { const int j = jb + 16 * i;
        const bf16* pr = proj + pj_off(row0 + t, C_RR + h * 64, 64, j); const bf16* pk = proj + pj_off(row0 + t, C_RK + h * 64, 64, j); const bf16* pv = proj + pj_off(row0 + t, C_RV + h * 64, 64, j);
        R.rc[i] = *(const u32x2*)pr; R.kc[i] = *(const u32x2*)pk; R.vc[i] = *(const u32x2*)pv;
        R.rp[i] = (u32x2){0u, 0u}; R.kp[i] = (u32x2){0u, 0u}; R.vp[i] = (u32x2){0u, 0u};
        if (!first) { R.rp[i] = *(const u32x2*)(pr - 64); R.kp[i] = *(const u32x2*)(pk - 64); R.vp[i] = *(const u32x2*)(pv - 64); } }
    { const int tt = X.tid >> 3, c8 = (X.tid & 7) * 8; const bf16* pl = proj + pj_off(row0 + tt, C_WD, 64, c8);
      R.lc = *(const u32x4*)pl; R.lp = (u32x4){0u, 0u, 0u, 0u}; if (!(c == 0 && tt == 0)) R.lp = *(const u32x4*)(pl - 64); }
    { const int m = X.tid >> 4, j4 = (X.tid & 15) * 4; R.w2v = *(const f32x4*)(a.in[10] + m * 512 + h * 64 + j4); R.a2v = *(const f32x4*)(a.in[12] + m * 512 + h * 64 + j4); }
}
DI void rw1_unit(const Ctx& X, const PArgs& a, int u, const R1Raw& R) {
    const bf16* proj = (const bf16*)(a.ws + WS_PROJ);
    const float* mu = a.in[8];
    const int pair = u >> 7, c = u & 127, b = pair >> 3, h = pair & 7, row0 = b * SEQ + c * 64;
    LAS unsigned char* L = X.lds;
    LAS bf16 *AT = (LAS bf16*)(L + R_AT), *RT = (LAS bf16*)(L + R_RT), *BH = (LAS bf16*)(L + R_BH), *KH = (LAS bf16*)(L + R_KH), *BHT = (LAS bf16*)(L + R_BHT), *KHT = (LAS bf16*)(L + R_KHT),
             *VT = (LAS bf16*)(L + R_VT), *AAK = (LAS bf16*)(L + R_AAK), *ARB = (LAS bf16*)(L + R_ARB), *ARK = (LAS bf16*)(L + R_ARK), *WT = (LAS bf16*)(L + R_WT), *U0T = (LAS bf16*)(L + R_U0T),
             *LW = (LAS bf16*)(L + R_LW), *LA = (LAS bf16*)(L + R_LA), *W2T = (LAS bf16*)(L + R_W2T), *A2T = (LAS bf16*)(L + R_A2T);
    LAS float *XB = (LAS float*)(L + R_XB), *CUM = (LAS float*)(L + R_CUM), *GC = (LAS float*)(L + R_GC), *TOT = (LAS float*)(L + R_TOT), *RED = (LAS float*)(L + R_RED);
    const int w = X.wave, r = X.lane & 15, g = X.lane >> 4;
    const int t = 16 * (w >> 1) + r, jb = 32 * (w & 1) + 4 * g;
    f32x4 rr_[2], kk_[2], vv_[2], w0_[2], a0_[2], kk_c[2], ka_c[2], rk_c[2];
#pragma unroll
    for (int i = 0; i < 2; ++i) { const int col = h * 64 + jb + 16 * i;
        rr_[i] = rw_shift_raw(R.rc[i], R.rp[i], *(const f32x4*)(mu + col)); kk_[i] = rw_shift_raw(R.kc[i], R.kp[i], *(const f32x4*)(mu + 512 + col)); vv_[i] = rw_shift_raw(R.vc[i], R.vp[i], *(const f32x4*)(mu + 1024 + col));
        w0_[i] = *(const f32x4*)(a.in[9] + col); a0_[i] = *(const f32x4*)(a.in[11] + col); kk_c[i] = *(const f32x4*)(a.in[14] + col); ka_c[i] = *(const f32x4*)(a.in[15] + col); rk_c[i] = *(const f32x4*)(a.in[16] + col); }
    {
        const int t = X.tid >> 3, c8 = (X.tid & 7) * 8;
        const f32x4 v0 = rw_shift_raw((u32x2){R.lc.x, R.lc.y}, (u32x2){R.lp.x, R.lp.y}, *(const f32x4*)(mu + 1536 + c8)), v1 = rw_shift_raw((u32x2){R.lc.z, R.lc.w}, (u32x2){R.lp.z, R.lp.w}, *(const f32x4*)(mu + 1536 + c8 + 4));
        if (c8 < 32) { u32x4 o; o.x = cvt_pk(tanh_fast(v0.x), tanh_fast(v0.y)); o.y = cvt_pk(tanh_fast(v0.z), tanh_fast(v0.w)); o.z = cvt_pk(tanh_fast(v1.x), tanh_fast(v1.y)); o.w = cvt_pk(tanh_fast(v1.z), tanh_fast(v1.w));
            *(LAS u32x4*)(LW + t * 40 + c8) = o; }
        else { u32x4 o; o.x = cvt_pk(v0.x, v0.y); o.y = cvt_pk(v0.z, v0.w); o.z = cvt_pk(v1.x, v1.y); o.w = cvt_pk(v1.z, v1.w);
            *(LAS u32x4*)(LA + t * 40 + (c8 - 32)) = o; }
        const int m = X.tid >> 4, j4 = (X.tid & 15) * 4;
        const f32x4 w2 = R.w2v, a2 = R.a2v;
#pragma unroll
        for (int e = 0; e < 4; ++e) { W2T[(j4 + e) * 40 + m] = f2bf(w2[e]); A2T[(j4 + e) * 40 + m] = f2bf(a2[e]); }
    }
    BAR_LDS();
    float rs_[8], kf_[8], vs_[8], kkv_[8], aa_[8], lw_[8];
    {
        f32x4 accw[2][1], acca[2][1]; zero_acc(accw); zero_acc(acca);
        mm_ll<2, 1, 1>(W2T + 32 * (w & 1) * 40, 40, LW + 16 * (w >> 1) * 40, 40, accw, X.lane);
        mm_ll<2, 1, 1>(A2T + 32 * (w & 1) * 40, 40, LA + 16 * (w >> 1) * 40, 40, acca, X.lane);
        float ss = 0.f, bon = 0.f;
#pragma unroll
        for (int i = 0; i < 2; ++i) {
            const int j = jb + 16 * i, col = h * 64 + j;
            const f32x4 rr = rr_[i], kk = kk_[i], vv = vv_[i], w0 = w0_[i], a0 = a0_[i], k_k = kk_c[i], k_a = ka_c[i], r_k = rk_c[i];
            f32x4 lw4;
#pragma unroll
            for (int e = 0; e < 4; ++e) {
                const float y = -(w0[e] + accw[i][0][e]);
                const float sp = fmaxf(y, 0.f) + __logf(1.0f + __expf(-fabsf(y)));
                const float wlog = -sp - 0.5f;
                const float lw = -__expf(wlog);
                const float aa = sigmoidf_(a0[e] + acca[i][0][e]);
                const float kkv = kk[e] * k_k[e];
                const float kf = kk[e] * (1.0f + (aa - 1.0f) * k_a[e]);
                ss += kkv * kkv; bon += rr[e] * kf * r_k[e];
                rs_[4 * i + e] = rr[e]; kf_[4 * i + e] = kf; vs_[4 * i + e] = vv[e]; kkv_[4 * i + e] = kkv; aa_[4 * i + e] = aa; lw_[4 * i + e] = lw; lw4[e] = lw;
            }
            *(LAS f32x4*)(CUM + t * CUMLD + j) = lw4;
        }
        ss += __shfl_xor(ss, 16); ss += __shfl_xor(ss, 32); bon += __shfl_xor(bon, 16); bon += __shfl_xor(bon, 32);
        if (g == 0) { RED[(t * 2 + (w & 1)) * 2] = ss; RED[(t * 2 + (w & 1)) * 2 + 1] = bon; }
    }
    BAR_LDS();
    {
        const int j = X.tid & 63, seg = X.tid >> 6; float v[8]; float run = 0.f;
#pragma unroll
        for (int i = 0; i < 8; ++i) { run += CUM[(seg * 8 + i) * CUMLD + j]; v[i] = run; }
        TOT[seg * 64 + j] = run;
        BAR_LDS();
        float off = 0.f;
#pragma unroll
        for (int s = 0; s < 7; ++s) off += (s < seg) ? TOT[s * 64 + j] : 0.f;
#pragma unroll
        for (int i = 0; i < 8; ++i) CUM[(seg * 8 + i) * CUMLD + j] = v[i] + off;
        if (seg == 7) { const float gc = __expf(v[7] + off); GC[j] = gc; ((float*)(a.ws + WS_RGC))[(size_t)u * 64 + j] = gc; }
    }
    BAR_LDS();
    {
        const float ssT = RED[(t * 2) * 2] + RED[(t * 2 + 1) * 2];
        const float inv = frsq(fmaxf(ssT, 1e-24f));
        if (g == 0 && (w & 1) == 0) ((float*)(a.ws + WS_BONUS))[(size_t)(row0 + t) * 8 + h] = RED[(t * 2) * 2 + 1] + RED[(t * 2 + 1) * 2 + 1];
#pragma unroll
        for (int i = 0; i < 2; ++i) {
            const int j = jb + 16 * i;
            const f32x4 cum = *(const LAS f32x4*)(CUM + t * CUMLD + j);
            float at[4], rt[4], bh[4], kh[4];
#pragma unroll
            for (int e = 0; e < 4; ++e) {
                const float kkn = kkv_[4 * i + e] * inv;
                const float eneg = __expf(-cum[e]);
                at[e] = -kkn * __expf(cum[e] - lw_[4 * i + e]); rt[e] = rs_[4 * i + e] * __expf(cum[e]);
                bh[e] = kkn * aa_[4 * i + e] * eneg; kh[e] = kf_[4 * i + e] * eneg;
                BHT[(j + e) * 72 + t] = f2bf(bh[e]); KHT[(j + e) * 72 + t] = f2bf(kh[e]); VT[(j + e) * 72 + t] = f2bf(vs_[4 * i + e]);
            }
            *(LAS u32x2*)(AT + t * 72 + j) = (u32x2){cvt_pk(at[0], at[1]), cvt_pk(at[2], at[3])};
            *(LAS u32x2*)(RT + t * 72 + j) = (u32x2){cvt_pk(rt[0], rt[1]), cvt_pk(rt[2], rt[3])};
            *(LAS u32x2*)(BH + t * 72 + j) = (u32x2){cvt_pk(bh[0], bh[1]), cvt_pk(bh[2], bh[3])};
            *(LAS u32x2*)(KH + t * 72 + j) = (u32x2){cvt_pk(kh[0], kh[1]), cvt_pk(kh[2], kh[3])};
            *(LAS f32x4*)(XB + t * XBLD + j) = (f32x4){at[0], at[1], at[2], at[3]};
        }
    }
    BAR_LDS();
    {
        LAS float* AAB = CUM;
        const int tq0 = 16 * (w >> 1), s0 = 32 * (w & 1);
        f32x4 ab[2][1], ak[2][1], rb[2][1], rk[2][1]; zero_acc(ab); zero_acc(ak); zero_acc(rb); zero_acc(rk);
        mm_ll<2, 1, 2>(BH + s0 * 72, 72, AT + tq0 * 72, 72, ab, X.lane);
        mm_ll<2, 1, 2>(KH + s0 * 72, 72, AT + tq0 * 72, 72, ak, X.lane);
        mm_ll<2, 1, 2>(BH + s0 * 72, 72, RT + tq0 * 72, 72, rb, X.lane);
        mm_ll<2, 1, 2>(KH + s0 * 72, 72, RT + tq0 * 72, 72, rk, X.lane);
#pragma unroll
        for (int tp = 0; tp < 2; ++tp) { const int sb = s0 + 16 * tp + 4 * g; f32x4 vab; float vak[4], vrb[4], vrk[4];
#pragma unroll
            for (int e = 0; e < 4; ++e) { const bool lo = (sb + e < t), le = (sb + e <= t);
                vab[e] = lo ? ab[tp][0][e] : 0.f; vak[e] = lo ? ak[tp][0][e] : 0.f; vrb[e] = le ? rb[tp][0][e] : 0.f; vrk[e] = le ? rk[tp][0][e] : 0.f; }
            *(LAS f32x4*)(AAB + t * CUMLD + sb) = vab;
            *(LAS u32x2*)(AAK + t * 72 + sb) = (u32x2){cvt_pk(vak[0], vak[1]), cvt_pk(vak[2], vak[3])};
            *(LAS u32x2*)(ARB + t * 72 + sb) = (u32x2){cvt_pk(vrb[0], vrb[1]), cvt_pk(vrb[2], vrb[3])};
            *(LAS u32x2*)(ARK + t * 72 + sb) = (u32x2){cvt_pk(vrk[0], vrk[1]), cvt_pk(vrk[2], vrk[3])}; }
    }
    BAR_LDS();
    LAS bf16* AABH = (LAS bf16*)(L + R_BH);
    LAS bf16* TINV = (LAS bf16*)(L + R_AT);
    LAS bf16* YT = (LAS bf16*)(L + R_KH);
    {
        const int tq0 = 16 * (w >> 1), i0 = 32 * (w & 1);
        f32x4 acc[2][1]; zero_acc(acc);
        mm_ll<2, 1, 2>(VT + i0 * 72, 72, AAK + tq0 * 72, 72, acc, X.lane);
#pragma unroll
        for (int tp = 0; tp < 2; ++tp) *(LAS f32x4*)(XB + t * XBLD + 64 + i0 + 16 * tp + 4 * g) = acc[tp][0];
        { const int tt = X.tid >> 3, s8 = (X.tid & 7) * 8; const f32x4 a0 = *(const LAS f32x4*)(CUM + tt * CUMLD + s8), a1 = *(const LAS f32x4*)(CUM + tt * CUMLD + s8 + 4);
          *(LAS u32x4*)(AABH + tt * 72 + s8) = (u32x4){cvt_pk(a0[0], a0[1]), cvt_pk(a0[2], a0[3]), cvt_pk(a1[0], a1[1]), cvt_pk(a1[2], a1[3])}; }
#pragma unroll
        for (int q = 0; q < 9; ++q) ((LAS unsigned*)WT)[X.tid * 9 + q] = 0u;
        if (w < 4) {
            const int l = X.lane & 15;
            float ar[16];
#pragma unroll
            for (int q = 0; q < 4; ++q) { const f32x4 v = *(const LAS f32x4*)(CUM + (16 * w + l) * CUMLD + 16 * w + 4 * q); ar[4 * q] = v[0]; ar[4 * q + 1] = v[1]; ar[4 * q + 2] = v[2]; ar[4 * q + 3] = v[3]; }
            float x[16];
#pragma unroll
            for (int i = 0; i < 16; ++i) { float xi = (i == l) ? 1.0f : 0.0f;
#pragma unroll
                for (int ip = 0; ip < i; ++ip) xi += __int_as_float(__builtin_amdgcn_readlane(__float_as_int(ar[ip]), i)) * x[ip];
                x[i] = xi; }
            if (X.lane < 16) {
#pragma unroll
                for (int i = 0; i < 16; ++i) TINV[(w * 16 + i) * 24 + l] = f2bf(x[i]); }
        }
    }
    BAR_LDS();
    {
        LAS bf16* Xt = (w < 4 ? WT + 16 * w * 72 : U0T + 16 * (w - 4) * 72);
        LAS bf16* Yw = YT + 16 * w * 24;
        const bf16x8 zf = (bf16x8){0, 0, 0, 0, 0, 0, 0, 0};
#pragma unroll
        for (int bk = 0; bk < 4; ++bk) {
            f32x4 acc = (f32x4){0.f, 0.f, 0.f, 0.f};
#pragma unroll
            for (int ks = 0; ks < (bk + 1) / 2; ++ks) {
                const bf16x8 pf = *(const LAS bf16x8*)(AABH + (16 * bk + r) * 72 + 32 * ks + 8 * g), qf = *(const LAS bf16x8*)(Xt + r * 72 + 32 * ks + 8 * g);
                acc = mfma16(pf, qf, acc); }
#pragma unroll
            for (int e = 0; e < 4; ++e) acc[e] += XB[(16 * bk + 4 * g + e) * XBLD + 16 * w + r];
            *(LAS u32x2*)(Yw + r * 24 + 4 * g) = (u32x2){cvt_pk(acc[0], acc[1]), cvt_pk(acc[2], acc[3])};
            asm volatile("s_waitcnt lgkmcnt(0)" ::: "memory");
            bf16x8 pf = zf, qf = zf;
            if (g < 2) { pf = *(const LAS bf16x8*)(TINV + (bk * 16 + r) * 24 + 8 * g); qf = *(const LAS bf16x8*)(Yw + r * 24 + 8 * g); }
            const f32x4 xs = mfma16(pf, qf, (f32x4){0.f, 0.f, 0.f, 0.f});
            *(LAS u32x2*)(Xt + r * 72 + 16 * bk + 4 * g) = (u32x2){cvt_pk(xs[0], xs[1]), cvt_pk(xs[2], xs[3])};
            asm volatile("s_waitcnt lgkmcnt(0)" ::: "memory");
        }
    }
    BAR_LDS();
    {
        bf16* out = (bf16*)(a.ws + WS_RM) + (size_t)u * 16384;
        const int q0 = 16 * (w >> 1), p0 = 32 * (w & 1), qq = q0 + r;
        f32x4 accG[2][1], accY[2][1], accM[2][1], accN[2][1]; zero_acc(accG); zero_acc(accY); zero_acc(accM); zero_acc(accN);
        mm_ll<2, 1, 2>(WT + p0 * 72, 72, ARB + q0 * 72, 72, accG, X.lane);
        mm_ll<2, 1, 2>(U0T + p0 * 72, 72, ARB + q0 * 72, 72, accY, X.lane);
        mm_ll<2, 1, 2>(VT + p0 * 72, 72, ARK + q0 * 72, 72, accY, X.lane);
        mm_ll<2, 1, 2>(WT + p0 * 72, 72, BHT + q0 * 72, 72, accM, X.lane);
        mm_ll<2, 1, 2>(BHT + p0 * 72, 72, U0T + q0 * 72, 72, accN, X.lane);
        mm_ll<2, 1, 2>(KHT + p0 * 72, 72, VT + q0 * 72, 72, accN, X.lane);
        const float gq = GC[qq];
        unsigned mw[4], nw_[4];
#pragma unroll
        for (int tp = 0; tp < 2; ++tp) { const int pp = p0 + 16 * tp + 4 * g;
            const u32x2 rtw = *(const LAS u32x2*)(RT + qq * 72 + pp);
            const f32x4 gp = *(const LAS f32x4*)(GC + pp);
            const f32x4 G4 = accG[tp][0] + (f32x4){bflo(rtw.x), bfhi(rtw.x), bflo(rtw.y), bfhi(rtw.y)};
            const f32x4 M4 = accM[tp][0] * gq, N4 = accN[tp][0] * gp;
            mw[2 * tp] = cvt_pk(M4[0], M4[1]); mw[2 * tp + 1] = cvt_pk(M4[2], M4[3]);
            nw_[2 * tp] = cvt_pk(N4[0], N4[1]); nw_[2 * tp + 1] = cvt_pk(N4[2], N4[3]);
            *(u32x2*)(out + 2 * 4096 + qq * 64 + pp) = (u32x2){cvt_pk(G4[0], G4[1]), cvt_pk(G4[2], G4[3])};
            *(u32x2*)(out + 3 * 4096 + qq * 64 + pp) = (u32x2){cvt_pk(accY[tp][0][0], accY[tp][0][1]), cvt_pk(accY[tp][0][2], accY[tp][0][3])}; }
        *(u32x4*)(out + 0 * 4096 + X.tid * 8) = (u32x4){mw[0], mw[1], mw[2], mw[3]};
        *(u32x4*)(out + 1 * 4096 + ((w >> 1) * 64 + X.lane) * 16 + (w & 1) * 8) = (u32x4){nw_[0], nw_[1], nw_[2], nw_[3]};
    }
    BAR_LDS();
}

DI void rw1_units(const Ctx& X, const PArgs& a) {
    int u = X.blk; if (u >= 2048) return;
    R1Raw cur; rw1_load(X, a, u, cur);
    for (;;) {
        const int un = u + X.nblk; const bool more = un < 2048;
        R1Raw nxt = cur; if (more) rw1_load(X, a, un, nxt);
        rw1_unit(X, a, u, cur);
        if (!more) break;
        cur = nxt; u = un;
    }
}

constexpr int R2D = 4;
DI void rw2_chain(const Ctx& X, const PArgs& a, int ch) {
    const int pair = ch >> 2, it = ch & 3, r = X.lane & 15, g = X.lane >> 4, i = 16 * it + r;
    const bf16* RM = (const bf16*)(a.ws + WS_RM); bf16* RS = (bf16*)(a.ws + WS_RS);
    LAS float* GCL = (LAS float*)X.lds;
    { const f32x4* src = (const f32x4*)((const float*)(a.ws + WS_RGC) + (size_t)pair * 128 * 64);
      for (int q = X.lane; q < 2048; q += 64) *(LAS f32x4*)(GCL + 4 * q) = src[q]; }
    f32x4 acc[4];
#pragma unroll
    for (int pt = 0; pt < 4; ++pt) acc[pt] = (f32x4){0.f, 0.f, 0.f, 0.f};
    u32x4 mreg[R2D][8], nreg[R2D][2];
#define R2_LOAD(s, c) do { const bf16* M_ = RM + ((size_t)pair * 128 + (c)) * 16384; \
        _Pragma("unroll") for (int q = 0; q < 8; ++q) mreg[s][q] = *(const u32x4*)(M_ + (q * 64 + X.lane) * 8); \
        _Pragma("unroll") for (int q = 0; q < 2; ++q) nreg[s][q] = *(const u32x4*)(M_ + 4096 + (it * 64 + X.lane) * 16 + q * 8); } while (0)
#pragma unroll
    for (int s = 0; s < R2D; ++s) R2_LOAD(s, s);
    LDS_WAIT();
    for (int c0 = 0; c0 < 128; c0 += R2D) {
#pragma unroll
        for (int s = 0; s < R2D; ++s) {
            const int c = c0 + s; const size_t u = (size_t)pair * 128 + c;
            f32x4 nw[4];
#pragma unroll
            for (int pt = 0; pt < 4; ++pt) { const unsigned lo = nreg[s][pt >> 1][(pt & 1) * 2], hi = nreg[s][pt >> 1][(pt & 1) * 2 + 1];
                const f32x4 gcv = *(const LAS f32x4*)(GCL + c * 64 + 16 * pt + 4 * g);
                nw[pt] = (f32x4){bflo(lo), bfhi(lo), bflo(hi), bfhi(hi)} + gcv * acc[pt]; }
            unsigned pk[4][2];
#pragma unroll
            for (int pt = 0; pt < 4; ++pt) { pk[pt][0] = cvt_pk(acc[pt][0], acc[pt][1]); pk[pt][1] = cvt_pk(acc[pt][2], acc[pt][3]);
                *(u32x2*)(RS + u * 4096 + i * 64 + 16 * pt + 4 * g) = (u32x2){pk[pt][0], pk[pt][1]}; }
            const bf16x8 sf0 = __builtin_bit_cast(bf16x8, (u32x4){pk[0][0], pk[0][1], pk[1][0], pk[1][1]});
            const bf16x8 sf1 = __builtin_bit_cast(bf16x8, (u32x4){pk[2][0], pk[2][1], pk[3][0], pk[3][1]});
#pragma unroll
            for (int pt = 0; pt < 4; ++pt) { nw[pt] = mfma16(__builtin_bit_cast(bf16x8, mreg[s][2 * pt]), sf0, nw[pt]); nw[pt] = mfma16(__builtin_bit_cast(bf16x8, mreg[s][2 * pt + 1]), sf1, nw[pt]); acc[pt] = nw[pt]; }
            if (c + R2D < 128) R2_LOAD(s, c + R2D);
        }
    }
#undef R2_LOAD
}

DI void rw3_wave(const Ctx& X, const PArgs& a, int u) {
    bf16* proj = (bf16*)(a.ws + WS_PROJ);
    const float* mu = a.in[8];
    const int pair = u >> 7, c = u & 127, b = pair >> 3, h = pair & 7, row0 = b * SEQ + c * 64;
    const int r = X.lane & 15, g = X.lane >> 4;
    const bf16* RMu = (const bf16*)(a.ws + WS_RM) + (size_t)u * 16384;
    const bf16* Su = (const bf16*)(a.ws + WS_RS) + (size_t)u * 4096;
    const bf16* G2 = (const bf16*)(a.ws + WS_G2T) + (size_t)h * 64 * 96;
    bf16x8 sfr[4][2], g2fr[4][3]; f32x4 gw[4], gb[4];
#pragma unroll
    for (int tp = 0; tp < 4; ++tp) {
#pragma unroll
        for (int ks = 0; ks < 2; ++ks) sfr[tp][ks] = *(const bf16x8*)(Su + (16 * tp + r) * 64 + 32 * ks + 8 * g);
#pragma unroll
        for (int ks = 0; ks < 3; ++ks) g2fr[tp][ks] = *(const bf16x8*)(G2 + (16 * tp + r) * 96 + 32 * ks + 8 * g);
        gw[tp] = *(const f32x4*)(a.in[17] + h * 64 + 16 * tp + 4 * g); gb[tp] = *(const f32x4*)(a.in[18] + h * 64 + 16 * tp + 4 * g); }
#pragma unroll 1
    for (int rb = 0; rb < 4; ++rb) {
        const int t = 16 * rb + r; const bool first = (c == 0 && t == 0);
        bf16x8 gfr[2], sg[3];
#pragma unroll
        for (int ks = 0; ks < 2; ++ks) gfr[ks] = *(const bf16x8*)(RMu + 2 * 4096 + t * 64 + 32 * ks + 8 * g);
        u32x4 gc[3], gp[3]; u32x2 vc[4], vp[4], y0[4];
#pragma unroll
        for (int ks = 0; ks < 3; ++ks) { const bf16* pg_ = proj + pj_off(row0 + t, C_GD, 192, 32 * ks + 8 * g); gc[ks] = *(const u32x4*)pg_; gp[ks] = (u32x4){0u, 0u, 0u, 0u}; if (!first) gp[ks] = *(const u32x4*)(pg_ - 192); }
#pragma unroll
        for (int tp = 0; tp < 4; ++tp) { const bf16* pv_ = proj + pj_off(row0 + t, C_RV + h * 64, 64, 16 * tp + 4 * g);
            vc[tp] = *(const u32x2*)pv_; vp[tp] = (u32x2){0u, 0u}; if (!first) vp[tp] = *(const u32x2*)(pv_ - 64);
            y0[tp] = *(const u32x2*)(RMu + 3 * 4096 + t * 64 + 16 * tp + 4 * g); }
        const float bonus = ((const float*)(a.ws + WS_BONUS))[(size_t)(row0 + t) * 8 + h];
#pragma unroll
        for (int ks = 0; ks < 3; ++ks) { const float* mp = mu + (C_GD - C_RR) + 32 * ks + 8 * g;
            const f32x4 va = rw_shift_raw((u32x2){gc[ks].x, gc[ks].y}, (u32x2){gp[ks].x, gp[ks].y}, *(const f32x4*)mp), vb = rw_shift_raw((u32x2){gc[ks].z, gc[ks].w}, (u32x2){gp[ks].z, gp[ks].w}, *(const f32x4*)(mp + 4));
            sg[ks] = __builtin_bit_cast(bf16x8, (u32x4){cvt_pk(sigmoidf_(va[0]), sigmoidf_(va[1])), cvt_pk(sigmoidf_(va[2]), sigmoidf_(va[3])), cvt_pk(sigmoidf_(vb[0]), sigmoidf_(vb[1])), cvt_pk(sigmoidf_(vb[2]), sigmoidf_(vb[3]))}); }
        f32x4 acc[4], gg[4]; float s = 0.f;
#pragma unroll
        for (int tp = 0; tp < 4; ++tp) { acc[tp] = (f32x4){bflo(y0[tp].x), bfhi(y0[tp].x), bflo(y0[tp].y), bfhi(y0[tp].y)}; gg[tp] = (f32x4){0.f, 0.f, 0.f, 0.f};
#pragma unroll
            for (int ks = 0; ks < 2; ++ks) acc[tp] = mfma16(sfr[tp][ks], gfr[ks], acc[tp]);
#pragma unroll
            for (int ks = 0; ks < 3; ++ks) gg[tp] = mfma16(g2fr[tp][ks], sg[ks], gg[tp]);
            s += (acc[tp][0] + acc[tp][1]) + (acc[tp][2] + acc[tp][3]); }
        s += __shfl_xor(s, 16); s += __shfl_xor(s, 32);
        const float mean = s * (1.0f / 64.0f); float q = 0.f;
#pragma unroll
        for (int tp = 0; tp < 4; ++tp)
#pragma unroll
            for (int e = 0; e < 4; ++e) { const float d = acc[tp][e] - mean; q += d * d; }
        q += __shfl_xor(q, 16); q += __shfl_xor(q, 32);
        const float rstd = frsq(q * (1.0f / 64.0f) + 64e-5f);
#pragma unroll
        for (int tp = 0; tp < 4; ++tp) { const int col = h * 64 + 16 * tp + 4 * g;
            const f32x4 vv = rw_shift_raw(vc[tp], vp[tp], *(const f32x4*)(mu + (C_RV - C_RR) + col));
            f32x4 o;
#pragma unroll
            for (int e = 0; e < 4; ++e) o[e] = ((acc[tp][e] - mean) * rstd * gw[tp][e] + gb[tp][e] + bonus * vv[e]) * gg[tp][e];
            *(u32x2*)((bf16*)a.out + (size_t)8 * 1024 * 1024 + (size_t)(row0 + t) * 512 + col) = (u32x2){cvt_pk(o[0], o[1]), cvt_pk(o[2], o[3])}; }
    }
}

namespace epi {
using pg8::Unit; using pg8::BM; using pg8::HALF;
struct InProj {
    static constexpr bool PERM = true, AFTER_DRAIN = false;
    bf16* proj; bf16* ga; bf16* gb;
    DI void operator()(const f32x4 (&acc)[2][2][4][2], const Unit& u, int wr, int wc, int fr, int fq) const {
        const int row0 = u.pm * BM + wr * 64 + fr;
        const bool gate = u.pn >= 15;
#pragma unroll
        for (int bj = 0; bj < 2; ++bj) {
            const int colb = u.pn * BM + bj * HALF + wc * 32 + 8 * fq;
            bf16* base; int pitch;
            if (gate) { base = (u.pn < 19 ? ga + (colb - 15 * BM) : gb + (colb - 19 * BM)); pitch = 1024; }
            else { const int ss = colb < C_RR ? (colb & ~127) : (colb < C_GD ? (colb & ~63) : C_GD); pitch = colb < C_RR ? 128 : (colb < C_GD ? 64 : 192);
                   base = proj + (size_t)ss * NTOK + (colb - ss); }
#pragma unroll
            for (int ai = 0; ai < 2; ++ai)
#pragma unroll
                for (int m = 0; m < 4; ++m) { f32x4 v0 = acc[ai][bj][m][0], v1 = acc[ai][bj][m][1];
                    if (gate) {
#pragma unroll
                        for (int e = 0; e < 4; ++e) { v0[e] = sigmoidf_(v0[e]); v1[e] = sigmoidf_(v1[e]); } }
                    *(u32x4*)(base + (size_t)(row0 + ai * HALF + m * 16) * pitch) = (u32x4){cvt_pk(v0[0], v0[1]), cvt_pk(v0[2], v0[3]), cvt_pk(v1[0], v1[1]), cvt_pk(v1[2], v1[3])}; }
        }
    }
};
template <bool ADD> struct GateMix {
    static constexpr bool PERM = true, AFTER_DRAIN = false;
    bf16* O; int ldc; const bf16* gate; int ldg;
    DI void operator()(const f32x4 (&acc)[2][2][4][2], const Unit& u, int wr, int wc, int fr, int fq) const {
        const int row0 = u.pm * BM + wr * 64 + fr, col0 = u.pn * BM + wc * 32 + 8 * fq;
#pragma unroll
        for (int ai = 0; ai < 2; ++ai)
#pragma unroll
            for (int m = 0; m < 4; ++m) { const size_t row = (size_t)(row0 + ai * HALF + m * 16);
#pragma unroll
                for (int bj = 0; bj < 2; ++bj) { const f32x4 v0 = acc[ai][bj][m][0], v1 = acc[ai][bj][m][1];
                    const u32x4 gw = *(const u32x4*)(gate + row * ldg + col0 + bj * HALF);
                    float o[8] = {v0[0] * bflo(gw.x), v0[1] * bfhi(gw.x), v0[2] * bflo(gw.y), v0[3] * bfhi(gw.y), v1[0] * bflo(gw.z), v1[1] * bfhi(gw.z), v1[2] * bflo(gw.w), v1[3] * bfhi(gw.w)};
                    bf16* op = O + row * ldc + col0 + bj * HALF;
                    if (ADD) { const u32x4 pw = *(const u32x4*)op;
                        o[0] += bflo(pw.x); o[1] += bfhi(pw.x); o[2] += bflo(pw.y); o[3] += bfhi(pw.y); o[4] += bflo(pw.z); o[5] += bfhi(pw.z); o[6] += bflo(pw.w); o[7] += bfhi(pw.w); }
                    *(u32x4*)op = (u32x4){cvt_pk(o[0], o[1]), cvt_pk(o[2], o[3]), cvt_pk(o[4], o[5]), cvt_pk(o[6], o[7])}; } }
    }
};
struct Resid {
    static constexpr bool PERM = false, AFTER_DRAIN = false;
    const float* base; float* C; const float* gt;
    DI void operator()(const f32x4 (&acc)[2][2][4][2], const Unit& u, int wr, int wc, int fr, int fq) const {
        const int row0 = u.pm * BM + wr * 64 + fr, col0 = u.pn * BM + wc * 32 + 4 * fq;
        const int b = (u.pm * BM) >> 13;
        f32x4 gv[2][2];
#pragma unroll
        for (int bj = 0; bj < 2; ++bj)
#pragma unroll
            for (int n = 0; n < 2; ++n) gv[bj][n] = *(const f32x4*)(gt + b * 6144 + col0 + bj * HALF + n * 16);
#pragma unroll
        for (int ai = 0; ai < 2; ++ai)
#pragma unroll
            for (int m = 0; m < 4; ++m) { const size_t off = (size_t)(row0 + ai * HALF + m * 16) * DM + col0;
#pragma unroll
                for (int bj = 0; bj < 2; ++bj)
#pragma unroll
                    for (int n = 0; n < 2; ++n) { const f32x4 bs = *(const f32x4*)(base + off + bj * HALF + n * 16);
                        *(f32x4*)(C + off + bj * HALF + n * 16) = bs + gv[bj][n] * acc[ai][bj][m][n]; } }
    }
};
struct SwiGlu {
    static constexpr bool PERM = true, AFTER_DRAIN = false;
    bf16* O;
    DI void operator()(const f32x4 (&acc)[2][2][4][2], const Unit& u, int wr, int wc, int fr, int fq) const {
        const int row0 = u.pm * BM + wr * 64 + fr, col0 = (u.pn & 3) * 128 + wc * 32 + 8 * fq;
#pragma unroll
        for (int ai = 0; ai < 2; ++ai)
#pragma unroll
            for (int m = 0; m < 4; ++m) { const f32x4 g0 = acc[ai][0][m][0], g1 = acc[ai][0][m][1], u0 = acc[ai][1][m][0], u1 = acc[ai][1][m][1];
                u32x4 w; w.x = cvt_pk(siluf_(g0[0]) * u0[0], siluf_(g0[1]) * u0[1]); w.y = cvt_pk(siluf_(g0[2]) * u0[2], siluf_(g0[3]) * u0[3]);
                w.z = cvt_pk(siluf_(g1[0]) * u1[0], siluf_(g1[1]) * u1[1]); w.w = cvt_pk(siluf_(g1[2]) * u1[2], siluf_(g1[3]) * u1[3]);
                *(u32x4*)(O + (size_t)(row0 + ai * HALF + m * 16) * 512 + col0) = w; }
    }
};
struct MoeOut {
    static constexpr bool PERM = true, AFTER_DRAIN = false;
    bf16* O;
    DI void operator()(const f32x4 (&acc)[2][2][4][2], const Unit& u, int wr, int wc, int fr, int fq) const {
        const int row0 = u.pm * BM + wr * 64 + fr, col0 = (u.pn & 3) * BM + wc * 32 + 8 * fq;
#pragma unroll
        for (int ai = 0; ai < 2; ++ai)
#pragma unroll
            for (int m = 0; m < 4; ++m) { bf16* rowp = O + (size_t)(row0 + ai * HALF + m * 16) * DM + col0;
#pragma unroll
                for (int bj = 0; bj < 2; ++bj) { const f32x4 v0 = acc[ai][bj][m][0], v1 = acc[ai][bj][m][1];
                    *(u32x4*)(rowp + bj * HALF) = (u32x4){cvt_pk(v0[0], v0[1]), cvt_pk(v0[2], v0[3]), cvt_pk(v1[0], v1[1]), cvt_pk(v1[2], v1[3])}; } }
    }
};
struct MoeOrder {
    const LAS int* tile_e; int ntiles, G, c;
    DI bool next(int i, Unit& u) const { const int L = i * G + c; if (L >= ntiles * 4) return false; const int pm = L >> 2; u.pm = pm; u.pn = tile_e[pm] * 4 + (L & 3); return true; }
    DI void a_ready(const Unit&) const {}
    DI void done(const Unit&) const {}
};
struct MoeGatherOrder {
    const LAS int* tile_e; const LAS int* pad_start; const LAS int* cnt; const int* tokl; int ntiles, G, c;
    DI bool next(int i, Unit& u) const { const int L = i * G + c; if (L >= ntiles * 4) return false; const int pm = L >> 2; u.pm = pm; u.pn = tile_e[pm] * 4 + (L & 3); return true; }
    DI int row_of(const Unit& u, int rr) const { const int e = u.pn >> 2, pos = u.pm * 256 - pad_start[e] + rr; return pos < cnt[e] ? tokl[e * 16384 + pos] : 0; }
    DI void a_ready(const Unit&) const {}
    DI void done(const Unit&) const {}
};
}

constexpr int L_TILE_E = 131072, L_PADSTART = 131072 + 1024, L_NTILES = 131072 + 1024 + 256, L_CNT = 131072 + 1024 + 512;
DI void moe_tables(const Ctx& X, const PArgs& a) {
    LAS int* tile_e = (LAS int*)(X.lds + L_TILE_E); LAS int* pad_start = (LAS int*)(X.lds + L_PADSTART); LAS int* ntl = (LAS int*)(X.lds + L_NTILES); LAS int* cntl = (LAS int*)(X.lds + L_CNT);
    if (X.tid == 0) {
        const unsigned* cnt = (const unsigned*)(a.ws + WS_CTL) + CW_ECNT; int tiles = 0;
        for (int e = 0; e < 32; ++e) { const int n = (int)__hip_atomic_load(cnt + e, __ATOMIC_RELAXED, __HIP_MEMORY_SCOPE_AGENT); const int nt = (n + 255) >> 8;
            cntl[e] = n; pad_start[e] = tiles * 256; for (int q = 0; q < nt; ++q) tile_e[tiles + q] = e; tiles += nt; }
        pad_start[32] = tiles * 256; ntl[0] = tiles;
    }
    __syncthreads();
}

DI void phase_expert_weights(const Ctx& X, const PArgs& a) {
    LAS float* scr = (LAS float*)(X.lds + X.wave * 16384);
    const int gw = X.blk * 8 + X.wave, NGW = X.nblk * 8;
    bf16* WGU = (bf16*)(a.ws + WS_EWGU); bf16* WD = (bf16*)(a.ws + WS_EWD);
    for (int it = gw; it < 3 * 8192; it += NGW) {
        const int which = it >> 13, r = it & 8191, e = r >> 8, q = r & 255;
        if (which < 2) { const int kb = q >> 4, nb = q & 15;
            transpose_item(a.in[27 + which] + (size_t)e * 1024 * 512, 512, nb * 32, kb * 64, WGU + ((size_t)e * 1024 + (nb >> 2) * 256 + which * 128 + (nb & 3) * 32) * 1024, 1024, false, scr, X.lane); }
        else { const int kb = q >> 5, nb = q & 31;
            transpose_item(a.in[29] + (size_t)e * 512 * 1024, 1024, nb * 32, kb * 64, WD + ((size_t)e * 1024 + nb * 32) * 512, 512, false, scr, X.lane); }
    }
}

DI void phase_router(const Ctx& X, const PArgs& a, bool dry = false) {
    const float* x1 = a.out;
    const bf16* WRH = (const bf16*)(a.ws + WS_WRH); const bf16* WRL = (const bf16*)(a.ws + WS_WRL); const float* CB = (const float*)(a.ws + WS_CB);
    LAS float* PLG = (LAS float*)X.lds;
    LAS float* PSS = (LAS float*)(X.lds + 24576);
    LAS int* EL = (LAS int*)(X.lds + 25088);
    LAS int* PL = (LAS int*)(X.lds + 25600);
    LAS float* RSL = (LAS float*)(X.lds + 26112);
    unsigned* cnt = (unsigned*)(a.ws + WS_CTL) + CW_ECNT;
    const int w = X.wave, r = X.lane & 15, g = X.lane >> 4, tg = w & 3, kh = w >> 2;
    for (int tb = X.blk; tb < 256; tb += X.nblk) {
        const int m = tb * 64 + 16 * tg + r, b = (tb * 64) >> 13;
        const float* xp = x1 + (size_t)m * DM + 512 * kh + 8 * g;
        const bf16* wh = WRH + ((size_t)b * 48 + r) * 1024 + 512 * kh + 8 * g; const bf16* wl = WRL + ((size_t)b * 48 + r) * 1024 + 512 * kh + 8 * g;
        f32x4 acc[3]; float ssq = 0.f;
#pragma unroll
        for (int ot = 0; ot < 3; ++ot) acc[ot] = (f32x4){0.f, 0.f, 0.f, 0.f};
#pragma unroll 4
        for (int ks = 0; ks < 16; ++ks) {
            const f32x4 xa = *(const f32x4*)(xp + 32 * ks), xb = *(const f32x4*)(xp + 32 * ks + 4);
            ssq += (xa[0] * xa[0] + xa[1] * xa[1]) + (xa[2] * xa[2] + xa[3] * xa[3]) + (xb[0] * xb[0] + xb[1] * xb[1]) + (xb[2] * xb[2] + xb[3] * xb[3]);
            const unsigned h0 = cvt_pk(xa[0], xa[1]), h1 = cvt_pk(xa[2], xa[3]), h2 = cvt_pk(xb[0], xb[1]), h3 = cvt_pk(xb[2], xb[3]);
            const unsigned l0 = cvt_pk(xa[0] - bflo(h0), xa[1] - bfhi(h0)), l1 = cvt_pk(xa[2] - bflo(h1), xa[3] - bfhi(h1)), l2 = cvt_pk(xb[0] - bflo(h2), xb[1] - bfhi(h2)), l3 = cvt_pk(xb[2] - bflo(h3), xb[3] - bfhi(h3));
            const bf16x8 ahi = __builtin_bit_cast(bf16x8, (u32x4){h0, h1, h2, h3}), alo = __builtin_bit_cast(bf16x8, (u32x4){l0, l1, l2, l3});
#pragma unroll
            for (int ot = 0; ot < 3; ++ot) {
                const bf16x8 bh = *(const bf16x8*)(wh + (size_t)ot * 16 * 1024 + 32 * ks), bl = *(const bf16x8*)(wl + (size_t)ot * 16 * 1024 + 32 * ks);
                acc[ot] = mfma16(bh, ahi, acc[ot]); acc[ot] = mfma16(bl, ahi, acc[ot]); acc[ot] = mfma16(bh, alo, acc[ot]); }
        }
        ssq += __shfl_xor(ssq, 16); ssq += __shfl_xor(ssq, 32);
        const int tl = 16 * tg + r;
#pragma unroll
        for (int ot = 0; ot < 3; ++ot) *(LAS f32x4*)(PLG + (kh * 64 + tl) * 48 + 16 * ot + 4 * g) = acc[ot];
        if (g == 0) PSS[kh * 64 + tl] = ssq;
        __syncthreads();
        if (X.tid < 64) {
            const int t = X.tid, mm = tb * 64 + t;
            const float rs = frsq((PSS[t] + PSS[64 + t]) * (1.f / DM) + 1e-6f);
            RSL[t] = rs;
            const LAS float* p0 = PLG + t * 48; const LAS float* p1 = PLG + (64 + t) * 48; const float* cb = CB + b * 48;
            float lg[4];
#pragma unroll
            for (int o = 0; o < 4; ++o) lg[o] = rs * (p0[o] + p1[o]) + cb[o];
            int gi = 0; float gm = lg[0];
#pragma unroll
            for (int o = 1; o < 4; ++o) if (lg[o] > gm) { gm = lg[o]; gi = o; }
            float gs = 0.f;
#pragma unroll
            for (int o = 0; o < 4; ++o) gs += __expf(lg[o] - gm);
            const float pgrp = 1.0f / gs;
            float sel[8];
#pragma unroll
            for (int o = 0; o < 8; ++o) sel[o] = rs * (p0[4 + gi * 8 + o] + p1[4 + gi * 8 + o]) + cb[4 + gi * 8 + o];
            int i0 = 0; float m0 = sel[0];
#pragma unroll
            for (int o = 1; o < 8; ++o) if (sel[o] > m0) { m0 = sel[o]; i0 = o; }
            int i1 = -1; float m1 = -3.0e38f;
#pragma unroll
            for (int o = 0; o < 8; ++o) if (o != i0 && sel[o] > m1) { m1 = sel[o]; i1 = o; }
            const float e1 = __expf(m1 - m0), den = 1.0f + e1;
            EL[t * 2] = gi * 8 + i0; EL[t * 2 + 1] = gi * 8 + i1;
            float* wt = (float*)(a.ws + WS_WTS) + (size_t)mm * 2; wt[0] = pgrp / den; wt[1] = pgrp * e1 / den;
        }
        __syncthreads();
        if (!dry && X.tid < 32) { int n = 0;
            for (int q = 0; q < 128; ++q) n += (EL[q] == X.tid) ? 1 : 0;
            int base = 0; if (n) base = (int)__hip_atomic_fetch_add(cnt + X.tid, (unsigned)n, __ATOMIC_RELAXED, __HIP_MEMORY_SCOPE_AGENT);
            for (int q = 0; q < 128; ++q) if (EL[q] == X.tid) PL[q] = base++; }
        __syncthreads();
        if (!dry && X.tid < 128) { const int e = EL[X.tid], pos = PL[X.tid];
            ((int*)(a.ws + WS_EID))[(size_t)tb * 128 + X.tid] = e; ((int*)(a.ws + WS_POS))[(size_t)tb * 128 + X.tid] = pos;
            ((int*)(a.ws + WS_TOKL))[(size_t)e * 16384 + pos] = tb * 64 + (X.tid >> 1); }
        {
            const float* g2 = a.in[22]; const float* mod = (const float*)(a.ws + WS_MOD); const float* RSV = (const float*)(a.ws + WS_RSV); bf16* h2 = (bf16*)(a.ws + WS_H2);
            for (int q = 0; q < 8; ++q) { const int mm = tb * 64 + X.wave * 8 + q; const float rs = RSL[X.wave * 8 + q];
                const f32x4* xr = (const f32x4*)(x1 + (size_t)mm * DM) + X.lane; u32x2* o = (u32x2*)(h2 + (size_t)mm * DM) + X.lane;
#pragma unroll
                for (int j = 0; j < 4; ++j) { const int col = 4 * X.lane + 256 * j;
                    const f32x4 gv = *(const f32x4*)(g2 + col), sh = *(const f32x4*)(mod + b * 6144 + 3072 + col), sc = *(const f32x4*)(mod + b * 6144 + 4096 + col);
                    const f32x4 y = xr[64 * j] * rs * gv * (1.0f + sc) + sh; o[64 * j] = (u32x2){cvt_pk(y.x, y.y), cvt_pk(y.z, y.w)}; } }
            (void)RSV;
        }
        __syncthreads();
    }
}

DI void phase_final(const Ctx& X, const PArgs& a, bool with_moe, bool dry = false) {
    moe_tables(X, a);
    const LAS int* pad_start = (const LAS int*)(X.lds + L_PADSTART); const int* EID = (const int*)(a.ws + WS_EID); const int* POS = (const int*)(a.ws + WS_POS);
    float* out = a.out; float* dst = dry ? (float*)(a.ws + WS_HID) : a.out; const float* fg = a.in[30]; const float* mod = (const float*)(a.ws + WS_MOD);
    const float* WTS = (const float*)(a.ws + WS_WTS); const bf16* Y = (const bf16*)(a.ws + WS_XG);
    const int gw = X.blk * 8 + X.wave, NGW = X.nblk * 8;
    for (int m = gw; m < NTOK; m += NGW) {
        const int b = m >> 13;
        f32x4* xr = (f32x4*)(out + (size_t)m * DM) + X.lane;
        f32x4 v[4]; float s = 0.f;
        int s0 = 0, s1 = 0; float w0 = 0.f, w1 = 0.f;
        if (with_moe) { s0 = pad_start[EID[m * 2]] + POS[m * 2]; s1 = pad_start[EID[m * 2 + 1]] + POS[m * 2 + 1]; w0 = WTS[m * 2]; w1 = WTS[m * 2 + 1]; }
#pragma unroll
        for (int j = 0; j < 4; ++j) { const int col = 4 * X.lane + 256 * j; v[j] = xr[64 * j];
            if (with_moe) {
                const u32x2 y0 = *(const u32x2*)(Y + (size_t)s0 * DM + col), y1 = *(const u32x2*)(Y + (size_t)s1 * DM + col);
                const f32x4 gt = *(const f32x4*)(mod + b * 6144 + 5120 + col);
                const f32x4 mo = w0 * (f32x4){bflo(y0.x), bfhi(y0.x), bflo(y0.y), bfhi(y0.y)} + w1 * (f32x4){bflo(y1.x), bfhi(y1.x), bflo(y1.y), bfhi(y1.y)};
                v[j] = v[j] + gt * mo; }
            s += (v[j].x * v[j].x + v[j].y * v[j].y) + (v[j].z * v[j].z + v[j].w * v[j].w); }
        const float rs = frsq(wave_sum(s) * (1.f / DM) + 1e-6f);
#pragma unroll
        for (int j = 0; j < 4; ++j) { const f32x4 g = *(const f32x4*)(fg + 4 * X.lane + 256 * j); ((f32x4*)(dst + (size_t)(dry ? (m & 4095) : m) * DM) + X.lane)[64 * j] = v[j] * rs * g; }
    }
}

#ifndef MK_DUP
#define MK_DUP 0
#endif
constexpr int NPH = 12;
template <class T> DI T* fresh_ptr(T* p) { asm volatile("" : "+s"(p)); return p; }
#define PH_ARGS const PArgs al{a.in, fresh_ptr(a.out), fresh_ptr(a.ws)}; unsigned char* ws = al.ws; (void)ws
__global__ void __launch_bounds__(512, 2) mk_fwd(Args a) {
    extern __shared__ __attribute__((aligned(16))) unsigned char lds_raw[];
    Ctx X; X.lds = (LAS unsigned char*)lds_raw; X.tid = threadIdx.x; X.lane = X.tid & 63; X.wave = __builtin_amdgcn_readfirstlane(X.tid >> 6); X.nblk = gridDim.x; X.blk = blockIdx.x;
    if (X.tid < 8) ((LAS unsigned*)(X.lds + LDS_MISC))[X.tid] = 0u;
    __syncthreads();
    XcdBarrier bar = xcd_barrier_post((unsigned*)(a.ws + WS_CTL) + CW_BAR, (volatile LAS unsigned*)(X.lds + LDS_MISC));
    const int lo = a.ph_lo, hi = a.ph_hi;
#ifndef MK_PHASE_MASK
#define MK_PHASE_MASK 0xffff
#endif
#define IN(k) (((MK_PHASE_MASK >> (k)) & 1) && lo <= (k) && (k) < hi)
#define SEAM(k) do { if (IN(k) && IN((k) + 1)) xcd_barrier(bar); } while (0)

    if (IN(0)) { PH_ARGS; phase_prologue(X, al); } SEAM(0);
    if (IN(1)) { PH_ARGS; phase_norm1(X, al); } SEAM(1);
    if (IN(2)) { PH_ARGS;
        pg8::Gemm g{(bf16*)al.out, (const bf16*)(ws + WS_WIN), NTOK, NWIN, 1024, 1024}; pg8::StaticOrder S; S.init(NTOK, NWIN, X.nblk, X.blk);
        epi::InProj E{(bf16*)(ws + WS_PROJ), (bf16*)al.out + (size_t)16 * 1024 * 1024, (bf16*)(ws + WS_GATEB)};
        pg8::gemm_phase<epi::InProj, pg8::StaticOrder>(X.lds, g, S, E, nullptr);
    } SEAM(2);
    if (IN(3)) { PH_ARGS;
        for (int rep = 0; rep < 1 + (MK_DUP & 1); ++rep) for (int u = X.blk; u < 1024; u += X.nblk) hg1_unit(X, al, u);
        __syncthreads();
        rw1_units(X, al);
        if ((MK_DUP >> 1) & 1) { __syncthreads(); rw1_units(X, al); }
        __syncthreads();
    } SEAM(3);
    if (IN(4)) { PH_ARGS;
        hg2_scan(X, al);
        for (int rep = 0; rep < 1 + ((MK_DUP >> 2) & 1); ++rep) if (X.wave == 0) for (int ch = 0; ch < 64; ++ch) if ((128 + ch) % X.nblk == X.blk) rw2_chain(X, al, ch);
    } SEAM(4);
    if (IN(5)) { PH_ARGS;
        for (int rep = 0; rep < 1 + ((MK_DUP >> 15) & 1); ++rep) for (int u = X.blk; u < 1024; u += X.nblk) hg3_unit(X, al, u);
        for (int u = X.blk * 8 + X.wave; u < 2048; u += X.nblk * 8) rw3_wave(X, al, u);
        if ((MK_DUP >> 3) & 1) for (int u = X.blk * 8 + X.wave; u < 2048; u += X.nblk * 8) rw3_wave(X, al, u);
    } SEAM(5);
    if (IN(6)) { PH_ARGS;
        pg8::StaticOrder S; S.init(NTOK, 1024, X.nblk, X.blk);
        { pg8::Gemm g{(const bf16*)al.out, (const bf16*)(ws + WS_WPA), NTOK, 1024, 512, 512};
          epi::GateMix<false> E{(bf16*)(ws + WS_MIXED), 1024, (bf16*)al.out + (size_t)16 * 1024 * 1024, 1024};
          pg8::gemm_phase<epi::GateMix<false>, pg8::StaticOrder>(X.lds, g, S, E, nullptr); }
        __syncthreads();
        { pg8::Gemm g{(const bf16*)al.out + (size_t)8 * 1024 * 1024, (const bf16*)(ws + WS_WPB), NTOK, 1024, 512, 512};
          epi::GateMix<true> E{(bf16*)(ws + WS_MIXED), 1024, (bf16*)(ws + WS_GATEB), 1024};
          pg8::gemm_phase<epi::GateMix<true>, pg8::StaticOrder>(X.lds, g, S, E, nullptr); }
    } SEAM(6);
    if (IN(7)) { PH_ARGS;
        pg8::Gemm g{(const bf16*)(ws + WS_MIXED), (const bf16*)(ws + WS_WOUT), NTOK, 1024, 1024, 1024}; pg8::StaticOrder S; S.init(NTOK, 1024, X.nblk, X.blk);
        epi::Resid E{al.in[0], al.out, (const float*)(ws + WS_MOD) + 2048};
        pg8::gemm_phase<epi::Resid, pg8::StaticOrder>(X.lds, g, S, E, nullptr);
        __syncthreads();
        phase_expert_weights(X, al);
    } SEAM(7);
    if (IN(8)) { PH_ARGS; if ((MK_DUP >> 16) & 1) { phase_router(X, al, true); __syncthreads(); } phase_router(X, al); } SEAM(8);
    if ((MK_DUP >> 20) & 1) {
#pragma unroll 1
        for (int q = 0; q < 10; ++q) xcd_barrier(bar); }
    if (IN(9)) { PH_ARGS;
        moe_tables(X, al);
        const int ntiles = ((const LAS int*)(X.lds + L_NTILES))[0];
        pg8::Gemm g{(const bf16*)(ws + WS_H2), (const bf16*)(ws + WS_EWGU), ntiles * 256, 32 * 1024, 1024, 1024};
        epi::MoeGatherOrder S{(const LAS int*)(X.lds + L_TILE_E), (const LAS int*)(X.lds + L_PADSTART), (const LAS int*)(X.lds + L_CNT), (const int*)(ws + WS_TOKL), ntiles, X.nblk, X.blk};
        epi::SwiGlu E{(bf16*)(ws + WS_HID)};
        pg8::gemm_phase_gather<epi::SwiGlu, epi::MoeGatherOrder>(X.lds, g, S, E, nullptr);
    } SEAM(9);
    if (IN(10)) { PH_ARGS;
        moe_tables(X, al);
        const int ntiles = ((const LAS int*)(X.lds + L_NTILES))[0];
        pg8::Gemm g{(const bf16*)(ws + WS_HID), (const bf16*)(ws + WS_EWD), ntiles * 256, 32 * 1024, 512, 512};
        epi::MoeOrder S{(const LAS int*)(X.lds + L_TILE_E), ntiles, X.nblk, X.blk};
        epi::MoeOut E{(bf16*)(ws + WS_XG)};
        pg8::gemm_phase<epi::MoeOut, epi::MoeOrder>(X.lds, g, S, E, nullptr);
    } SEAM(10);
    if (IN(11)) { PH_ARGS; phase_final(X, al, true); }
#undef IN
#undef SEAM
}

extern "C" void kernel_launch(void* const* d_in, const int* in_sizes, int n_in, void* d_out, int out_size, void* d_ws, size_t ws_size, hipStream_t stream) {
    static int grid = 0;
    if (grid == 0) {
        int dev = 0, cus = 0;
        if (n_in != 31 || out_size != NTOK * DM || ws_size < WS_END) { fprintf(stderr, "kernel_launch: unexpected shapes (n_in %d out %d ws %zu)\n", n_in, out_size, ws_size); grid = -1; return; }
        if (hipGetDevice(&dev) != hipSuccess || hipDeviceGetAttribute(&cus, hipDeviceAttributeMultiprocessorCount, dev) != hipSuccess) { grid = -1; return; }
        if (hipFuncSetAttribute((const void*)mk_fwd, hipFuncAttributeMaxDynamicSharedMemorySize, LDS_BYTES) != hipSuccess) { fprintf(stderr, "kernel_launch: hipFuncSetAttribute failed\n"); grid = -1; return; }
        int per_cu = 0;
        if (hipOccupancyMaxActiveBlocksPerMultiprocessor(&per_cu, (const void*)mk_fwd, 512, LDS_BYTES) != hipSuccess || per_cu < 1) fprintf(stderr, "kernel_launch: occupancy query reports %d\n", per_cu);
        (void)hipGetLastError();
        grid = cus;
    }
    if (grid < 0) return;
    (void)hipMemsetAsync((char*)d_ws + WS_CTL, 0, CTL_ZERO_BYTES, stream);
    Args a{};
    for (int i = 0; i < 31; ++i) a.in[i] = (const float*)d_in[i];
    a.out = (float*)d_out; a.ws = (unsigned char*)d_ws;
#if MK_ONE_LAUNCH
    a.ph_lo = 0; a.ph_hi = NPH;
    hipLaunchKernelGGL(mk_fwd, dim3(grid), dim3(512), LDS_BYTES, stream, a);
#else
    for (int ph = 0; ph < NPH; ++ph) {
        a.ph_lo = ph; a.ph_hi = ph + 1;
        hipLaunchKernelGGL(mk_fwd, dim3(grid), dim3(512), LDS_BYTES, stream, a);
    }
#endif
}
```
